# Optimizing an MI355X kernel written in HIP

```python
import math
import jax, jax.numpy as jnp
from jax import lax
import numpy as np

D_MODEL = 1024
BATCH = 8
SEQ = 8192
DEPTH = 1

GRID_W = 64
CTX_LEN = 256
HEAD_DIM = 64
ATTN_SCALE = HEAD_DIM ** -0.5
ROPE_FREQS = HEAD_DIM // 4
ROPE_BASE = 10000.0
EPS = 1e-6
BLOCK = 128
A_Q_HEADS = 16
A_KV_HEADS = 2
A_GROUP = A_Q_HEADS // A_KV_HEADS
WINDOW = 128
A_WIDTH = A_Q_HEADS * HEAD_DIM
B_HEADS = 8
B_V_DIM = 2 * HEAD_DIM
B_WIDTH = B_HEADS * B_V_DIM
KA_W = A_KV_HEADS * HEAD_DIM
KB_W = B_HEADS * 2 * HEAD_DIM
KV_W = 2 * KA_W + KB_W + B_WIDTH
IN_W = KV_W + A_WIDTH + KB_W + 2 * D_MODEL
N_EXPERTS = 256
TOP_K = 8
N_GROUPS = 8
TOPK_GROUPS = 4
D_EXPERT = D_MODEL // 4
ROUTED_SCALE = 2.5
MOE_BLOCK = 128

kernel_name = "hybrid_dit_gqa_sink_diffattn_moe"


def rms_norm(x, g):
    xf = x.astype(jnp.float32)
    y = xf * lax.rsqrt(jnp.mean(xf * xf, axis=-1, keepdims=True) + EPS)
    return (y * g.astype(jnp.float32)).astype(x.dtype)


def rope_tables(n):
    rows = n // GRID_W
    row = jnp.broadcast_to(jnp.arange(rows)[:, None], (rows, GRID_W)).reshape(-1)
    col = jnp.broadcast_to(jnp.arange(GRID_W)[None, :], (rows, GRID_W)).reshape(-1)
    freqs = ROPE_BASE ** (-jnp.arange(ROPE_FREQS, dtype=jnp.float32) / ROPE_FREQS)
    pos = jnp.stack([row, col], axis=-1).astype(jnp.float32)
    ang = pos[:, :, None] * freqs
    return jnp.cos(ang), jnp.sin(ang)


def apply_rope(x, cos, sin):
    bshape = (x.shape[1],) + (1,) * (x.ndim - 3) + (2, ROPE_FREQS)
    c = cos.reshape(bshape)
    s = sin.reshape(bshape)
    xr = x.astype(jnp.float32).reshape(x.shape[:-1] + (2, 2, ROPE_FREQS))
    x1, x2 = xr[..., 0, :], xr[..., 1, :]
    out = jnp.stack([x1 * c - x2 * s, x2 * c + x1 * s], axis=-2)
    return out.reshape(x.shape).astype(x.dtype)


def sink_attend(q, k, v, sink, mask=None):
    s = jnp.einsum('bqkgd,bskd->bkgqs', q, k).astype(jnp.float32) * ATTN_SCALE
    if mask is not None:
        s = jnp.where(mask, s, -jnp.inf)
    sink_col = jnp.broadcast_to(sink.astype(jnp.float32)[None, :, :, None, None], s.shape[:-1] + (1,))
    p = jax.nn.softmax(jnp.concatenate([s, sink_col], axis=-1), axis=-1)[..., :-1]
    return jnp.einsum('bkgqs,bskd->bqkgd', p.astype(v.dtype), v)


def window_attention(q, k, v, kc, vc, sink):
    B, n = q.shape[:2]
    nb = n // BLOCK
    span = BLOCK + 2 * WINDOW
    pad = ((0, 0), (WINDOW, WINDOW), (0, 0), (0, 0))
    k_pad = jnp.pad(k, pad)
    v_pad = jnp.pad(v, pad)
    qb = jnp.moveaxis(q.reshape((B, nb, BLOCK) + q.shape[2:]), 1, 0)
    offs = jnp.arange(span) - WINDOW
    band = jnp.abs(jnp.arange(BLOCK)[:, None] - offs[None, :]) <= WINDOW
    ctx_ok = jnp.ones((BLOCK, kc.shape[1]), dtype=bool)

    def one_block(args):
        i, q_i = args
        start = i * BLOCK
        k_i = jnp.concatenate([lax.dynamic_slice_in_dim(k_pad, start, span, axis=1), kc], axis=1)
        v_i = jnp.concatenate([lax.dynamic_slice_in_dim(v_pad, start, span, axis=1), vc], axis=1)
        kpos = start + offs
        valid = band & ((kpos >= 0) & (kpos < n))[None, :]
        mask = jnp.concatenate([valid, ctx_ok], axis=1)
        return sink_attend(q_i, k_i, v_i, sink, mask)

    out = lax.map(one_block, (jnp.arange(nb), qb))
    return jnp.moveaxis(out, 0, 1).reshape(B, n, A_WIDTH)


def diff_attend(q, k, v, lam):
    s = jnp.einsum('bqhjd,bshjd->bhjqs', q, k).astype(jnp.float32) * ATTN_SCALE
    p = jax.nn.softmax(s, axis=-1)
    a = p[:, :, 0] - lam * p[:, :, 1]
    return jnp.einsum('bhqs,bshe->bqhe', a.astype(v.dtype), v)


def blocked_diff_attention(q, k, v, lam):
    B, n = q.shape[:2]
    nb = n // BLOCK
    qb = jnp.moveaxis(q.reshape((B, nb, BLOCK) + q.shape[2:]), 1, 0)
    out = lax.map(lambda q_i: diff_attend(q_i, k, v, lam), qb)
    return jnp.moveaxis(out, 0, 1).reshape((B, n) + out.shape[3:])


def mixer_kv(kv, p):
    B, S = kv.shape[:2]
    ka, va, kb, vb = jnp.split(kv, [KA_W, 2 * KA_W, 2 * KA_W + KB_W], axis=-1)
    ka = rms_norm(ka.reshape(B, S, A_KV_HEADS, HEAD_DIM), p['knorm_a'])
    va = va.reshape(B, S, A_KV_HEADS, HEAD_DIM)
    kb = rms_norm(kb.reshape(B, S, B_HEADS, 2, HEAD_DIM), p['knorm_b'])
    vb = vb.reshape(B, S, B_HEADS, B_V_DIM)
    return ka, va, kb, vb


def mixer_q(qg, p):
    B, S = qg.shape[:2]
    qa, qb, ga, gb = jnp.split(qg, [A_WIDTH, A_WIDTH + KB_W, A_WIDTH + KB_W + D_MODEL], axis=-1)
    qa = rms_norm(qa.reshape(B, S, A_KV_HEADS, A_GROUP, HEAD_DIM), p['qnorm_a'])
    qb = rms_norm(qb.reshape(B, S, B_HEADS, 2, HEAD_DIM), p['qnorm_b'])
    return qa, qb, jax.nn.sigmoid(ga), jax.nn.sigmoid(gb)


def merge_branches(oa, ob, ga, gb, p, lam_init):
    B, S = oa.shape[:2]
    ob = rms_norm(ob, p['subln_g']) * (1.0 - lam_init)
    ya = oa.reshape(B, S, A_WIDTH) @ p['w_pa']
    yb = ob.reshape(B, S, B_WIDTH) @ p['w_pb']
    return (ga * ya + gb * yb) @ p['w_o']


def token_mixers(h, hc, cos, sin, p, lam_init, update_ctx):
    proj = h @ p['w_in']
    ka, va, kb, vb = mixer_kv(proj[..., :KV_W], p)
    qa, qb, ga, gb = mixer_q(proj[..., KV_W:], p)
    ka, kb, qa, qb = (apply_rope(t, cos, sin) for t in (ka, kb, qa, qb))
    proj_c = hc @ (p['w_in'] if update_ctx else p['w_in'][:, :KV_W])
    kac, vac, kbc, vbc = mixer_kv(proj_c[..., :KV_W], p)
    oa = window_attention(qa, ka, va, kac, vac, p['sink_a'])
    ob = blocked_diff_attention(qb, jnp.concatenate([kb, kbc], axis=1),
                                jnp.concatenate([vb, vbc], axis=1), p['lam'])
    out = merge_branches(oa, ob, ga, gb, p, lam_init)
    out_c = None
    if update_ctx:
        qac, qbc, gac, gbc = mixer_q(proj_c[..., KV_W:], p)
        oac = sink_attend(qac, kac, vac, p['sink_a']).reshape(hc.shape[0], hc.shape[1], A_WIDTH)
        obc = diff_attend(qbc, kbc, vbc, p['lam'])
        out_c = merge_branches(oac, obc, gac, gbc, p, lam_init)
    return out, out_c


def swiglu(x, wg, wu, wd):
    return (jax.nn.silu(x @ wg) * (x @ wu)) @ wd


def moe(tokens, p):
    T, D = tokens.shape
    scores = jax.nn.sigmoid((tokens @ p['w_router']).astype(jnp.float32))
    biased = scores + p['router_bias'].astype(jnp.float32)
    grp = biased.reshape(T, N_GROUPS, N_EXPERTS // N_GROUPS)
    grp_score = lax.top_k(grp, 2)[0].sum(-1)
    _, top_g = lax.top_k(grp_score, TOPK_GROUPS)
    gmask = jax.nn.one_hot(top_g, N_GROUPS, dtype=jnp.float32).sum(-2) > 0
    emask = jnp.repeat(gmask, N_EXPERTS // N_GROUPS, axis=1)
    _, idx = lax.top_k(jnp.where(emask, biased, -jnp.inf), TOP_K)
    w = jnp.take_along_axis(scores, idx, axis=-1)
    w = w / jnp.sum(w, axis=-1, keepdims=True) * ROUTED_SCALE

    M = T * TOP_K
    e_flat = idx.reshape(M)
    tok_flat = jnp.arange(M) // TOP_K
    w_flat = w.reshape(M)
    order = jnp.argsort(e_flat)
    e_s, tok_s, w_s = e_flat[order], tok_flat[order], w_flat[order]
    counts = jnp.bincount(e_flat, length=N_EXPERTS)
    start = jnp.cumsum(counts) - counts
    padded = (counts + MOE_BLOCK - 1) // MOE_BLOCK * MOE_BLOCK
    pend = jnp.cumsum(padded)
    pstart = pend - padded
    dest = pstart[e_s] + (jnp.arange(M) - start[e_s])
    nblk = -(-M // MOE_BLOCK) + N_EXPERTS
    P = nblk * MOE_BLOCK
    buf_tok = jnp.zeros((P,), jnp.int32).at[dest].set(tok_s.astype(jnp.int32))
    buf_w = jnp.zeros((P,), jnp.float32).at[dest].set(w_s)
    blk_expert = jnp.minimum(jnp.searchsorted(pend, jnp.arange(nblk) * MOE_BLOCK, side='right'),
                             N_EXPERTS - 1)

    def body(b, y):
        rows = lax.dynamic_slice_in_dim(buf_tok, b * MOE_BLOCK, MOE_BLOCK)
        wts = lax.dynamic_slice_in_dim(buf_w, b * MOE_BLOCK, MOE_BLOCK)
        e = blk_expert[b]
        out = swiglu(tokens[rows], p['w_gate_e'][e], p['w_up_e'][e], p['w_down_e'][e])
        return y.at[rows].add(out.astype(jnp.float32) * wts[:, None])

    y = lax.fori_loop(0, nblk, body, jnp.zeros((T, D), jnp.float32))
    shared = swiglu(tokens, p['w_gate_s'], p['w_up_s'], p['w_down_s']).astype(jnp.float32)
    return (y + shared).astype(tokens.dtype)


def setup_inputs(seed: int = 0) -> dict:
    key = jax.random.key(seed)
    ks = jax.random.split(key, 32)
    L, D = DEPTH, D_MODEL

    def nrm(k, shape, s):
        return jax.random.normal(k, shape, jnp.float32) * s

    return {
        "x": nrm(ks[0], (BATCH, SEQ, D), 1.0),
        "c": nrm(ks[1], (BATCH, D), 1.0),
        "ctx": nrm(ks[2], (BATCH, CTX_LEN, D), 1.0),
        "c_ctx": nrm(ks[3], (D,), 1.0),
        "w_ada": nrm(ks[4], (L, D, 6 * D), 0.5 * D ** -0.5),
        "b_ada": nrm(ks[5], (L, 6 * D), 0.02),
        "norm1_g": 1.0 + nrm(ks[6], (L, D), 0.1),
        "norm2_g": 1.0 + nrm(ks[7], (L, D), 0.1),
        "w_in": nrm(ks[8], (L, D, IN_W), D ** -0.5),
        "qnorm_a": 1.0 + nrm(ks[9], (L, HEAD_DIM), 0.1),
        "knorm_a": 1.0 + nrm(ks[10], (L, HEAD_DIM), 0.1),
        "sink_a": nrm(ks[11], (L, A_KV_HEADS, A_GROUP), 0.5),
        "qnorm_b": 1.0 + nrm(ks[12], (L, HEAD_DIM), 0.1),
        "knorm_b": 1.0 + nrm(ks[13], (L, HEAD_DIM), 0.1),
        "lam_q1": nrm(ks[14], (L, HEAD_DIM), 0.1),
        "lam_k1": nrm(ks[15], (L, HEAD_DIM), 0.1),
        "lam_q2": nrm(ks[16], (L, HEAD_DIM), 0.1),
        "lam_k2": nrm(ks[17], (L, HEAD_DIM), 0.1),
        "subln_g": 1.0 + nrm(ks[18], (L, B_V_DIM), 0.1),
        "w_pa": nrm(ks[19], (L, A_WIDTH, D), A_WIDTH ** -0.5),
        "w_pb": nrm(ks[20], (L, B_WIDTH, D), B_WIDTH ** -0.5),
        "w_o": nrm(ks[21], (L, D, D), D ** -0.5),
        "w_router": nrm(ks[22], (L, D, N_EXPERTS), D ** -0.5),
        "router_bias": nrm(ks[23], (L, N_EXPERTS), 0.01),
        "w_gate_e": nrm(ks[24], (L, N_EXPERTS, D, D_EXPERT), D ** -0.5),
        "w_up_e": nrm(ks[25], (L, N_EXPERTS, D, D_EXPERT), D ** -0.5),
        "w_down_e": nrm(ks[26], (L, N_EXPERTS, D_EXPERT, D), D_EXPERT ** -0.5),
        "w_gate_s": nrm(ks[27], (L, D, D_EXPERT), D ** -0.5),
        "w_up_s": nrm(ks[28], (L, D, D_EXPERT), D ** -0.5),
        "w_down_s": nrm(ks[29], (L, D_EXPERT, D), D_EXPERT ** -0.5),
    }


def reference(x, c, ctx, c_ctx, w_ada, b_ada, norm1_g, norm2_g, w_in, qnorm_a, knorm_a, sink_a,
              qnorm_b, knorm_b, lam_q1, lam_k1, lam_q2, lam_k2, subln_g, w_pa, w_pb, w_o,
              w_router, router_bias, w_gate_e, w_up_e, w_down_e, w_gate_s, w_up_s, w_down_s):
    B, n, D = x.shape
    cos, sin = rope_tables(n)
    for l in range(DEPTH):
        update_ctx = l < DEPTH - 1
        lam_init = 0.8 - 0.6 * math.exp(-0.3 * l)
        lam = (jnp.exp(jnp.sum(lam_q1[l].astype(jnp.float32) * lam_k1[l].astype(jnp.float32)))
               - jnp.exp(jnp.sum(lam_q2[l].astype(jnp.float32) * lam_k2[l].astype(jnp.float32)))
               + lam_init)
        p = {
            'w_in': w_in[l], 'qnorm_a': qnorm_a[l], 'knorm_a': knorm_a[l], 'sink_a': sink_a[l],
            'qnorm_b': qnorm_b[l], 'knorm_b': knorm_b[l], 'lam': lam, 'subln_g': subln_g[l],
            'w_pa': w_pa[l], 'w_pb': w_pb[l], 'w_o': w_o[l],
            'w_router': w_router[l], 'router_bias': router_bias[l],
            'w_gate_e': w_gate_e[l], 'w_up_e': w_up_e[l], 'w_down_e': w_down_e[l],
            'w_gate_s': w_gate_s[l], 'w_up_s': w_up_s[l], 'w_down_s': w_down_s[l],
        }
        mod = (jax.nn.silu(c) @ w_ada[l] + b_ada[l])[:, None, :]
        mod_c = jax.nn.silu(c_ctx) @ w_ada[l] + b_ada[l]
        sh1, sc1, g1, sh2, sc2, g2 = jnp.split(mod, 6, axis=-1)
        csh1, csc1, cg1, csh2, csc2, cg2 = jnp.split(mod_c, 6, axis=-1)

        h = rms_norm(x, norm1_g[l]) * (1.0 + sc1) + sh1
        hc = rms_norm(ctx, norm1_g[l]) * (1.0 + csc1) + csh1
        mix, mix_c = token_mixers(h, hc, cos, sin, p, lam_init, update_ctx)
        x = x + g1 * mix
        h2 = rms_norm(x, norm2_g[l]) * (1.0 + sc2) + sh2
        if update_ctx:
            ctx = ctx + cg1 * mix_c
            h2c = rms_norm(ctx, norm2_g[l]) * (1.0 + csc2) + csh2
            y = moe(jnp.concatenate([h2.reshape(-1, D), h2c.reshape(-1, D)], axis=0), p)
            x = x + g2 * y[:B * n].reshape(B, n, D)
            ctx = ctx + cg2 * y[B * n:].reshape(ctx.shape)
        else:
            x = x + g2 * moe(h2.reshape(-1, D), p).reshape(B, n, D)
    return x
```

```cpp
#include <hip/hip_runtime.h>
#include <cstdio>
#include <cstdint>

#ifndef MK_ONE_LAUNCH
#define MK_ONE_LAUNCH 1
#endif

#define GAS __attribute__((address_space(1)))
#define LAS __attribute__((address_space(3)))
typedef unsigned short bf16_t;
typedef short bf16x8 __attribute__((ext_vector_type(8)));
typedef short s16x4 __attribute__((ext_vector_type(4)));
typedef float f32x4 __attribute__((ext_vector_type(4)));
typedef float f32x2 __attribute__((ext_vector_type(2)));
typedef float f32x16 __attribute__((ext_vector_type(16)));
typedef unsigned u32x4 __attribute__((ext_vector_type(4)));
typedef unsigned u32x2 __attribute__((ext_vector_type(2)));

constexpr int DM = 1024, NBATCH = 8, SEQ = 8192, CTXL = 256;
constexpr int T = NBATCH * SEQ;
constexpr int TC = NBATCH * CTXL;
constexpr int TT = T + TC;
constexpr int INW = 6400;
constexpr int NEXP = 256, NE1 = 257;
constexpr int DEXP = 256;
constexpr float EPSN = 1e-6f;
constexpr float QSCALE = 0.125f * 1.4426950408889634f;
constexpr int NSLOT = 9;
constexpr int PMAX = T * NSLOT + 256 * 256;

constexpr size_t MiB = 1u << 20;
constexpr size_t WS_CTL = 0, CTL_BYTES = 2 * MiB;
constexpr size_t WS_WIN = 2 * MiB;
constexpr size_t WS_WPAB = 15 * MiB;
constexpr size_t WS_WO = 19 * MiB;
constexpr size_t WS_WR = 21 * MiB;
constexpr size_t WS_ROPE = 22 * MiB;
constexpr size_t WS_SCAL = 22 * MiB + 65536;
constexpr size_t WS_TEXP = 22 * MiB + 131072;
constexpr size_t WS_MOD = 22 * MiB + 262144;
constexpr size_t WS_IDX = 23 * MiB;
constexpr size_t WS_WTS = 25 * MiB;
constexpr size_t WS_RNK = 27 * MiB;
constexpr size_t WS_WGB = 29 * MiB;
constexpr size_t WS_RTOK = 30 * MiB;
constexpr size_t WS_RW = 33 * MiB;
constexpr size_t WS_RDST = 36 * MiB;
constexpr size_t WS_H = 40 * MiB;
constexpr size_t WS_Q = 172 * MiB;
constexpr size_t WS_KVA = 428 * MiB;
constexpr size_t WS_KB = 461 * MiB;
constexpr size_t WS_VB = 593 * MiB;
constexpr size_t WS_G = 725 * MiB;
constexpr size_t WS_ACT = 40 * MiB;
constexpr size_t WS_X1 = 360 * MiB;
constexpr size_t WS_WDS = 488 * MiB;
constexpr size_t WS_WGU = 489 * MiB;
constexpr size_t WS_H2 = 746 * MiB;
constexpr size_t WS_LT = 874 * MiB;
constexpr size_t WS_Y2 = 489 * MiB;
constexpr size_t WS_END = 1066 * MiB;
static_assert(WS_Y2 + ((size_t)T * NSLOT + 1) * 1024 <= WS_END, "Y2 overlay");
static_assert(WS_ACT + (size_t)PMAX * 512 <= WS_X1 && WS_X1 + (size_t)T * 2048 <= WS_WDS && WS_WDS + (size_t)1024 * 512 <= WS_WGU && WS_WGU + (size_t)NE1 * 512 * 2048 <= WS_H2, "moe map");
static_assert(WS_RTOK + (size_t)PMAX * 4 <= WS_RW && WS_RW + (size_t)PMAX * 4 <= WS_RDST && WS_RDST + (size_t)PMAX * 4 <= WS_H, "routing map");

constexpr int CW_TMO = 0;
constexpr int CW_BAR = 4096;
constexpr int CW_CNT = 16384;
constexpr int CW_MOD = 32768;
static_assert((CW_MOD + 9 * 6144) * 4 <= (int)CTL_BYTES, "ctl");

constexpr int RING_BYTES = 131072;
constexpr int LDSCTL_OFF = RING_BYTES, MISC_OFF = LDSCTL_OFF + 320;
constexpr int LDS_BYTES = 163840;

#define LDS_WAIT() asm volatile("s_waitcnt lgkmcnt(0)" ::: "memory")
#define VM_WAIT() asm volatile("s_waitcnt vmcnt(0)" ::: "memory")
__device__ __forceinline__ unsigned cvt_pk_bf16(float lo, float hi) { unsigned r; asm volatile("v_cvt_pk_bf16_f32 %0, %1, %2" : "=v"(r) : "v"(lo), "v"(hi)); return r; }
__device__ __forceinline__ float bf_lo(unsigned w) { return __uint_as_float(w << 16); }
__device__ __forceinline__ float bf_hi(unsigned w) { return __uint_as_float(w & 0xffff0000u); }
__device__ __forceinline__ float wave_sum(float v) {
#pragma unroll
    for (int o = 1; o < 64; o <<= 1) v += __shfl_xor(v, o);
    return v;
}
__device__ __forceinline__ int lane_id() { int l; asm volatile("v_mbcnt_lo_u32_b32 %0, -1, 0\n\tv_mbcnt_hi_u32_b32 %0, -1, %0" : "=v"(l)); return l; }
__device__ __forceinline__ float sigmoidf_(float x) { return __builtin_amdgcn_rcpf(1.0f + __builtin_amdgcn_exp2f(x * -1.4426950408889634f)); }

#define XB_TMO      128
#define XB_XCNT(j)  (256  + 64 * (j))
#define XB_XSUB(j)  (1280 + 64 * (j))
#define XB_XGEN(j)  (2304 + 64 * (j))
#define XB_TOP      3328
#define XB_TOPGEN   3392
#define XCD_BAR_WORDS 3456
#define XB_SPIN_CAP (1u << 18)
__device__ __forceinline__ unsigned xb_ld(unsigned* p)              { return __hip_atomic_load(p, __ATOMIC_RELAXED, __HIP_MEMORY_SCOPE_AGENT); }
__device__ __forceinline__ unsigned xb_add(unsigned* p, unsigned v) { return __hip_atomic_fetch_add(p, v, __ATOMIC_RELAXED, __HIP_MEMORY_SCOPE_AGENT); }
__device__ __forceinline__ unsigned xb_xcc_id() { return (unsigned)__builtin_amdgcn_s_getreg((3 << 11) | 20) & 0xFu; }
#define XB_SPIN(cond, bar) do { unsigned _sp = 0; while (cond) { __builtin_amdgcn_s_sleep(1); \
    if ((++_sp & 255u) == 0u) { if (xb_ld(&(bar)[XB_TMO])) break; if (_sp > XB_SPIN_CAP) { atomicAdd(&(bar)[XB_TMO], 1u); break; } } } } while (0)
struct XcdBarrier { unsigned* bar; unsigned x; volatile LAS unsigned* st; };
__device__ __forceinline__ XcdBarrier xcd_barrier_post(unsigned* bar, volatile LAS unsigned* st, bool leader) {
    XcdBarrier b; b.bar = bar; b.x = xb_xcc_id(); b.st = st;
    if (leader) (void)xb_add(&bar[XB_XCNT(b.x)], 1u);
    return b;
}
__device__ __forceinline__ void xcd_barrier_complete(unsigned* bar, unsigned x, unsigned& nloc, unsigned& nx) {
    const unsigned G = gridDim.x * gridDim.y * gridDim.z;
    unsigned sum, cnt, mine, sp = 0u;
    for (;;) {
        sum = 0u; cnt = 0u; mine = 0u;
#pragma unroll
        for (unsigned j = 0; j < 16; ++j) { const unsigned c = xb_ld(&bar[XB_XCNT(j)]); sum += c; cnt += (c > 0u) ? 1u : 0u; mine = (j == x) ? c : mine; }
        if (sum == G) break;
        __builtin_amdgcn_s_sleep(1);
        if ((++sp & 255u) == 0u) { if (xb_ld(&bar[XB_TMO])) break; if (sp > XB_SPIN_CAP) { atomicAdd(&bar[XB_TMO], 1u); break; } }
    }
    nloc = mine > 0u ? mine : 1u; nx = cnt > 0u ? cnt : 1u;
}
__device__ __forceinline__ void xcd_barrier(const XcdBarrier& b, bool leader) {
    asm volatile("s_waitcnt vmcnt(0)" ::: "memory");
    __syncthreads();
    if (leader) {
        unsigned* bar = b.bar;
        __builtin_amdgcn_s_waitcnt(0);
        unsigned nloc = b.st[0], nx = b.st[1];
        if (nloc == 0u) { xcd_barrier_complete(bar, b.x, nloc, nx); b.st[0] = nloc; b.st[1] = nx; }
        const unsigned old = xb_add(&bar[XB_XSUB(b.x)], 1u);
        const unsigned gen = old / nloc;
        if (old + 1u == (gen + 1u) * nloc) {
            __builtin_amdgcn_fence(__ATOMIC_RELEASE, "agent");
            asm volatile("s_waitcnt vmcnt(0)" ::: "memory");
            const unsigned og = xb_add(&bar[XB_TOP], 1u);
            const unsigned tg = og / nx;
            if (og + 1u == (tg + 1u) * nx) xb_add(&bar[XB_TOPGEN], 1u);
            else XB_SPIN(xb_ld(&bar[XB_TOPGEN]) == tg, bar);
            __builtin_amdgcn_fence(__ATOMIC_ACQUIRE, "agent");
            xb_add(&bar[XB_XGEN(b.x)], 1u);
            asm volatile("s_waitcnt vmcnt(0)" ::: "memory");
        } else {
            XB_SPIN(xb_ld(&bar[XB_XGEN(b.x)]) == gen, bar);
            __builtin_amdgcn_fence(__ATOMIC_ACQUIRE, "agent");
            asm volatile("s_waitcnt vmcnt(0)" ::: "memory");
        }
    }
    __syncthreads();
}

__device__ __forceinline__ void glds16_sv(const void* sbase, unsigned voff, unsigned lds_dst) { unsigned keep;
    asm volatile("s_mov_b32 %0, m0\n\ts_mov_b32 m0, %3\n\ts_nop 0\n\tglobal_load_lds_dwordx4 %1, %2\n\ts_mov_b32 m0, %0" : "=&s"(keep) : "v"(voff), "s"(sbase), "s"(lds_dst) : "memory"); }
namespace pg8 {
constexpr int BM = 256, BK = 64, HALF = 128, HTB = HALF * BK * 2, STAGE_BYTES = 8 * HTB;
__host__ __device__ __forceinline__ int lds_byte(int r, int c) { const int st = (r >> 4) * 2 + (c >> 5), rr = r & 15, cc = c & 31, ob = rr * 64 + cc * 2; return st * 1024 + (ob ^ (((ob >> 9) & 1) << 5)); }
__host__ __device__ __forceinline__ void stage_rc(int b, int& R, int& C) { const int st = b / 1024, sb = b % 1024, swz = sb ^ (((sb >> 9) & 1) << 5); R = (st >> 1) * 16 + swz / 64; C = (st & 1) * 32 + (swz % 64) / 2; }

struct Unit { const char* A; const char* B; const int* tok; int pm, pn, x0; };

template <class Epi, class Sched, bool ALIGN_EPI, bool GATHER>
__device__ __forceinline__ void gemm_phase(LAS unsigned char* lds, const int K, const Sched& S, const Epi& E, const int wid) {
    const int lane = lane_id(), tid = wid * 64 + lane, wr = wid >> 2, wc = wid & 3, fr = lane & 15, fq = lane >> 4;
    const int nt = K / BK;
    unsigned voffA[2], voffB[2]; int RA[2], CA[2];
#pragma unroll
    for (int i = 0; i < 2; ++i) { int R, C; stage_rc(tid * 16 + i * 8192, R, C); RA[i] = R; CA[i] = C; voffA[i] = (unsigned)(R * K + C) * 2u; voffB[i] = voffA[i]; }
    const size_t kstep = (size_t)(BK * 2);
    const size_t hstep = (size_t)HALF * K * 2;
    const unsigned ldsw = (unsigned)wid * 1024u;
    const unsigned ldsb = (unsigned)(uintptr_t)lds + ldsw;
    const int aoff = lds_byte(wr * 64 + fr, fq * 8), boff = lds_byte(wc * 32 + fr, fq * 8);
#define PG8_SA(b, h) (((b) * 2 + (h)) * HTB)
#define PG8_SB(b, h) ((4 + (b) * 2 + (h)) * HTB)
#define PG8_STAGE(bufoff, gbase, voff) do { _Pragma("unroll") for (int _i = 0; _i < 2; ++_i) \
        glds16_sv((const void*)(gbase), (voff)[_i], ldsb + (unsigned)((bufoff) + _i * 8192)); } while (0)
#define PG8_LDA(dst, b, h) do { _Pragma("unroll") for (int m = 0; m < 4; ++m) _Pragma("unroll") for (int k = 0; k < 2; ++k) dst[m][k] = *(const LAS bf16x8*)(lds + PG8_SA(b, h) + aoff + m * 2048 + k * 1024); } while (0)
#define PG8_LDB(dst, b, h) do { _Pragma("unroll") for (int n = 0; n < 2; ++n) _Pragma("unroll") for (int k = 0; k < 2; ++k) dst[n][k] = *(const LAS bf16x8*)(lds + PG8_SB(b, h) + boff + n * 2048 + k * 1024); } while (0)
#define PG8_MMA(ai, bj, At, Bt) do { __builtin_amdgcn_s_setprio(1); _Pragma("unroll") for (int m = 0; m < 4; ++m) _Pragma("unroll") for (int n = 0; n < 2; ++n) _Pragma("unroll") for (int k = 0; k < 2; ++k) \
        acc[ai][bj][m][n] = __builtin_amdgcn_mfma_f32_16x16x32_bf16(Bt[n][k], At[m][k], acc[ai][bj][m][n], 0, 0, 0); __builtin_amdgcn_s_setprio(0); } while (0)
#define PG8_WAIT_V(n) asm volatile("s_waitcnt vmcnt(" #n ")" ::: "memory")
#define PG8_WAIT_L(n) asm volatile("s_waitcnt lgkmcnt(" #n ")" ::: "memory")
#define PG8_BAR __builtin_amdgcn_s_barrier()
#define PG8_SCHED __builtin_amdgcn_sched_barrier(0)
    Unit cur, nxt; int ui = 0;
    if (!S.next(0, cur)) return;
    f32x4 acc[2][2][4][2];
#pragma unroll
    for (int a = 0; a < 2; ++a)
#pragma unroll
        for (int b = 0; b < 2; ++b)
#pragma unroll
            for (int m = 0; m < 4; ++m)
#pragma unroll
                for (int n = 0; n < 2; ++n) acc[a][b][m][n] = (f32x4){0.f, 0.f, 0.f, 0.f};
    bf16x8 At[4][2], B0[2][2], B1[2][2];
    const char *cA0, *cA1, *nA0, *nA1; const char* cB = cur.B; const char* nB;
    unsigned cv0[2] = {0u, 0u}, cv1[2] = {0u, 0u}, nv0[2] = {0u, 0u}, nv1[2] = {0u, 0u};
#define PG8_SEL(g) { GATHER ? (g)[0] : voffA[0], GATHER ? (g)[1] : voffA[1] }
    if constexpr (GATHER) {
        cA0 = cur.A; cA1 = cur.A;
#pragma unroll
        for (int i = 0; i < 2; ++i) { cv0[i] = (unsigned)cur.tok[RA[i]] * (unsigned)(K * 2) + (unsigned)CA[i] * 2u; cv1[i] = (unsigned)cur.tok[HALF + RA[i]] * (unsigned)(K * 2) + (unsigned)CA[i] * 2u; }
    } else {
        cA0 = cur.A; cA1 = cur.A + hstep;
    }
    { const unsigned p0_[2] = PG8_SEL(cv0), p1_[2] = PG8_SEL(cv1);
    PG8_STAGE(PG8_SB(0, 0), cB, voffB); PG8_STAGE(PG8_SB(0, 1), cB + hstep, voffB); PG8_STAGE(PG8_SA(0, 0), cA0, p0_); PG8_STAGE(PG8_SA(0, 1), cA1, p1_);
    if (wr == 1) PG8_BAR;
    PG8_WAIT_V(2); PG8_BAR;
    PG8_STAGE(PG8_SB(1, 0), cB + kstep, voffB); PG8_STAGE(PG8_SA(1, 0), cA0 + kstep, p0_); PG8_STAGE(PG8_SB(1, 1), cB + hstep + kstep, voffB); }
    PG8_WAIT_V(6); PG8_BAR;
    for (;;) {
        const bool has_next = S.next(ui + 1, nxt);
        if (has_next) {
            nB = nxt.B;
            if constexpr (GATHER) {
                nA0 = nxt.A; nA1 = nxt.A;
#pragma unroll
                for (int i = 0; i < 2; ++i) { nv0[i] = (unsigned)nxt.tok[RA[i]] * (unsigned)(K * 2) + (unsigned)CA[i] * 2u; nv1[i] = (unsigned)nxt.tok[HALF + RA[i]] * (unsigned)(K * 2) + (unsigned)CA[i] * 2u; }
            } else {
                nA0 = nxt.A; nA1 = nxt.A + hstep;
            }
        } else {
            nB = cB; nA0 = cA0; nA1 = cA1;
            if constexpr (GATHER) {
#pragma unroll
                for (int i = 0; i < 2; ++i) { nv0[i] = cv0[i]; nv1[i] = cv1[i]; } }
        }
#pragma unroll 1
        for (int t = 0; t < nt; t += 2) {
            const bool last = (t == nt - 2);
            if constexpr (Epi::HAS_MID) { if (t == nt / 2) E.mid(acc, cur, wr, wc, fr, fq); }
            const char* a1h1 = cA1 + (size_t)(t + 1) * kstep;
            const char* a2h0 = last ? nA0 : cA0 + (size_t)(t + 2) * kstep;
            const char* a2h1 = last ? nA1 : cA1 + (size_t)(t + 2) * kstep;
            const char* b2 = last ? nB : cB + (size_t)(t + 2) * kstep;
            const char* a3h0 = a2h0 + kstep; const char* b3 = b2 + kstep;
            const unsigned x0[2] = { GATHER ? (last ? nv0[0] : cv0[0]) : voffA[0], GATHER ? (last ? nv0[1] : cv0[1]) : voffA[1] };
            const unsigned x1[2] = { GATHER ? (last ? nv1[0] : cv1[0]) : voffA[0], GATHER ? (last ? nv1[1] : cv1[1]) : voffA[1] };
            const unsigned c1_[2] = PG8_SEL(cv1);
            PG8_LDB(B0, 0, 0); PG8_LDB(B1, 0, 1); PG8_SCHED; PG8_LDA(At, 0, 0); PG8_STAGE(PG8_SA(1, 1), a1h1, c1_);
            PG8_WAIT_V(8); PG8_WAIT_L(0); PG8_BAR; PG8_MMA(0, 0, At, B0); PG8_MMA(0, 1, At, B1); PG8_BAR; PG8_SCHED;
            PG8_LDA(At, 0, 1); PG8_STAGE(PG8_SB(0, 0), b2, voffB); PG8_STAGE(PG8_SB(0, 1), b2 + hstep, voffB); PG8_STAGE(PG8_SA(0, 0), a2h0, x0);
            PG8_WAIT_V(8); PG8_WAIT_L(0); PG8_BAR; PG8_MMA(1, 0, At, B0); PG8_MMA(1, 1, At, B1); PG8_BAR; PG8_SCHED;
            PG8_LDB(B0, 1, 0); PG8_LDB(B1, 1, 1); PG8_SCHED; PG8_LDA(At, 1, 0); PG8_STAGE(PG8_SA(0, 1), a2h1, x1);
            PG8_WAIT_V(8); PG8_WAIT_L(0); PG8_BAR; PG8_MMA(0, 0, At, B0); PG8_MMA(0, 1, At, B1); PG8_BAR; PG8_SCHED;
            PG8_LDA(At, 1, 1); PG8_STAGE(PG8_SB(1, 0), b3, voffB); PG8_STAGE(PG8_SB(1, 1), b3 + hstep, voffB); PG8_STAGE(PG8_SA(1, 0), a3h0, x0);
            PG8_WAIT_V(8); PG8_WAIT_L(0); PG8_BAR; PG8_MMA(1, 0, At, B0); PG8_MMA(1, 1, At, B1); PG8_BAR; PG8_SCHED;
        }
        if constexpr (ALIGN_EPI) { if (wr == 0) PG8_BAR; }
        if constexpr (!Epi::AFTER_DRAIN) { E(acc, cur, wr, wc, fr, fq); }
        if (!has_next) break;
#pragma unroll
        for (int a = 0; a < 2; ++a)
#pragma unroll
            for (int b = 0; b < 2; ++b)
#pragma unroll
                for (int m = 0; m < 4; ++m)
#pragma unroll
                    for (int n = 0; n < 2; ++n) acc[a][b][m][n] = (f32x4){0.f, 0.f, 0.f, 0.f};
        cur = nxt; cA0 = nA0; cA1 = nA1; cB = nB; ++ui;
        if constexpr (GATHER) {
#pragma unroll
            for (int i = 0; i < 2; ++i) { cv0[i] = nv0[i]; cv1[i] = nv1[i]; } }
        if constexpr (ALIGN_EPI) { if (wr == 1) PG8_BAR; }
    }
    PG8_WAIT_V(0);
    if constexpr (!ALIGN_EPI) { if (wr == 0) PG8_BAR; }
    PG8_BAR;
    if constexpr (Epi::AFTER_DRAIN) { E.fused(acc, cur, wr, wc, fr, fq, lds, wid, lane); }
#undef PG8_SA
#undef PG8_SB
#undef PG8_STAGE
#undef PG8_LDA
#undef PG8_LDB
#undef PG8_MMA
#undef PG8_WAIT_V
#undef PG8_WAIT_L
#undef PG8_BAR
#undef PG8_SCHED
#undef PG8_SEL
}

struct SchedMN {
    int nM, nN, nwg, G, c, K; const char* A; const char* B;
    __device__ __forceinline__ bool next(int i, Unit& u) const {
        const long L = (long)i * G + c; if (L >= nwg) return false;
        int wgid = (int)L; { const int q = nwg / 8, r = nwg % 8, xcd = wgid % 8, off = wgid / 8; wgid = (xcd < r ? xcd * (q + 1) : r * (q + 1) + (xcd - r) * q) + off; }
        const int nig = 8 * nN, gid = wgid / nig, fm = gid * 8, gsz = (nM - fm) < 8 ? (nM - fm) : 8;
        u.pm = fm + ((wgid % nig) % gsz); u.pn = (wgid % nig) / gsz;
        u.A = A + (size_t)u.pm * 256 * K * 2; u.B = B + (size_t)u.pn * 256 * K * 2; u.tok = nullptr; u.x0 = 0; return true;
    }
};
}

using pg8::Unit;
__host__ __device__ __forceinline__ int inv32(int p) { return 16 * ((p >> 2) & 1) + 4 * (p >> 3) + (p & 3); }

struct EpiP1 {
    static constexpr bool AFTER_DRAIN = false, HAS_MID = false;
    bf16_t *KVA, *KB, *VB, *Q, *G; const float *qna, *kna, *qnb, *knb; const float* rope; int skip;
    __device__ __forceinline__ void operator()(const f32x4 (&acc)[2][2][4][2], const Unit& u, int wr, int wc, int fr, int fq) const {
        if (skip == 1) { if (acc[0][0][0][0][0] == 1.2345e-30f) KVA[0] = 0; return; }
        const int pn = u.pn; const int row0 = u.pm * 256 + wr * 64 + fr;
        int kind;
        bf16_t* dst; int ld; int coloff; const float* gain = nullptr; float qs = 1.0f;
        if (pn == 0) { dst = KVA; ld = 256; coloff = 0; if (wc < 2) { kind = 0; gain = kna; } else kind = 3; }
        else if (pn < 5) { dst = KB; ld = 1024; coloff = 256 * (pn - 1); kind = 0; gain = knb; }
        else if (pn < 9) { dst = VB; ld = 1024; coloff = 256 * (pn - 5); kind = 1; }
        else if (pn < 13) { dst = Q; ld = 2048; coloff = 256 * (pn - 9); kind = 0; gain = qna; qs = QSCALE; }
        else if (pn < 17) { dst = Q; ld = 2048; coloff = 1024 + 256 * (pn - 13); kind = 0; gain = qnb; qs = QSCALE; }
        else { dst = G; ld = 2048; coloff = 256 * (pn - 17); kind = 2; }
        if (kind == 0) {
            const bool latent = u.pm < 256;
            f32x4 g[2][2];
#pragma unroll
            for (int bj = 0; bj < 2; ++bj)
#pragma unroll
                for (int n = 0; n < 2; ++n) g[bj][n] = *(const f32x4*)(gain + 32 * bj + 16 * n + 4 * fq);
            f32x4 cA[2], sA[2], cB[4], sB[4];
            if (latent) {
#pragma unroll
                for (int ai = 0; ai < 2; ++ai) { const int pos = ((row0 + ai * 128) & (SEQ - 1)) >> 6; cA[ai] = *(const f32x4*)(rope + pos * 16 + 4 * fq); sA[ai] = *(const f32x4*)(rope + 2048 + pos * 16 + 4 * fq); }
#pragma unroll
                for (int m = 0; m < 4; ++m) { const int pos = (row0 + m * 16) & 63; cB[m] = *(const f32x4*)(rope + pos * 16 + 4 * fq); sB[m] = *(const f32x4*)(rope + 2048 + pos * 16 + 4 * fq); }
            }
#pragma unroll
            for (int ai = 0; ai < 2; ++ai)
#pragma unroll
                for (int m = 0; m < 4; ++m) {
                    const int row = row0 + ai * 128 + m * 16;
                    float ss = 0.f;
#pragma unroll
                    for (int bj = 0; bj < 2; ++bj)
#pragma unroll
                        for (int n = 0; n < 2; ++n) { const f32x4 v = acc[ai][bj][m][n]; ss += (v[0] * v[0] + v[1] * v[1]) + (v[2] * v[2] + v[3] * v[3]); }
                    ss += __shfl_xor(ss, 16); ss += __shfl_xor(ss, 32);
                    const float rs = rsqrtf(ss * (1.0f / 64.0f) + EPSN) * qs;
#pragma unroll
                    for (int bj = 0; bj < 2; ++bj) {
                        f32x4 y0 = acc[ai][bj][m][0] * rs * g[bj][0], y1 = acc[ai][bj][m][1] * rs * g[bj][1];
                        f32x4 o0 = y0, o1 = y1;
                        if (latent) {
                            const f32x4 cs = (bj == 0) ? cA[ai] : cB[m], sn = (bj == 0) ? sA[ai] : sB[m];
                            o0 = y0 * cs - y1 * sn; o1 = y1 * cs + y0 * sn;
                        }
                        u32x4 w; w.x = cvt_pk_bf16(o0[0], o0[1]); w.y = cvt_pk_bf16(o0[2], o0[3]); w.z = cvt_pk_bf16(o1[0], o1[1]); w.w = cvt_pk_bf16(o1[2], o1[3]);
                        if (skip != 2 || w.x == 0x12345678u) *(u32x4*)(dst + (size_t)row * ld + coloff + 64 * wc + 32 * bj + 8 * fq) = w;
                    }
                    asm volatile("" ::: "memory");
                }
        } else {
#pragma unroll
            for (int ai = 0; ai < 2; ++ai)
#pragma unroll
                for (int m = 0; m < 4; ++m) {
                    const int row = row0 + ai * 128 + m * 16;
#pragma unroll
                    for (int bj = 0; bj < 2; ++bj) {
                        f32x4 v0 = acc[ai][bj][m][0], v1 = acc[ai][bj][m][1];
                        if (kind == 2) {
#pragma unroll
                            for (int i = 0; i < 4; ++i) { v0[i] = sigmoidf_(v0[i]); v1[i] = sigmoidf_(v1[i]); }
                        }
                        const int col = coloff + 64 * wc + 32 * bj + 8 * fq;
                        u32x4 w; w.x = cvt_pk_bf16(v0[0], v0[1]); w.y = cvt_pk_bf16(v0[2], v0[3]); w.z = cvt_pk_bf16(v1[0], v1[1]); w.w = cvt_pk_bf16(v1[2], v1[3]);
                        if (skip != 2 || w.x == 0x12345678u) *(u32x4*)(dst + (size_t)row * ld + col) = w;
                    }
                }
        }
    }
};

struct EpiZ {
    static constexpr bool AFTER_DRAIN = false, HAS_MID = true;
    const bf16_t* G; bf16_t* Z;
    __device__ __forceinline__ void mid(f32x4 (&acc)[2][2][4][2], const Unit& u, int wr, int wc, int fr, int fq) const {
        const int row0 = u.pm * 256 + wr * 64 + fr, col0 = u.pn * 256 + wc * 64 + 8 * fq;
        u32x4 gq[3][4];
#define ZM_LOAD(i_, B_) do { const bf16_t* gp_ = G + (size_t)(row0 + ((i_) >> 2) * 128 + ((i_) & 3) * 16) * 2048 + col0; \
        gq[B_][0] = *(const u32x4*)gp_; gq[B_][1] = *(const u32x4*)(gp_ + 1024); gq[B_][2] = *(const u32x4*)(gp_ + 32); gq[B_][3] = *(const u32x4*)(gp_ + 1024 + 32); } while (0)
        ZM_LOAD(0, 0); ZM_LOAD(1, 1);
#pragma unroll
        for (int i = 0; i < 8; ++i) {
            if (i + 2 < 8) ZM_LOAD(i + 2, (i + 2) % 3);
            const int ai = i >> 2, m = i & 3;
#pragma unroll
            for (int bj = 0; bj < 2; ++bj) {
                const u32x4 a = gq[i % 3][2 * bj], b = gq[i % 3][2 * bj + 1];
                f32x4 r0, r1;
                r0[0] = bf_lo(a.x) * __builtin_amdgcn_rcpf(fmaxf(bf_lo(b.x), 1e-30f)); r0[1] = bf_hi(a.x) * __builtin_amdgcn_rcpf(fmaxf(bf_hi(b.x), 1e-30f)); r0[2] = bf_lo(a.y) * __builtin_amdgcn_rcpf(fmaxf(bf_lo(b.y), 1e-30f)); r0[3] = bf_hi(a.y) * __builtin_amdgcn_rcpf(fmaxf(bf_hi(b.y), 1e-30f));
                r1[0] = bf_lo(a.z) * __builtin_amdgcn_rcpf(fmaxf(bf_lo(b.z), 1e-30f)); r1[1] = bf_hi(a.z) * __builtin_amdgcn_rcpf(fmaxf(bf_hi(b.z), 1e-30f)); r1[2] = bf_lo(a.w) * __builtin_amdgcn_rcpf(fmaxf(bf_lo(b.w), 1e-30f)); r1[3] = bf_hi(a.w) * __builtin_amdgcn_rcpf(fmaxf(bf_hi(b.w), 1e-30f));
                acc[ai][bj][m][0] *= r0; acc[ai][bj][m][1] *= r1;
            }
            asm volatile("" ::: "memory");
        }
#undef ZM_LOAD
    }
    __device__ __forceinline__ void operator()(const f32x4 (&acc)[2][2][4][2], const Unit& u, int wr, int wc, int fr, int fq) const {
        const int row0 = u.pm * 256 + wr * 64 + fr, col0 = u.pn * 256 + wc * 64 + 8 * fq;
        u32x4 gbv[2][4][2];
#pragma unroll
        for (int ai = 0; ai < 2; ++ai)
#pragma unroll
            for (int m = 0; m < 4; ++m)
#pragma unroll
                for (int bj = 0; bj < 2; ++bj) gbv[ai][m][bj] = *(const u32x4*)(G + (size_t)(row0 + ai * 128 + m * 16) * 2048 + 1024 + col0 + bj * 32);
#pragma unroll
        for (int ai = 0; ai < 2; ++ai)
#pragma unroll
            for (int m = 0; m < 4; ++m)
#pragma unroll
                for (int bj = 0; bj < 2; ++bj) {
                    const size_t off = (size_t)(row0 + ai * 128 + m * 16);
                    const u32x4 b = gbv[ai][m][bj];
                    const f32x4 v0 = acc[ai][bj][m][0], v1 = acc[ai][bj][m][1];
                    u32x4 w;
                    w.x = cvt_pk_bf16(v0[0] * fmaxf(bf_lo(b.x), 1e-30f), v0[1] * fmaxf(bf_hi(b.x), 1e-30f)); w.y = cvt_pk_bf16(v0[2] * fmaxf(bf_lo(b.y), 1e-30f), v0[3] * fmaxf(bf_hi(b.y), 1e-30f));
                    w.z = cvt_pk_bf16(v1[0] * fmaxf(bf_lo(b.z), 1e-30f), v1[1] * fmaxf(bf_hi(b.z), 1e-30f)); w.w = cvt_pk_bf16(v1[2] * fmaxf(bf_lo(b.w), 1e-30f), v1[3] * fmaxf(bf_hi(b.w), 1e-30f));
                    *(u32x4*)(Z + off * 1024 + col0 + bj * 32) = w;
                    if (bj == 1) asm volatile("" ::: "memory");
                }
    }
};

struct EpiX1 {
    static constexpr bool AFTER_DRAIN = false, HAS_MID = false;
    const float* x; bf16_t* x1; const float* modacc; const float* bada;
    __device__ __forceinline__ void operator()(const f32x4 (&acc)[2][2][4][2], const Unit& u, int wr, int wc, int fr, int fq) const {
        const int row0 = u.pm * 256 + wr * 64 + fr, col0 = u.pn * 256 + wc * 64 + 8 * fq;
        const int b = (u.pm * 256) >> 13;
        f32x4 g1[2][2];
#pragma unroll
        for (int bj = 0; bj < 2; ++bj)
#pragma unroll
            for (int n = 0; n < 2; ++n) { const int c = col0 + bj * 32 + n * 4; g1[bj][n] = *(const f32x4*)(modacc + b * 6144 + 2048 + c); }
        f32x4 xb[3][4];
#define X1_LOAD(i_, B_) do { const size_t off_ = (size_t)(row0 + ((i_) >> 2) * 128 + ((i_) & 3) * 16) * 1024 + col0; \
        xb[B_][0] = *(const f32x4*)(x + off_); xb[B_][1] = *(const f32x4*)(x + off_ + 4); xb[B_][2] = *(const f32x4*)(x + off_ + 32); xb[B_][3] = *(const f32x4*)(x + off_ + 36); } while (0)
        X1_LOAD(0, 0); X1_LOAD(1, 1);
#pragma unroll
        for (int i = 0; i < 8; ++i) {
            if (i + 2 < 8) X1_LOAD(i + 2, (i + 2) % 3);
            const int ai = i >> 2, m = i & 3;
            const size_t off = (size_t)(row0 + ai * 128 + m * 16) * 1024 + col0;
#pragma unroll
            for (int bj = 0; bj < 2; ++bj) {
                const f32x4 r0 = xb[i % 3][2 * bj] + g1[bj][0] * acc[ai][bj][m][0], r1 = xb[i % 3][2 * bj + 1] + g1[bj][1] * acc[ai][bj][m][1];
                u32x4 w; w.x = cvt_pk_bf16(r0[0], r0[1]); w.y = cvt_pk_bf16(r0[2], r0[3]); w.z = cvt_pk_bf16(r1[0], r1[1]); w.w = cvt_pk_bf16(r1[2], r1[3]);
                *(u32x4*)(x1 + off + bj * 32) = w;
            }
            asm volatile("" ::: "memory");
        }
#undef X1_LOAD
    }
};

struct EpiAct {
    static constexpr bool AFTER_DRAIN = false, HAS_MID = false;
    bf16_t* act; const float* rw;
    __device__ __forceinline__ void operator()(const f32x4 (&acc)[2][2][4][2], const Unit& u, int wr, int wc, int fr, int fq) const {
        const int row0 = u.pm * 256 + wr * 64 + fr, col0 = u.pn * 128 + wc * 32 + 8 * fq;
        float wv[2][4];
#pragma unroll
        for (int ai = 0; ai < 2; ++ai)
#pragma unroll
            for (int m = 0; m < 4; ++m) wv[ai][m] = rw[row0 + ai * 128 + m * 16];
#pragma unroll
        for (int ai = 0; ai < 2; ++ai)
#pragma unroll
            for (int m = 0; m < 4; ++m) {
                const int row = row0 + ai * 128 + m * 16;
                const float w = wv[ai][m];
                const f32x4 g0 = acc[ai][0][m][0], g1 = acc[ai][0][m][1], u0 = acc[ai][1][m][0], u1 = acc[ai][1][m][1];
                float a[8];
#pragma unroll
                for (int i = 0; i < 4; ++i) { a[i] = g0[i] * sigmoidf_(g0[i]) * u0[i] * w; a[4 + i] = g1[i] * sigmoidf_(g1[i]) * u1[i] * w; }
                u32x4 o; o.x = cvt_pk_bf16(a[0], a[1]); o.y = cvt_pk_bf16(a[2], a[3]); o.z = cvt_pk_bf16(a[4], a[5]); o.w = cvt_pk_bf16(a[6], a[7]);
                *(u32x4*)(act + (size_t)row * 256 + col0) = o;
            }
    }
};

struct EpiY2 {
    static constexpr bool AFTER_DRAIN = false, HAS_MID = false;
    unsigned char* Y2; const int* rdst;
    __device__ __forceinline__ void operator()(const f32x4 (&acc)[2][2][4][2], const Unit& u, int wr, int wc, int fr, int fq) const {
        const int row0 = u.pm * 256 + wr * 64 + fr, col0 = u.pn * 256 + wc * 64 + 16 * fq;
        int dv[2][4];
#pragma unroll
        for (int ai = 0; ai < 2; ++ai)
#pragma unroll
            for (int m = 0; m < 4; ++m) dv[ai][m] = rdst[row0 + ai * 128 + m * 16];
#pragma unroll
        for (int ai = 0; ai < 2; ++ai)
#pragma unroll
            for (int m = 0; m < 4; ++m) {
                const int d = dv[ai][m];
                u32x4 o;
#pragma unroll
                for (int bj = 0; bj < 2; ++bj) {
                    const f32x4 v0 = acc[ai][bj][m][0], v1 = acc[ai][bj][m][1];
                    int w0 = __builtin_amdgcn_cvt_pk_fp8_f32(v0[0], v0[1], 0, false); w0 = __builtin_amdgcn_cvt_pk_fp8_f32(v0[2], v0[3], w0, true);
                    int w1 = __builtin_amdgcn_cvt_pk_fp8_f32(v1[0], v1[1], 0, false); w1 = __builtin_amdgcn_cvt_pk_fp8_f32(v1[2], v1[3], w1, true);
                    if (bj == 0) { o.x = (unsigned)w0; o.y = (unsigned)w1; } else { o.z = (unsigned)w0; o.w = (unsigned)w1; }
                }
                *(u32x4*)(Y2 + (size_t)d * 1024 + col0) = o;
            }
    }
};

struct EpiRoute {
    static constexpr bool AFTER_DRAIN = true, HAS_MID = false;
    const float* rbias; int* idx; float* wts; int* rnk; int* wgb; unsigned* cnt;
    __device__ __forceinline__ void fused(const f32x4 (&acc)[2][2][4][2], const Unit& u, int wr, int wc, int fr, int fq, LAS unsigned char* lds, int wid, int lane) const {
        LAS float* sc = (LAS float*)lds;
        LAS unsigned* hist = (LAS unsigned*)(lds + 131072 + 1024);
        LAS float* xg = (LAS float*)(lds + 131072 + 2048);
        LAS float* mv = (LAS float*)(lds + 131072 + 6144);
        const int tid = wid * 64 + lane;
        if (tid < 256) hist[tid] = 0u;
#pragma unroll
        for (int ai = 0; ai < 2; ++ai) {
            __syncthreads();
#pragma unroll
            for (int m = 0; m < 4; ++m) { const int r = wr * 64 + m * 16 + fr;
#pragma unroll
                for (int bj = 0; bj < 2; ++bj)
#pragma unroll
                    for (int n = 0; n < 2; ++n)
#pragma unroll
                        for (int i = 0; i < 4; ++i) sc[(bj * 128 + wc * 32 + n * 16 + fq * 4 + i) * 128 + r] = acc[ai][bj][m][n][i]; }
            __syncthreads();
            const int row = tid & 127, half = (tid >> 7) & 1;
            float gs[4];
            if (tid < 256) {
#pragma unroll
                for (int g = 0; g < 4; ++g) { float m1 = -INFINITY, m2 = -INFINITY;
#pragma unroll 8
                    for (int j = 0; j < 32; ++j) { const int e = (half * 4 + g) * 32 + j; const float sg_ = sigmoidf_(sc[e * 128 + row]); sc[e * 128 + row] = sg_; const float b = sg_ + rbias[e]; if (b > m1) { m2 = m1; m1 = b; } else if (b > m2) m2 = b; }
                    gs[g] = m1 + m2; xg[row * 8 + half * 4 + g] = gs[g]; }
            }
            __syncthreads();
            float Lv[8]; int Li[8];
            if (tid < 256) {
                float ga[8];
#pragma unroll
                for (int h = 0; h < 8; ++h) ga[h] = xg[row * 8 + h];
#pragma unroll
                for (int k = 0; k < 8; ++k) { Lv[k] = -INFINITY; Li[k] = 0; }
#pragma unroll
                for (int g = 0; g < 4; ++g) { const int gg = half * 4 + g; int rank = 0;
#pragma unroll
                    for (int h = 0; h < 8; ++h) rank += (ga[h] > gs[g] || (ga[h] == gs[g] && h < gg)) ? 1 : 0;
                    if (rank < 4) {
#pragma unroll 1
                        for (int j = 0; j < 32; ++j) { const int e = gg * 32 + j; float v = sc[e * 128 + row] + rbias[e]; int ei = e;
#pragma unroll
                            for (int k = 0; k < 8; ++k) { if (v > Lv[k]) { const float tv = Lv[k]; const int ti = Li[k]; Lv[k] = v; Li[k] = ei; v = tv; ei = ti; } } } } }
                if (half == 1) {
#pragma unroll
                    for (int k = 0; k < 8; ++k) { mv[(row * 8 + k) * 2 + 0] = Lv[k]; ((LAS int*)mv)[(row * 8 + k) * 2 + 1] = Li[k]; } }
            }
            __syncthreads();
            if (tid < 128) {
#pragma unroll 1
                for (int q = 0; q < 8; ++q) { float v = mv[(row * 8 + q) * 2 + 0]; int ei = ((LAS int*)mv)[(row * 8 + q) * 2 + 1];
#pragma unroll
                    for (int k = 0; k < 8; ++k) { if (v > Lv[k]) { const float tv = Lv[k]; const int ti = Li[k]; Lv[k] = v; Li[k] = ei; v = tv; ei = ti; } } }
                float Ls[8]; float sum = 0.f;
#pragma unroll
                for (int k = 0; k < 8; ++k) { Ls[k] = sc[Li[k] * 128 + row]; sum += Ls[k]; }
                const float inv = 2.5f / sum;
                const int t = u.pm * 256 + ai * 128 + row;
#pragma unroll
                for (int k = 0; k < 8; ++k) { const unsigned rk = atomicAdd((unsigned*)&hist[Li[k]], 1u); idx[t * 8 + k] = Li[k]; wts[t * 8 + k] = Ls[k] * inv; rnk[t * 8 + k] = (int)rk; }
            }
        }
        __syncthreads();
        if (tid < 256) { const unsigned c = hist[tid]; unsigned base = 0u; if (c) base = atomicAdd(cnt + tid, c); wgb[u.pm * 256 + tid] = (int)base; }
        __syncthreads();
    }
};

namespace att {
#define SBAR() __builtin_amdgcn_sched_barrier(0)
__device__ __forceinline__ int crow(int r, int hi) { return (r & 3) + 8 * (r >> 2) + 4 * hi; }
constexpr float THR = 8.f;
__device__ __forceinline__ void partialSM(f32x16& p0, f32x16& p1, float& m_reg, float& alpha) {
    float pmax = p0[0];
#pragma unroll
    for (int r = 1; r < 16; ++r) pmax = fmaxf(pmax, p0[r]);
#pragma unroll
    for (int r = 0; r < 16; ++r) pmax = fmaxf(pmax, p1[r]);
    { auto rr = __builtin_amdgcn_permlane32_swap(__float_as_uint(pmax), __float_as_uint(pmax), false, false);
      pmax = fmaxf(__uint_as_float(rr[0]), __uint_as_float(rr[1])); }
    float mn;
    if (__builtin_expect(__all(pmax - m_reg <= THR), 1)) { mn = m_reg; alpha = 1.f; }
    else { mn = fmaxf(m_reg, pmax); alpha = __builtin_amdgcn_exp2f(m_reg - mn); m_reg = mn; }
#pragma unroll
    for (int r = 0; r < 16; ++r) { p0[r] -= mn; p1[r] -= mn; }
#pragma unroll
    for (int r = 0; r < 16; ++r) p0[r] = __builtin_amdgcn_exp2f(p0[r]);
}
__device__ __forceinline__ void finishSM(f32x16& p0, f32x16& p1, float alpha, float& l_reg, bf16x8& pa0, bf16x8& pa1, bf16x8& pa2, bf16x8& pa3) {
#pragma unroll
    for (int r = 0; r < 16; ++r) p1[r] = __builtin_amdgcn_exp2f(p1[r]);
    float ps = 0;
#pragma unroll
    for (int r = 0; r < 16; ++r) ps += p0[r];
#pragma unroll
    for (int r = 0; r < 16; ++r) ps += p1[r];
    { auto rr = __builtin_amdgcn_permlane32_swap(__float_as_uint(ps), __float_as_uint(ps), false, false);
      ps = __uint_as_float(rr[0]) + __uint_as_float(rr[1]); }
    l_reg = l_reg * alpha + ps;
#define PK4(P, BASE, OUT) do { unsigned a0 = cvt_pk_bf16(P[BASE + 0], P[BASE + 1]), a1 = cvt_pk_bf16(P[BASE + 2], P[BASE + 3]);   \
    unsigned b0 = cvt_pk_bf16(P[BASE + 4], P[BASE + 5]), b1 = cvt_pk_bf16(P[BASE + 6], P[BASE + 7]);                              \
    auto r0 = __builtin_amdgcn_permlane32_swap(a0, b0, false, false); auto r1 = __builtin_amdgcn_permlane32_swap(a1, b1, false, false); \
    u32x4 w = {r0[0], r1[0], r0[1], r1[1]}; OUT = *reinterpret_cast<bf16x8*>(&w); } while (0)
    PK4(p0, 0, pa0); PK4(p0, 8, pa1); PK4(p1, 0, pa2); PK4(p1, 8, pa3);
#undef PK4
}
template <int NCB> __device__ __forceinline__ int v_st(int k, int c) { const int kk = (k & ~0xC) | ((k & 4) << 1) | ((k & 8) >> 1); return ((kk >> 3) * NCB + (c >> 5)) * 512 + ((kk & 7) * 32 + (c & 31)) * 2; }
__device__ __forceinline__ int v_rd_base(int lane) { return ((lane & 3) << 3) | (((lane >> 2) & 3) << 6) | (((lane >> 4) & 1) << 5) | (((lane >> 5) & 1) << 8); }
template <int OFF> __device__ __forceinline__ s16x4 tr_read(int vb) { s16x4 r; asm volatile("ds_read_b64_tr_b16 %0, %1 offset:%2" : "=&v"(r) : "v"(vb), "i"(OFF) : "memory"); return r; }
template <int OFF> __device__ __forceinline__ s16x4 tr_fake(int vb) { s16x4 r; asm volatile("" : "=v"(r) : "v"(vb)); return r; }
template <int NCB, int D0> __device__ __forceinline__ void pv_one(f32x16& od, int vb, bf16x8 pa0, bf16x8 pa1, bf16x8 pa2, bf16x8 pa3) {
#define VOFF(ks, half) (((2 * (ks) + (half)) * NCB + D0) * 512)
    const s16x4 l0 = tr_read<VOFF(0, 0)>(vb), h0 = tr_read<VOFF(0, 1)>(vb), l1 = tr_read<VOFF(1, 0)>(vb), h1 = tr_read<VOFF(1, 1)>(vb);
    const s16x4 l2 = tr_read<VOFF(2, 0)>(vb), h2 = tr_read<VOFF(2, 1)>(vb), l3 = tr_read<VOFF(3, 0)>(vb), h3 = tr_read<VOFF(3, 1)>(vb);
#undef VOFF
    asm volatile("s_waitcnt lgkmcnt(0)" ::: "memory"); SBAR();
#define PK(L, H) (bf16x8){L[0], L[1], L[2], L[3], H[0], H[1], H[2], H[3]}
    od = __builtin_amdgcn_mfma_f32_32x32x16_bf16(pa0, PK(l0, h0), od, 0, 0, 0);
    od = __builtin_amdgcn_mfma_f32_32x32x16_bf16(pa1, PK(l1, h1), od, 0, 0, 0);
    od = __builtin_amdgcn_mfma_f32_32x32x16_bf16(pa2, PK(l2, h2), od, 0, 0, 0);
    od = __builtin_amdgcn_mfma_f32_32x32x16_bf16(pa3, PK(l3, h3), od, 0, 0, 0);
#undef PK
}

__device__ __forceinline__ void glds16(const void* gsrc, unsigned lds_dst) { unsigned keep;
    asm volatile("s_mov_b32 %0, m0\n\ts_mov_b32 m0, %2\n\ts_nop 0\n\tglobal_load_lds_dwordx4 %1, off\n\ts_mov_b32 m0, %0" : "=&s"(keep) : "v"(gsrc), "s"(lds_dst) : "memory"); }
__device__ __forceinline__ void glds16s(const void* sbase, unsigned voff, unsigned lds_dst) { unsigned keep;
    asm volatile("s_mov_b32 %0, m0\n\ts_mov_b32 m0, %3\n\ts_nop 0\n\tglobal_load_lds_dwordx4 %1, %2\n\ts_mov_b32 m0, %0" : "=&s"(keep) : "v"(voff), "s"(sbase), "s"(lds_dst) : "memory"); }
__device__ __forceinline__ float fadd_(float a, float b) { float r; asm("v_add_f32_e32 %0, %1, %2" : "=v"(r) : "v"(a), "v"(b)); return r; }
constexpr int B2_WS = 131072 + 4096;
constexpr int B_SHM_V = 16384, B_SHM_K = 16384;
#define KSWZB(row, colB) ((row) * 256 + ((colB) ^ (((row) & 7) << 4)))
__device__ __forceinline__ void qktB(f32x16& p0, f32x16& p1, const char* Ks, const bf16x8* qr, int r32, int hi, int map) {
    p0 = f32x16{}; p1 = f32x16{};
#pragma unroll
    for (int d0 = 0; d0 < 4; ++d0) { const int cb = ((map * 4 + d0) * 16 + hi * 8) * 2;
        const bf16x8 b0 = *reinterpret_cast<const bf16x8*>(Ks + KSWZB(r32, cb));
        const bf16x8 b1 = *reinterpret_cast<const bf16x8*>(Ks + KSWZB(32 + r32, cb));
        p0 = __builtin_amdgcn_mfma_f32_32x32x16_bf16(b0, qr[d0], p0, 0, 0, 0);
        p1 = __builtin_amdgcn_mfma_f32_32x32x16_bf16(b1, qr[d0], p1, 0, 0, 0); }
}
__device__ __forceinline__ void attnB_unit(const bf16_t* Qb, const bf16_t* __restrict__ KBp, const bf16_t* __restrict__ VBp, bf16_t* Ob, int b, int h, int qb, char* lds, float lam, const float* subg, const int wid) {
    const int lane = lane_id(), tid = wid * 64 + lane, r32 = lane & 31, hi = lane >> 5, map = wid >> 2, rg = wid & 3;
    char* V_lds = lds; char* K_lds = lds + 2 * B_SHM_V;
    float* ws = (float*)(lds + 2 * B_SHM_V + 2 * B_SHM_K) + wid * 64; float* li_l = ws; float* al_l = ws + 32;
    float m_reg = -1e30f, l_reg = 0; f32x16 o[4] = {}; bf16x8 qr[4];
    const size_t qrow = (size_t)b * SEQ + qb * 128 + rg * 32;
    const bf16_t* Qw = Qb + (qrow + r32) * 2048 + 1024 + h * 128 + map * 64 + hi * 8;
#pragma unroll
    for (int d0 = 0; d0 < 4; ++d0) qr[d0] = *reinterpret_cast<const bf16x8*>(Qw + d0 * 16);
    const int sr = tid >> 4, sc = (tid & 15) * 8, vst0 = v_st<4>(sr, sc), vst1 = v_st<4>(32 + sr, sc);
    const int vb0 = (int)(uintptr_t)V_lds + v_rd_base(lane);
    const bf16_t* Kh = KBp + h * 128 + sc; const bf16_t* Vh = VBp + h * 128 + sc;
    struct { bf16x8 vs0, vs1, ks0, ks1; } sr_[2];
#define ROWOF(tile) ((tile) < 128 ? (size_t)b * SEQ + (size_t)(tile) * 64 : (size_t)T + (size_t)b * CTXL + (size_t)((tile) - 128) * 64)
#define SLOAD(i, tile) do { const size_t r0_ = ROWOF(tile) + sr; sr_[i].vs0 = *(const bf16x8*)(Vh + r0_ * 1024); sr_[i].vs1 = *(const bf16x8*)(Vh + (r0_ + 32) * 1024); \
    sr_[i].ks0 = *(const bf16x8*)(Kh + r0_ * 1024); sr_[i].ks1 = *(const bf16x8*)(Kh + (r0_ + 32) * 1024); } while (0)
#define SWRITE(bu, i) do { *(bf16x8*)(V_lds + (bu) * B_SHM_V + vst0) = sr_[i].vs0; *(bf16x8*)(V_lds + (bu) * B_SHM_V + vst1) = sr_[i].vs1; const int kc = sc * 2; \
    *(bf16x8*)(K_lds + (bu) * B_SHM_K + KSWZB(sr, kc)) = sr_[i].ks0; *(bf16x8*)(K_lds + (bu) * B_SHM_K + KSWZB(32 + sr, kc)) = sr_[i].ks1; } while (0)
#define SWAIT() asm volatile("s_waitcnt vmcnt(4)" ::: "memory")
#define RESC(a) do { if (__any((a) < 1.f)) { if (hi == 0) al_l[r32] = (a); asm volatile("s_waitcnt lgkmcnt(0)" ::: "memory"); \
    _Pragma("unroll") for (int d = 0; d < 4; ++d) _Pragma("unroll") for (int r = 0; r < 16; ++r) o[d][r] *= al_l[crow(r, hi)]; } } while (0)
#define PVALL(vbx) do { pv_one<4, 0>(o[0], vbx, pa0, pa1, pa2, pa3); pv_one<4, 1>(o[1], vbx, pa0, pa1, pa2, pa3); pv_one<4, 2>(o[2], vbx, pa0, pa1, pa2, pa3); pv_one<4, 3>(o[3], vbx, pa0, pa1, pa2, pa3); } while (0)
    f32x16 pA0, pA1, pB0, pB1; float alA, alB; bf16x8 pa0, pa1, pa2, pa3; constexpr int NT = 132;
    SLOAD(0, 0); asm volatile("s_waitcnt vmcnt(0)" ::: "memory"); SWRITE(0, 0); __syncthreads();
    qktB(pA0, pA1, K_lds, qr, r32, hi, map); partialSM(pA0, pA1, m_reg, alA);
    SLOAD(1, 1); SLOAD(0, 2);
    SWAIT(); SWRITE(1, 1); __syncthreads();
    for (int j = 1; j + 1 < NT; j += 2) {
        SBAR(); qktB(pB0, pB1, K_lds + B_SHM_K, qr, r32, hi, map);
        finishSM(pA0, pA1, alA, l_reg, pa0, pa1, pa2, pa3); SBAR();
        SLOAD(1, j + 2); SBAR();
        PVALL(vb0); partialSM(pB0, pB1, m_reg, alB);
        __syncthreads(); SWAIT(); SWRITE(0, 0);
        RESC(alB); __syncthreads();
        SBAR(); qktB(pA0, pA1, K_lds, qr, r32, hi, map);
        finishSM(pB0, pB1, alB, l_reg, pa0, pa1, pa2, pa3); SBAR();
        if (j + 3 < NT) SLOAD(0, j + 3); SBAR();
        PVALL(vb0 + B_SHM_V); partialSM(pA0, pA1, m_reg, alA);
        __syncthreads(); SWAIT(); SWRITE(1, 1);
        RESC(alA); __syncthreads();
    }
    SBAR(); qktB(pB0, pB1, K_lds + B_SHM_K, qr, r32, hi, map);
    finishSM(pA0, pA1, alA, l_reg, pa0, pa1, pa2, pa3); SBAR();
    PVALL(vb0); partialSM(pB0, pB1, m_reg, alB);
    __syncthreads(); RESC(alB);
    finishSM(pB0, pB1, alB, l_reg, pa0, pa1, pa2, pa3); SBAR();
    PVALL(vb0 + B_SHM_V);
    if (hi == 0) li_l[r32] = l_reg; asm volatile("s_waitcnt lgkmcnt(0)" ::: "memory");
    float rli[16];
#pragma unroll
    for (int r = 0; r < 16; ++r) rli[r] = __builtin_amdgcn_rcpf(li_l[crow(r, hi)]);
    __syncthreads();
    float* X = (float*)lds + rg * 4096;
    if (map == 1) {
#pragma unroll
        for (int r = 0; r < 16; ++r)
#pragma unroll
            for (int d0 = 0; d0 < 4; ++d0) X[crow(r, hi) * 128 + d0 * 32 + r32] = o[d0][r] * rli[r] * lam;
    }
    __syncthreads();
    if (map == 0) {
        float sg[4];
#pragma unroll
        for (int d0 = 0; d0 < 4; ++d0) sg[d0] = subg[d0 * 32 + r32] * 0.8f;
        bf16_t* Ow = Ob + qrow * 2048 + 1024 + h * 128;
#pragma unroll
        for (int r = 0; r < 16; ++r) {
            float dv[4]; float ss = 0.f;
#pragma unroll
            for (int d0 = 0; d0 < 4; ++d0) { dv[d0] = o[d0][r] * rli[r] - X[crow(r, hi) * 128 + d0 * 32 + r32]; ss += dv[d0] * dv[d0]; }
#pragma unroll
            for (int s = 1; s < 32; s <<= 1) ss += __shfl_xor(ss, s);
            const float rs = rsqrtf(ss * (1.0f / 128.0f) + EPSN);
#pragma unroll
            for (int d0 = 0; d0 < 4; ++d0) { const unsigned w = cvt_pk_bf16(dv[d0] * rs * sg[d0], 0.f); Ow[(size_t)crow(r, hi) * 2048 + d0 * 32 + r32] = (bf16_t)(w & 0xffffu); }
        }
    }
    __syncthreads();
#undef ROWOF
#undef SLOAD
#undef SWRITE
#undef SWAIT
#undef RESC
#undef PVALL
}

constexpr int A_SHM = 8192;
#define KSWZA(row, chunk) ((row) * 128 + ((((chunk) ^ ((row) >> 1)) & 7) << 4))
__device__ __forceinline__ void qktA(f32x16& p0, f32x16& p1, const char* Ks, const bf16x8* qr, int r32, int hi) {
    p0 = f32x16{}; p1 = f32x16{};
#pragma unroll
    for (int d0 = 0; d0 < 4; ++d0) { const int ch = 2 * d0 + hi;
        const bf16x8 b0 = *reinterpret_cast<const bf16x8*>(Ks + KSWZA(r32, ch));
        const bf16x8 b1 = *reinterpret_cast<const bf16x8*>(Ks + KSWZA(32 + r32, ch));
        p0 = __builtin_amdgcn_mfma_f32_32x32x16_bf16(b0, qr[d0], p0, 0, 0, 0);
        p1 = __builtin_amdgcn_mfma_f32_32x32x16_bf16(b1, qr[d0], p1, 0, 0, 0); }
}
__device__ __forceinline__ void maskA(f32x16& p0, f32x16& p1, int tile, int t0, int r32, int hi) {
#pragma unroll
    for (int r = 0; r < 16; ++r) {
        const int v0 = 64 * tile + crow(r, hi), v1 = v0 + 32;
        { const int k = t0 - 384 + v0, d = t0 + r32 - k; const bool ok = (v0 < 544) && (k >= 0) && (k < SEQ) && (d <= 128) && (d >= -128); if (!ok) p0[r] = -INFINITY; }
        { const int k = t0 - 384 + v1, d = t0 + r32 - k; const bool ok = (v1 < 544) && (k >= 0) && (k < SEQ) && (d <= 128) && (d >= -128); if (!ok) p1[r] = -INFINITY; }
    }
}
__device__ __forceinline__ void attnA_unit(const bf16_t* Qb, const bf16_t* __restrict__ KVAp, bf16_t* Ob, int b, int kvh, int qb, char* lds, const float* sink, const int wid, const bool do_store = true) {
    const int lane = lane_id(), tid = wid * 64 + lane, r32 = lane & 31, hi = lane >> 5;
    char* V_lds = lds; char* K_lds = lds + 2 * A_SHM;
    float* ws = (float*)(lds + 4 * A_SHM) + wid * 64; float* li_l = ws; float* al_l = ws + 32;
    float m_reg = -1e30f, l_reg = 0; f32x16 o[2] = {}; bf16x8 qr[4];
    const int head = kvh * 8 + wid, t0 = qb * 32;
    const size_t qrow = (size_t)b * SEQ + t0;
    const bf16_t* Qw = Qb + (qrow + r32) * 2048 + head * 64 + hi * 8;
#pragma unroll
    for (int d0 = 0; d0 < 4; ++d0) qr[d0] = *reinterpret_cast<const bf16x8*>(Qw + d0 * 16);
    const int srow = tid >> 3, sch = tid & 7, vst = v_st<2>(srow, sch * 8), kst = KSWZA(srow, sch);
    const int vb0 = (int)(uintptr_t)V_lds + v_rd_base(lane);
    const bf16_t* KVh = KVAp + kvh * 64 + sch * 8;
    struct { bf16x8 vs, ks; } sr_[2];
#define ROWOFA(v) ((v) < 256 ? (size_t)T + (size_t)b * CTXL + (v) : ((v) < 544 ? (size_t)b * SEQ + (size_t)min(max(t0 - 384 + (v), 0), SEQ - 1) : (size_t)T + (size_t)b * CTXL))
#define SLOAD(i, tile) do { const int v_ = (tile) * 64 + srow; const size_t r0_ = ROWOFA(v_); sr_[i].ks = *(const bf16x8*)(KVh + r0_ * 256); sr_[i].vs = *(const bf16x8*)(KVh + r0_ * 256 + 128); } while (0)
#define SWRITE(bu, i) do { *(bf16x8*)(V_lds + (bu) * A_SHM + vst) = sr_[i].vs; *(bf16x8*)(K_lds + (bu) * A_SHM + kst) = sr_[i].ks; } while (0)
#define SWAIT() asm volatile("s_waitcnt vmcnt(2)" ::: "memory")
#define RESC(a) do { if (__any((a) < 1.f)) { if (hi == 0) al_l[r32] = (a); asm volatile("s_waitcnt lgkmcnt(0)" ::: "memory"); \
    _Pragma("unroll") for (int d = 0; d < 2; ++d) _Pragma("unroll") for (int r = 0; r < 16; ++r) o[d][r] *= al_l[crow(r, hi)]; } } while (0)
#define PVALL(vbx) do { pv_one<2, 0>(o[0], vbx, pa0, pa1, pa2, pa3); pv_one<2, 1>(o[1], vbx, pa0, pa1, pa2, pa3); } while (0)
    f32x16 pA0, pA1, pB0, pB1; float alA, alB; bf16x8 pa0, pa1, pa2, pa3; constexpr int NT = 10;
    SLOAD(0, 0); asm volatile("s_waitcnt vmcnt(0)" ::: "memory"); SWRITE(0, 0); __syncthreads();
    qktA(pA0, pA1, K_lds, qr, r32, hi); partialSM(pA0, pA1, m_reg, alA);
    SLOAD(1, 1); SLOAD(0, 2);
    SWAIT(); SWRITE(1, 1); __syncthreads();
    for (int j = 1; j + 1 < NT; j += 2) {
        SBAR(); qktA(pB0, pB1, K_lds + A_SHM, qr, r32, hi); if (j >= 4) maskA(pB0, pB1, j, t0, r32, hi);
        finishSM(pA0, pA1, alA, l_reg, pa0, pa1, pa2, pa3); SBAR();
        SLOAD(1, j + 2); SBAR();
        PVALL(vb0); partialSM(pB0, pB1, m_reg, alB);
        __syncthreads(); SWAIT(); SWRITE(0, 0);
        RESC(alB); __syncthreads();
        SBAR(); qktA(pA0, pA1, K_lds, qr, r32, hi); if (j + 1 >= 4) maskA(pA0, pA1, j + 1, t0, r32, hi);
        finishSM(pB0, pB1, alB, l_reg, pa0, pa1, pa2, pa3); SBAR();
        if (j + 3 < NT) SLOAD(0, j + 3); SBAR();
        PVALL(vb0 + A_SHM); partialSM(pA0, pA1, m_reg, alA);
        __syncthreads(); SWAIT(); SWRITE(1, 1);
        RESC(alA); __syncthreads();
    }
    SBAR(); qktA(pB0, pB1, K_lds + A_SHM, qr, r32, hi); maskA(pB0, pB1, NT - 1, t0, r32, hi);
    finishSM(pA0, pA1, alA, l_reg, pa0, pa1, pa2, pa3); SBAR();
    PVALL(vb0); partialSM(pB0, pB1, m_reg, alB);
    __syncthreads(); RESC(alB);
    finishSM(pB0, pB1, alB, l_reg, pa0, pa1, pa2, pa3); SBAR();
    PVALL(vb0 + A_SHM);
    l_reg += __builtin_amdgcn_exp2f(sink[head] * 1.4426950408889634f - m_reg);
    if (hi == 0) li_l[r32] = l_reg; asm volatile("s_waitcnt lgkmcnt(0)" ::: "memory");
    bf16_t* Ow = Ob + qrow * 2048 + head * 64;
    if (do_store)
#pragma unroll
    for (int r = 0; r < 16; ++r) { const float rl = __builtin_amdgcn_rcpf(li_l[crow(r, hi)]);
#pragma unroll
        for (int d0 = 0; d0 < 2; ++d0) { const unsigned w = cvt_pk_bf16(o[d0][r] * rl, 0.f); Ow[(size_t)crow(r, hi) * 2048 + d0 * 32 + r32] = (bf16_t)(w & 0xffffu); } }
    __syncthreads();
#undef ROWOFA
#undef SLOAD
#undef SWRITE
#undef SWAIT
#undef RESC
#undef PVALL
}


template <int VAR> __device__ __forceinline__ void attnB6_unit(const bf16_t* Qb, const bf16_t* __restrict__ KBp, const bf16_t* __restrict__ VBp, bf16_t* Ob, int b, int h, int qb, char* lds, float lam, const float* subg, const int wid, const bool do_store) {
    const int lane = lane_id(), r32 = lane & 31, hi = lane >> 5;
    constexpr int SLOT = 8192, VRING = 4 * SLOT, QOFF = 8 * SLOT;
    float* li_l = (float*)(lds + B2_WS) + wid * 64;
    f32x16 o0[4] = {}, o1[4] = {};
    const size_t qrow = (size_t)b * SEQ + qb * 256 + wid * 32;
    const bf16_t* Qw = Qb + (qrow + r32) * 2048 + 1024 + h * 128 + hi * 8;
    const int q1a = (int)(uintptr_t)lds + QOFF + wid * 8192 + lane * 16;
#pragma unroll
    for (int d0 = 0; d0 < 8; ++d0) { const bf16x8 t_ = *reinterpret_cast<const bf16x8*>(Qw + d0 * 16); *reinterpret_cast<bf16x8*>(lds + QOFF + wid * 8192 + d0 * 1024 + lane * 16) = t_; }
    asm volatile("s_waitcnt lgkmcnt(0)" ::: "memory");
    unsigned koff, voff;
    { const int p = wid * 64 + lane;
      { const int row = p >> 4, cpos = p & 15, chunk = cpos ^ (row & 15); koff = (unsigned)(row * 2048 + h * 256 + chunk * 16); }
      { const int st = p >> 5, kk7 = (p >> 2) & 7, ch = p & 3, kk = (st >> 2) * 8 + kk7, k = (kk & ~0xC) | ((kk & 4) << 1) | ((kk & 8) >> 1), c = (st & 3) * 32 + ch * 8; voff = (unsigned)(k * 2048 + h * 256 + c * 2); } }
    const char* Kg = (const char*)KBp; const char* Vg = (const char*)VBp;
    const unsigned lds0 = (unsigned)(uintptr_t)lds;
    const unsigned kdst = lds0 + wid * 1024, vdst = lds0 + VRING + wid * 1024;
#define TBASE(tile) (((tile) < 256 ? (size_t)b * SEQ + (size_t)(tile) * 32 : (size_t)T + (size_t)b * CTXL + (size_t)((tile) - 256) * 32) * 2048)
#define DMA_K(tile) do { if (VAR == 1) break; glds16(Kg + TBASE(tile) + koff, kdst + (unsigned)(((tile) & 3) * SLOT)); } while (0)
#define DMA_V(tile) do { if (VAR == 1) break; glds16(Vg + TBASE(tile) + voff, vdst + (unsigned)(((tile) & 3) * SLOT)); } while (0)
#define BARV(N) do { if (VAR == 4) asm volatile("s_waitcnt vmcnt(" #N ") lgkmcnt(0)" ::: "memory"); else asm volatile("s_waitcnt vmcnt(" #N ") lgkmcnt(0)\n\ts_barrier" ::: "memory"); } while (0)
#define WAITL(N) asm volatile("s_waitcnt lgkmcnt(" #N ")" ::: "memory")
#define LDK(dst, addr, OFF) do { if (VAR == 6 || VAR == 7) { asm volatile("" : "=v"(dst)); } else asm volatile("ds_read_b128 %0, %1 offset:%2" : "=&v"(dst) : "v"(addr), "i"(OFF) : "memory"); } while (0)
    const int kbase = (int)lds0 + r32 * 256 + ((hi ^ (r32 & 15)) << 4);
    const int vbase = (int)(lds0 + VRING) + v_rd_base(lane);
    constexpr int NT = 264;
    f32x2 l0a = {0.f, 0.f}, l0b = {0.f, 0.f}, l1a = {0.f, 0.f}, l1b = {0.f, 0.f};
#define EX(v) ((VAR == 2) ? (v) * 0.5f : (VAR == 6) ? (v) : __builtin_amdgcn_exp2f(v))
#define PK4(P, BASE, OUT) do { if (VAR == 6 || VAR == 8) break; unsigned a0 = cvt_pk_bf16(P[BASE + 0], P[BASE + 1]), a1 = cvt_pk_bf16(P[BASE + 2], P[BASE + 3]);   \
    unsigned b0_ = cvt_pk_bf16(P[BASE + 4], P[BASE + 5]), b1_ = cvt_pk_bf16(P[BASE + 6], P[BASE + 7]);                              \
    auto r0 = __builtin_amdgcn_permlane32_swap(a0, b0_, false, false); auto r1 = __builtin_amdgcn_permlane32_swap(a1, b1_, false, false); \
    u32x4 w = {r0[0], r1[0], r0[1], r1[1]}; OUT = *reinterpret_cast<bf16x8*>(&w); } while (0)
#define LSUM2(la, lb, P, B) do { if (VAR == 6 || VAR == 8) break; const float t0_ = (P[B] + P[B + 1]) + (P[B + 2] + P[B + 3]), t1_ = (P[B + 4] + P[B + 5]) + (P[B + 6] + P[B + 7]); la[0] += t0_ + t1_; } while (0)
#define KRD(MP, kb_, k0_, k1_, k2_, k3_) do { LDK(k0_, (kb_) ^ (((MP) * 4 + 0) << 5), 0); LDK(k1_, (kb_) ^ (((MP) * 4 + 1) << 5), 0); LDK(k2_, (kb_) ^ (((MP) * 4 + 2) << 5), 0); LDK(k3_, (kb_) ^ (((MP) * 4 + 3) << 5), 0); } while (0)
#define QRD(MP, q0_, q1_, q2_, q3_) do { LDK(q0_, q1a, (MP) * 4096 + 0); LDK(q1_, q1a, (MP) * 4096 + 1024); LDK(q2_, q1a, (MP) * 4096 + 2048); LDK(q3_, q1a, (MP) * 4096 + 3072); } while (0)
#define QKMF(S_, k0_, k1_, k2_, k3_, q0_, q1_, q2_, q3_) do { \
    S_ = __builtin_amdgcn_mfma_f32_32x32x16_bf16(k0_, q0_, (f32x16){}, 0, 0, 0); S_ = __builtin_amdgcn_mfma_f32_32x32x16_bf16(k1_, q1_, S_, 0, 0, 0); \
    S_ = __builtin_amdgcn_mfma_f32_32x32x16_bf16(k2_, q2_, S_, 0, 0, 0); S_ = __builtin_amdgcn_mfma_f32_32x32x16_bf16(k3_, q3_, S_, 0, 0, 0); } while (0)
#define SMX_E(S_) do { _Pragma("unroll") for (int r = 0; r < 16; ++r) S_[r] = EX(S_[r]); } while (0)
#define SMX_P(S_, PA, LA, LB) do { PK4(S_, 0, PA[0]); PK4(S_, 8, PA[1]); LSUM2(LA, LB, S_, 0); LSUM2(LA, LB, S_, 8); } while (0)
#define QF0(d) qf0[d]
#define QF1(d) qf1[d]
#define TRR(OFF_, vbx__) ((VAR == 6 || VAR == 7) ? tr_fake<OFF_>(vbx__) : tr_read<OFF_>(vbx__))
#define VRD(pre, D0, vbx) const s16x4 pre##0 = TRR(((0 * 4 + D0) * 512), vbx), pre##1 = TRR(((1 * 4 + D0) * 512), vbx), pre##2 = TRR(((2 * 4 + D0) * 512), vbx), pre##3 = TRR(((3 * 4 + D0) * 512), vbx)
#define VF(pre, a, b_) ((bf16x8){pre##a[0], pre##a[1], pre##a[2], pre##a[3], pre##b_[0], pre##b_[1], pre##b_[2], pre##b_[3]})
#define PVM(pre, D0) do { \
    o0[D0] = __builtin_amdgcn_mfma_f32_32x32x16_bf16(pa0[0], VF(pre, 0, 1), o0[D0], 0, 0, 0); o1[D0] = __builtin_amdgcn_mfma_f32_32x32x16_bf16(pa1[0], VF(pre, 0, 1), o1[D0], 0, 0, 0); \
    o0[D0] = __builtin_amdgcn_mfma_f32_32x32x16_bf16(pa0[1], VF(pre, 2, 3), o0[D0], 0, 0, 0); o1[D0] = __builtin_amdgcn_mfma_f32_32x32x16_bf16(pa1[1], VF(pre, 2, 3), o1[D0], 0, 0, 0); } while (0)
#define PVM2(pre, D0, PO0, PO1) do { if (VAR == 3) break; \
    o0[D0] = __builtin_amdgcn_mfma_f32_32x32x16_bf16(PO0[0], VF(pre, 0, 1), o0[D0], 0, 0, 0); o1[D0] = __builtin_amdgcn_mfma_f32_32x32x16_bf16(PO1[0], VF(pre, 0, 1), o1[D0], 0, 0, 0); \
    o0[D0] = __builtin_amdgcn_mfma_f32_32x32x16_bf16(PO0[1], VF(pre, 2, 3), o0[D0], 0, 0, 0); o1[D0] = __builtin_amdgcn_mfma_f32_32x32x16_bf16(PO1[1], VF(pre, 2, 3), o1[D0], 0, 0, 0); } while (0)
#define VRD4(d0_, d1_, d2_, d3_, D0, vbx) do { d0_ = TRR(((0 * 4 + D0) * 512), vbx); d1_ = TRR(((1 * 4 + D0) * 512), vbx); d2_ = TRR(((2 * 4 + D0) * 512), vbx); d3_ = TRR(((3 * 4 + D0) * 512), vbx); } while (0)
    bf16x8 pa0[2], pa1[2];
    bf16x8 pk0, pk1, pk2, pk3, pq0, pq1, pq2, pq3;
    s16x4 va0, va1, va2, va3;
#define STEP5(j, HASPV, HASNEXT) do { \
    const int kcur_ = kbase + ((j) & 3) * SLOT, knxt_ = kbase + (((j) + 1) & 3) * SLOT, vbx_ = vbase + (((j) - 1) & 3) * SLOT, vnx_ = vbase + ((j) & 3) * SLOT; \
    f32x16 S0_, S1_; bf16x8 mk0, mk1, mk2, mk3, mq0, mq1, mq2, mq3; \
    SBAR(); \
    QKMF(S0_, pk0, pk1, pk2, pk3, pq0, pq1, pq2, pq3); SBAR(); \
    QRD(1, mq0, mq1, mq2, mq3); KRD(1, kcur_, mk0, mk1, mk2, mk3); \
    if (HASPV) { \
        s16x4 vb0, vb1, vb2, vb3; VRD4(vb0, vb1, vb2, vb3, 1, vbx_); SBAR(); \
        PVM2(va, 0, pa0, pa1); SBAR(); \
        WAITL(4); SBAR(); QKMF(S1_, mk0, mk1, mk2, mk3, mq0, mq1, mq2, mq3); SBAR(); \
        { s16x4 vc0, vc1, vc2, vc3; VRD4(vc0, vc1, vc2, vc3, 2, vbx_); WAITL(4); SBAR(); PVM2(vb, 1, pa0, pa1); SMX_E(S0_); SBAR(); \
          { s16x4 vd0, vd1, vd2, vd3; VRD4(vd0, vd1, vd2, vd3, 3, vbx_); WAITL(4); SBAR(); PVM2(vc, 2, pa0, pa1); SMX_E(S1_); SBAR(); \
            if (HASNEXT) { QRD(0, pq0, pq1, pq2, pq3); KRD(0, knxt_, pk0, pk1, pk2, pk3); } \
            if (HASNEXT) WAITL(8); else WAITL(0); \
            SBAR(); \
            LSUM2(l0a, l0b, S0_, 0); LSUM2(l0a, l0b, S0_, 8); LSUM2(l1a, l1b, S1_, 0); LSUM2(l1a, l1b, S1_, 8); \
            if (VAR != 3) { o0[3] = __builtin_amdgcn_mfma_f32_32x32x16_bf16(pa0[0], VF(vd, 0, 1), o0[3], 0, 0, 0); o1[3] = __builtin_amdgcn_mfma_f32_32x32x16_bf16(pa1[0], VF(vd, 0, 1), o1[3], 0, 0, 0); SBAR(); \
              o0[3] = __builtin_amdgcn_mfma_f32_32x32x16_bf16(pa0[1], VF(vd, 2, 3), o0[3], 0, 0, 0); PK4(S0_, 0, pa0[0]); SBAR(); \
              o1[3] = __builtin_amdgcn_mfma_f32_32x32x16_bf16(pa1[1], VF(vd, 2, 3), o1[3], 0, 0, 0); PK4(S1_, 0, pa1[0]); SBAR(); } \
            PK4(S0_, 8, pa0[1]); PK4(S1_, 8, pa1[1]); SBAR(); } } \
    } else { \
        WAITL(0); SBAR(); QKMF(S1_, mk0, mk1, mk2, mk3, mq0, mq1, mq2, mq3); SBAR(); \
        if (HASNEXT) { QRD(0, pq0, pq1, pq2, pq3); KRD(0, knxt_, pk0, pk1, pk2, pk3); } \
        SMX_E(S0_); SMX_E(S1_); SMX_P(S0_, pa0, l0a, l0b); SMX_P(S1_, pa1, l1a, l1b); SBAR(); } \
    VRD4(va0, va1, va2, va3, 0, vnx_); } while (0)
#define MF(acc_, a_, b_) acc_ = __builtin_amdgcn_mfma_f32_32x32x16_bf16(a_, b_, acc_, 0, 0, 0)
#define E2(S_, i_) do { S_[i_] = EX(S_[i_]); S_[(i_) + 1] = EX(S_[(i_) + 1]); } while (0)
#define SUM4(S_, i_) fadd_(fadd_(S_[i_], S_[(i_) + 1]), fadd_(S_[(i_) + 2], S_[(i_) + 3]))
#define STEP6(j) do { \
    const int kcur_ = kbase + ((j) & 3) * SLOT, knxt_ = kbase + (((j) + 1) & 3) * SLOT, vbx_ = vbase + (((j) - 1) & 3) * SLOT, vnx_ = vbase + ((j) & 3) * SLOT; \
    f32x16 S0_, S1_; bf16x8 mk0, mk1, mk2, mk3, mq0, mq1, mq2, mq3; s16x4 vb0, vb1, vb2, vb3, vc0, vc1, vc2, vc3, vd0, vd1, vd2, vd3; float a0_, a1_, a2_, a3_, b0_, b1_; \
    SBAR(); \
    S0_ = __builtin_amdgcn_mfma_f32_32x32x16_bf16(pk0, pq0, (f32x16){}, 0, 0, 0); LDK(mq0, q1a, 4096); LDK(mq1, q1a, 5120); SBAR(); \
    MF(S0_, pk1, pq1); LDK(mq2, q1a, 6144); LDK(mq3, q1a, 7168); SBAR(); \
    MF(S0_, pk2, pq2); LDK(mk0, kcur_ ^ (4 << 5), 0); LDK(mk1, kcur_ ^ (5 << 5), 0); SBAR(); \
    MF(S0_, pk3, pq3); LDK(mk2, kcur_ ^ (6 << 5), 0); LDK(mk3, kcur_ ^ (7 << 5), 0); SBAR(); \
    MF(o0[0], pa0[0], VF(va, 0, 1)); vb0 = TRR(((0 * 4 + 1) * 512), vbx_); vb1 = TRR(((1 * 4 + 1) * 512), vbx_); SBAR(); \
    MF(o1[0], pa1[0], VF(va, 0, 1)); vb2 = TRR(((2 * 4 + 1) * 512), vbx_); vb3 = TRR(((3 * 4 + 1) * 512), vbx_); SBAR(); \
    MF(o0[0], pa0[1], VF(va, 2, 3)); E2(S0_, 0); SBAR(); \
    MF(o1[0], pa1[1], VF(va, 2, 3)); E2(S0_, 2); SBAR(); \
    WAITL(4); SBAR(); \
    S1_ = __builtin_amdgcn_mfma_f32_32x32x16_bf16(mk0, mq0, (f32x16){}, 0, 0, 0); E2(S0_, 4); LDK(pk0, knxt_ ^ (0 << 5), 0); SBAR(); \
    MF(S1_, mk1, mq1); E2(S0_, 6); LDK(pk1, knxt_ ^ (1 << 5), 0); SBAR(); \
    MF(S1_, mk2, mq2); E2(S0_, 8); LDK(pk2, knxt_ ^ (2 << 5), 0); SBAR(); \
    MF(S1_, mk3, mq3); E2(S0_, 10); LDK(pk3, knxt_ ^ (3 << 5), 0); SBAR(); \
    WAITL(4); SBAR(); \
    MF(o0[1], pa0[0], VF(vb, 0, 1)); E2(S0_, 12); vc0 = TRR(((0 * 4 + 2) * 512), vbx_); vc1 = TRR(((1 * 4 + 2) * 512), vbx_); SBAR(); \
    MF(o1[1], pa1[0], VF(vb, 0, 1)); E2(S0_, 14); vc2 = TRR(((2 * 4 + 2) * 512), vbx_); vc3 = TRR(((3 * 4 + 2) * 512), vbx_); SBAR(); \
    MF(o0[1], pa0[1], VF(vb, 2, 3)); a0_ = SUM4(S0_, 0); LDK(pq0, q1a, 0); LDK(pq1, q1a, 1024); SBAR(); \
    MF(o1[1], pa1[1], VF(vb, 2, 3)); a1_ = SUM4(S0_, 4); LDK(pq2, q1a, 2048); LDK(pq3, q1a, 3072); SBAR(); \
    WAITL(4); SBAR(); \
    MF(o0[2], pa0[0], VF(vc, 0, 1)); E2(S1_, 0); vd0 = TRR(((0 * 4 + 3) * 512), vbx_); vd1 = TRR(((1 * 4 + 3) * 512), vbx_); SBAR(); \
    MF(o1[2], pa1[0], VF(vc, 0, 1)); E2(S1_, 2); vd2 = TRR(((2 * 4 + 3) * 512), vbx_); vd3 = TRR(((3 * 4 + 3) * 512), vbx_); SBAR(); \
    MF(o0[2], pa0[1], VF(vc, 2, 3)); E2(S1_, 4); a2_ = SUM4(S0_, 8); va0 = TRR(((0 * 4 + 0) * 512), vnx_); va1 = TRR(((1 * 4 + 0) * 512), vnx_); SBAR(); \
    MF(o1[2], pa1[1], VF(vc, 2, 3)); E2(S1_, 6); a3_ = SUM4(S0_, 12); va2 = TRR(((2 * 4 + 0) * 512), vnx_); va3 = TRR(((3 * 4 + 0) * 512), vnx_); SBAR(); \
    WAITL(4); SBAR(); \
    MF(o0[3], pa0[0], VF(vd, 0, 1)); E2(S1_, 8); l0a[0] += fadd_(fadd_(a0_, a1_), fadd_(a2_, a3_)); SBAR(); \
    MF(o1[3], pa1[0], VF(vd, 0, 1)); E2(S1_, 10); PK4(S0_, 0, pa0[0]); SBAR(); \
    MF(o0[3], pa0[1], VF(vd, 2, 3)); E2(S1_, 12); b0_ = SUM4(S1_, 0); SBAR(); \
    MF(o1[3], pa1[1], VF(vd, 2, 3)); E2(S1_, 14); PK4(S0_, 8, pa0[1]); b1_ = SUM4(S1_, 4); SBAR(); \
    PK4(S1_, 0, pa1[0]); PK4(S1_, 8, pa1[1]); l1a[0] += fadd_(fadd_(b0_, b1_), fadd_(SUM4(S1_, 8), SUM4(S1_, 12))); SBAR(); } while (0)
    DMA_K(0); DMA_V(0); DMA_K(1); DMA_V(1); DMA_K(2);
    BARV(1);
    QRD(0, pq0, pq1, pq2, pq3); KRD(0, kbase, pk0, pk1, pk2, pk3); WAITL(0);
    DMA_K(3); DMA_V(2);
    STEP5(0, 0, 1);
    BARV(2);
#pragma unroll 1
    for (int j = 1; j + 1 < NT; ++j) {
        if (j + 3 < NT) DMA_K(j + 3);
        if (j + 2 < NT) DMA_V(j + 2);
        if (VAR == 3) STEP5(j, 1, 1); else STEP6(j);
        if (j + 3 < NT) BARV(2); else BARV(0);
    }
    STEP5(NT - 1, 1, 0);
    BARV(0);
    { const int vbx_ = vbase + ((NT - 1) & 3) * SLOT;
      s16x4 vb0, vb1, vb2, vb3, vc0, vc1, vc2, vc3, vd0, vd1, vd2, vd3;
      VRD4(vb0, vb1, vb2, vb3, 1, vbx_); WAITL(4); SBAR(); PVM2(va, 0, pa0, pa1); SBAR();
      VRD4(vc0, vc1, vc2, vc3, 2, vbx_); WAITL(4); SBAR(); PVM2(vb, 1, pa0, pa1); SBAR();
      VRD4(vd0, vd1, vd2, vd3, 3, vbx_); WAITL(4); SBAR(); PVM2(vc, 2, pa0, pa1); SBAR(); WAITL(0); SBAR(); PVM2(vd, 3, pa0, pa1); SBAR(); }
    float l0 = (l0a[0] + l0a[1]) + (l0b[0] + l0b[1]), l1 = (l1a[0] + l1a[1]) + (l1b[0] + l1b[1]);
    { auto rr = __builtin_amdgcn_permlane32_swap(__float_as_uint(l0), __float_as_uint(l0), false, false); l0 = __uint_as_float(rr[0]) + __uint_as_float(rr[1]); }
    { auto rr = __builtin_amdgcn_permlane32_swap(__float_as_uint(l1), __float_as_uint(l1), false, false); l1 = __uint_as_float(rr[0]) + __uint_as_float(rr[1]); }
    if (hi == 0) { li_l[r32] = __builtin_amdgcn_rcpf(l0); li_l[32 + r32] = lam * __builtin_amdgcn_rcpf(l1); }
    asm volatile("s_waitcnt lgkmcnt(0)" ::: "memory");
    if (do_store) {
        float sg[4];
#pragma unroll
        for (int d0 = 0; d0 < 4; ++d0) sg[d0] = subg[d0 * 32 + r32] * 0.8f;
        bf16_t* Ow = Ob + qrow * 2048 + 1024 + h * 128;
#pragma unroll
        for (int r = 0; r < 16; ++r) {
            float dv[4]; float ss = 0.f; const float ra_ = li_l[crow(r, hi)], rb_ = li_l[32 + crow(r, hi)];
#pragma unroll
            for (int d0 = 0; d0 < 4; ++d0) { dv[d0] = o0[d0][r] * ra_ - o1[d0][r] * rb_; ss += dv[d0] * dv[d0]; }
#pragma unroll
            for (int s_ = 1; s_ < 32; s_ <<= 1) ss += __shfl_xor(ss, s_);
            const float rs = rsqrtf(ss * (1.0f / 128.0f) + EPSN);
#pragma unroll
            for (int d0 = 0; d0 < 4; ++d0) { const unsigned w = cvt_pk_bf16(dv[d0] * rs * sg[d0], 0.f); Ow[(size_t)crow(r, hi) * 2048 + d0 * 32 + r32] = (bf16_t)(w & 0xffffu); }
        }
    }
    BARV(0);
#undef TBASE
#undef DMA_K
#undef DMA_V
#undef BARV
#undef WAITL
#undef LDK
#undef EX
#undef PK4
#undef LSUM2
#undef KRD
#undef QRD
#undef QKMF
#undef VRD4
#undef STEP5
#undef STEP6
#undef MF
#undef E2
#undef SUM4
#undef SMX_E
#undef SMX_P
#undef PVM2
#undef STEP4
#undef QF0
#undef QF1
#undef VRD
#undef VF
#undef PVM
}
template <int VAR> __device__ __forceinline__ void attnB7_unit(const bf16_t* Qb, const bf16_t* __restrict__ KBp, const bf16_t* __restrict__ VBp, bf16_t* Ob, int b, int h, int qb, char* lds, float lam, const float* subg, const int wid, const bool do_store, const int nb, const int nh, const int nqb, const bool first, const bool has_next) {
    const int lane = lane_id(), r32 = lane & 31, hi = lane >> 5;
    constexpr int SLOT = 8192, VRING = 4 * SLOT, QOFF = 8 * SLOT;
    float* li_l = (float*)(lds + B2_WS) + wid * 64;
    f32x16 o0[4] = {}, o1[4] = {};
    const size_t qrow = (size_t)b * SEQ + qb * 256 + wid * 32;
    const int q1a = (int)(uintptr_t)lds + QOFF + wid * 8192 + lane * 16;
    unsigned koff, voff;
    { const int p = wid * 64 + lane;
      { const int row = p >> 4, cpos = p & 15, chunk = cpos ^ (row & 15); koff = (unsigned)(row * 2048 + chunk * 16); }
      { const int st = p >> 5, kk7 = (p >> 2) & 7, ch = p & 3, kk = (st >> 2) * 8 + kk7, k = (kk & ~0xC) | ((kk & 4) << 1) | ((kk & 8) >> 1), c = (st & 3) * 32 + ch * 8; voff = (unsigned)(k * 2048 + c * 2); } }
    const char* Kg = (const char*)KBp; const char* Vg = (const char*)VBp;
    const unsigned lds0 = (unsigned)(uintptr_t)lds;
    const unsigned kdst = lds0 + wid * 1024, vdst = lds0 + VRING + wid * 1024;
#define TB(bb_, hh_, tile) (((tile) < 256 ? (size_t)(bb_) * SEQ + (size_t)(tile) * 32 : (size_t)T + (size_t)(bb_) * CTXL + (size_t)((tile) - 256) * 32) * 2048 + (size_t)(hh_) * 256)
#define DMA_K(tile) do { if (VAR == 1) break; glds16s(Kg + TB(b, h, tile), koff, kdst + (unsigned)(((tile) & 3) * SLOT)); } while (0)
#define DMA_V(tile) do { if (VAR == 1) break; glds16s(Vg + TB(b, h, tile), voff, vdst + (unsigned)(((tile) & 3) * SLOT)); } while (0)
#define DMA_KN(tile) do { if (VAR == 1) break; glds16s(Kg + TB(nb, nh, tile), koff, kdst + (unsigned)(((tile) & 3) * SLOT)); } while (0)
#define DMA_VN(tile) do { if (VAR == 1) break; glds16s(Vg + TB(nb, nh, tile), voff, vdst + (unsigned)(((tile) & 3) * SLOT)); } while (0)
#define QDMA(bb_, hh_, qq_) do { const int lq_ = lane_id(); const bf16_t* qs_ = Qb + ((size_t)(bb_) * SEQ + (size_t)(qq_) * 256 + wid * 32) * 2048 + 1024 + (hh_) * 128; const unsigned qo_ = (unsigned)((lq_ & 31) * 4096 + (lq_ >> 5) * 16); \
    _Pragma("unroll") for (int d0 = 0; d0 < 8; ++d0) glds16s(qs_ + d0 * 16, qo_, lds0 + QOFF + wid * 8192 + d0 * 1024); } while (0)
#define BARV(N) do { if (VAR == 4) asm volatile("s_waitcnt vmcnt(" #N ") lgkmcnt(0)" ::: "memory"); else asm volatile("s_waitcnt vmcnt(" #N ") lgkmcnt(0)\n\ts_barrier" ::: "memory"); } while (0)
#define WAITL(N) asm volatile("s_waitcnt lgkmcnt(" #N ")" ::: "memory")
#define LDK(dst, addr, OFF) do { if (VAR == 6 || VAR == 7) { asm volatile("" : "=v"(dst)); } else asm volatile("ds_read_b128 %0, %1 offset:%2" : "=&v"(dst) : "v"(addr), "i"(OFF) : "memory"); } while (0)
    const int kbase = (int)lds0 + r32 * 256 + ((hi ^ (r32 & 15)) << 4);
    const int vbase = (int)(lds0 + VRING) + (((lane & 3) << 3) | (((lane >> 2) & 3) << 6) | (((lane >> 4) & 1) << 5) | ((lane >> 5) << 11));
    constexpr int NT = 264;
    f32x2 l0a = {0.f, 0.f}, l0b = {0.f, 0.f}, l1a = {0.f, 0.f}, l1b = {0.f, 0.f};
#define EX(v) ((VAR == 2) ? (v) * 0.5f : (VAR == 6) ? (v) : __builtin_amdgcn_exp2f(v))
#define PK4(P, BASE, OUT) do { if (VAR == 6 || VAR == 8) break; u32x4 w_ = {cvt_pk_bf16(P[BASE + 0], P[BASE + 1]), cvt_pk_bf16(P[BASE + 2], P[BASE + 3]), cvt_pk_bf16(P[BASE + 4], P[BASE + 5]), cvt_pk_bf16(P[BASE + 6], P[BASE + 7])}; OUT = *reinterpret_cast<bf16x8*>(&w_); } while (0)
#define LSUM2(la, lb, P, B) do { if (VAR == 6 || VAR == 8) break; const float t0_ = (P[B] + P[B + 1]) + (P[B + 2] + P[B + 3]), t1_ = (P[B + 4] + P[B + 5]) + (P[B + 6] + P[B + 7]); la[0] += t0_ + t1_; } while (0)
#define KRD(MP, kb_, k0_, k1_, k2_, k3_) do { LDK(k0_, (kb_) ^ (((MP) * 4 + 0) << 5), 0); LDK(k1_, (kb_) ^ (((MP) * 4 + 1) << 5), 0); LDK(k2_, (kb_) ^ (((MP) * 4 + 2) << 5), 0); LDK(k3_, (kb_) ^ (((MP) * 4 + 3) << 5), 0); } while (0)
#define QRD(MP, q0_, q1_, q2_, q3_) do { LDK(q0_, q1a, (MP) * 4096 + 0); LDK(q1_, q1a, (MP) * 4096 + 1024); LDK(q2_, q1a, (MP) * 4096 + 2048); LDK(q3_, q1a, (MP) * 4096 + 3072); } while (0)
#define QKMF(S_, k0_, k1_, k2_, k3_, q0_, q1_, q2_, q3_) do { \
    S_ = __builtin_amdgcn_mfma_f32_32x32x16_bf16(k0_, q0_, (f32x16){}, 0, 0, 0); S_ = __builtin_amdgcn_mfma_f32_32x32x16_bf16(k1_, q1_, S_, 0, 0, 0); \
    S_ = __builtin_amdgcn_mfma_f32_32x32x16_bf16(k2_, q2_, S_, 0, 0, 0); S_ = __builtin_amdgcn_mfma_f32_32x32x16_bf16(k3_, q3_, S_, 0, 0, 0); } while (0)
#define SMX_E(S_) do { _Pragma("unroll") for (int r = 0; r < 16; ++r) S_[r] = EX(S_[r]); } while (0)
#define SMX_P(S_, PA, LA, LB) do { PK4(S_, 0, PA[0]); PK4(S_, 8, PA[1]); LSUM2(LA, LB, S_, 0); LSUM2(LA, LB, S_, 8); } while (0)
#define QF0(d) qf0[d]
#define QF1(d) qf1[d]
#define TRR(OFF_, vbx__) ((VAR == 6 || VAR == 7) ? tr_fake<OFF_>(vbx__) : tr_read<OFF_>(vbx__))
#define VRD(pre, D0, vbx) const s16x4 pre##0 = TRR(((0 * 4 + D0) * 512 + 0), vbx), pre##1 = TRR(((0 * 4 + D0) * 512 + 256), vbx), pre##2 = TRR(((2 * 4 + D0) * 512 + 0), vbx), pre##3 = TRR(((2 * 4 + D0) * 512 + 256), vbx)
#define VF(pre, a, b_) ((bf16x8){pre##a[0], pre##a[1], pre##a[2], pre##a[3], pre##b_[0], pre##b_[1], pre##b_[2], pre##b_[3]})
#define PVM(pre, D0) do { \
    o0[D0] = __builtin_amdgcn_mfma_f32_32x32x16_bf16(VF(pre, 0, 1), pa0[0], o0[D0], 0, 0, 0); o1[D0] = __builtin_amdgcn_mfma_f32_32x32x16_bf16(VF(pre, 0, 1), pa1[0], o1[D0], 0, 0, 0); \
    o0[D0] = __builtin_amdgcn_mfma_f32_32x32x16_bf16(VF(pre, 2, 3), pa0[1], o0[D0], 0, 0, 0); o1[D0] = __builtin_amdgcn_mfma_f32_32x32x16_bf16(VF(pre, 2, 3), pa1[1], o1[D0], 0, 0, 0); } while (0)
#define PVM2(pre, D0, PO0, PO1) do { if (VAR == 3) break; \
    o0[D0] = __builtin_amdgcn_mfma_f32_32x32x16_bf16(VF(pre, 0, 1), PO0[0], o0[D0], 0, 0, 0); o1[D0] = __builtin_amdgcn_mfma_f32_32x32x16_bf16(VF(pre, 0, 1), PO1[0], o1[D0], 0, 0, 0); \
    o0[D0] = __builtin_amdgcn_mfma_f32_32x32x16_bf16(VF(pre, 2, 3), PO0[1], o0[D0], 0, 0, 0); o1[D0] = __builtin_amdgcn_mfma_f32_32x32x16_bf16(VF(pre, 2, 3), PO1[1], o1[D0], 0, 0, 0); } while (0)
#define VRD4(d0_, d1_, d2_, d3_, D0, vbx) do { d0_ = TRR(((0 * 4 + D0) * 512 + 0), vbx); d1_ = TRR(((0 * 4 + D0) * 512 + 256), vbx); d2_ = TRR(((2 * 4 + D0) * 512 + 0), vbx); d3_ = TRR(((2 * 4 + D0) * 512 + 256), vbx); } while (0)
    bf16x8 pa0[2], pa1[2];
    bf16x8 pk0, pk1, pk2, pk3, pq0, pq1, pq2, pq3;
    s16x4 va0, va1, va2, va3;
#define STEP5(j, HASPV, HASNEXT) do { \
    const int kcur_ = kbase + ((j) & 3) * SLOT, knxt_ = kbase + (((j) + 1) & 3) * SLOT, vbx_ = vbase + (((j) - 1) & 3) * SLOT, vnx_ = vbase + ((j) & 3) * SLOT; \
    f32x16 S0_, S1_; bf16x8 mk0, mk1, mk2, mk3, mq0, mq1, mq2, mq3; \
    SBAR(); \
    QKMF(S0_, pk0, pk1, pk2, pk3, pq0, pq1, pq2, pq3); SBAR(); \
    QRD(1, mq0, mq1, mq2, mq3); KRD(1, kcur_, mk0, mk1, mk2, mk3); \
    if (HASPV) { \
        s16x4 vb0, vb1, vb2, vb3; VRD4(vb0, vb1, vb2, vb3, 1, vbx_); SBAR(); \
        PVM2(va, 0, pa0, pa1); SBAR(); \
        WAITL(4); SBAR(); QKMF(S1_, mk0, mk1, mk2, mk3, mq0, mq1, mq2, mq3); SBAR(); \
        { s16x4 vc0, vc1, vc2, vc3; VRD4(vc0, vc1, vc2, vc3, 2, vbx_); WAITL(4); SBAR(); PVM2(vb, 1, pa0, pa1); SMX_E(S0_); SBAR(); \
          { s16x4 vd0, vd1, vd2, vd3; VRD4(vd0, vd1, vd2, vd3, 3, vbx_); WAITL(4); SBAR(); PVM2(vc, 2, pa0, pa1); SMX_E(S1_); SBAR(); \
            if (HASNEXT) { KRD(0, knxt_, pk0, pk1, pk2, pk3); } \
            if (HASNEXT) WAITL(4); else WAITL(0); \
            SBAR(); \
            LSUM2(l0a, l0b, S0_, 0); LSUM2(l0a, l0b, S0_, 8); LSUM2(l1a, l1b, S1_, 0); LSUM2(l1a, l1b, S1_, 8); \
            if (VAR != 3) { o0[3] = __builtin_amdgcn_mfma_f32_32x32x16_bf16(VF(vd, 0, 1), pa0[0], o0[3], 0, 0, 0); o1[3] = __builtin_amdgcn_mfma_f32_32x32x16_bf16(VF(vd, 0, 1), pa1[0], o1[3], 0, 0, 0); SBAR(); \
              o0[3] = __builtin_amdgcn_mfma_f32_32x32x16_bf16(VF(vd, 2, 3), pa0[1], o0[3], 0, 0, 0); PK4(S0_, 0, pa0[0]); SBAR(); \
              o1[3] = __builtin_amdgcn_mfma_f32_32x32x16_bf16(VF(vd, 2, 3), pa1[1], o1[3], 0, 0, 0); PK4(S1_, 0, pa1[0]); SBAR(); } \
            PK4(S0_, 8, pa0[1]); PK4(S1_, 8, pa1[1]); SBAR(); } } \
    } else { \
        WAITL(0); SBAR(); QKMF(S1_, mk0, mk1, mk2, mk3, mq0, mq1, mq2, mq3); SBAR(); \
        if (HASNEXT) { KRD(0, knxt_, pk0, pk1, pk2, pk3); } \
        SMX_E(S0_); SMX_E(S1_); SMX_P(S0_, pa0, l0a, l0b); SMX_P(S1_, pa1, l1a, l1b); SBAR(); } \
    VRD4(va0, va1, va2, va3, 0, vnx_); } while (0)
#define MF(acc_, a_, b_) acc_ = __builtin_amdgcn_mfma_f32_32x32x16_bf16(a_, b_, acc_, 0, 0, 0)
#define E2(S_, i_) do { S_[i_] = EX(S_[i_]); S_[(i_) + 1] = EX(S_[(i_) + 1]); } while (0)
#define SUM4(S_, i_) fadd_(fadd_(S_[i_], S_[(i_) + 1]), fadd_(S_[(i_) + 2], S_[(i_) + 3]))
#define STEP6(j) do { \
    const int kcur_ = kbase + ((j) & 3) * SLOT, knxt_ = kbase + (((j) + 1) & 3) * SLOT, vbx_ = vbase + (((j) - 1) & 3) * SLOT, vnx_ = vbase + ((j) & 3) * SLOT; \
    f32x16 S0_, S1_; bf16x8 mk0, mk1, mk2, mk3, mq0, mq1, mq2, mq3; s16x4 vb0, vb1, vb2, vb3, vc0, vc1, vc2, vc3, vd0, vd1, vd2, vd3; float a0_, a1_, a2_, a3_, b0_, b1_; \
    SBAR(); \
    S0_ = __builtin_amdgcn_mfma_f32_32x32x16_bf16(pk0, pq0, (f32x16){}, 0, 0, 0); LDK(mq0, q1a, 4096); LDK(mq1, q1a, 5120); SBAR(); \
    MF(S0_, pk1, pq1); LDK(mq2, q1a, 6144); LDK(mq3, q1a, 7168); SBAR(); \
    MF(S0_, pk2, pq2); LDK(mk0, kcur_ ^ (4 << 5), 0); LDK(mk1, kcur_ ^ (5 << 5), 0); SBAR(); \
    MF(S0_, pk3, pq3); LDK(mk2, kcur_ ^ (6 << 5), 0); LDK(mk3, kcur_ ^ (7 << 5), 0); SBAR(); \
    MF(o0[0], VF(va, 0, 1), pa0[0]); vb0 = TRR(((0 * 4 + 1) * 512 + 0), vbx_); vb1 = TRR(((0 * 4 + 1) * 512 + 256), vbx_); SBAR(); \
    MF(o1[0], VF(va, 0, 1), pa1[0]); vb2 = TRR(((2 * 4 + 1) * 512 + 0), vbx_); vb3 = TRR(((2 * 4 + 1) * 512 + 256), vbx_); SBAR(); \
    MF(o0[0], VF(va, 2, 3), pa0[1]); E2(S0_, 0); SBAR(); \
    MF(o1[0], VF(va, 2, 3), pa1[1]); E2(S0_, 2); SBAR(); \
    WAITL(4); SBAR(); \
    S1_ = __builtin_amdgcn_mfma_f32_32x32x16_bf16(mk0, mq0, (f32x16){}, 0, 0, 0); E2(S0_, 4); SBAR(); \
    MF(S1_, mk1, mq1); E2(S0_, 6); SBAR(); \
    MF(S1_, mk2, mq2); E2(S0_, 8); SBAR(); \
    MF(S1_, mk3, mq3); E2(S0_, 10); SBAR(); \
    WAITL(0); SBAR(); \
    MF(o0[1], VF(vb, 0, 1), pa0[0]); E2(S0_, 12); vc0 = TRR(((0 * 4 + 2) * 512 + 0), vbx_); vc1 = TRR(((0 * 4 + 2) * 512 + 256), vbx_); SBAR(); \
    MF(o1[1], VF(vb, 0, 1), pa1[0]); E2(S0_, 14); vc2 = TRR(((2 * 4 + 2) * 512 + 0), vbx_); vc3 = TRR(((2 * 4 + 2) * 512 + 256), vbx_); SBAR(); \
    MF(o0[1], VF(vb, 2, 3), pa0[1]); a0_ = SUM4(S0_, 0); LDK(pk0, knxt_ ^ (0 << 5), 0); LDK(pk1, knxt_ ^ (1 << 5), 0); SBAR(); \
    MF(o1[1], VF(vb, 2, 3), pa1[1]); a1_ = SUM4(S0_, 4); LDK(pk2, knxt_ ^ (2 << 5), 0); LDK(pk3, knxt_ ^ (3 << 5), 0); SBAR(); \
    WAITL(4); SBAR(); \
    MF(o0[2], VF(vc, 0, 1), pa0[0]); E2(S1_, 0); vd0 = TRR(((0 * 4 + 3) * 512 + 0), vbx_); vd1 = TRR(((0 * 4 + 3) * 512 + 256), vbx_); SBAR(); \
    MF(o1[2], VF(vc, 0, 1), pa1[0]); E2(S1_, 2); vd2 = TRR(((2 * 4 + 3) * 512 + 0), vbx_); vd3 = TRR(((2 * 4 + 3) * 512 + 256), vbx_); SBAR(); \
    MF(o0[2], VF(vc, 2, 3), pa0[1]); E2(S1_, 4); a2_ = SUM4(S0_, 8); va0 = TRR(((0 * 4 + 0) * 512 + 0), vnx_); va1 = TRR(((0 * 4 + 0) * 512 + 256), vnx_); SBAR(); \
    MF(o1[2], VF(vc, 2, 3), pa1[1]); E2(S1_, 6); a3_ = SUM4(S0_, 12); va2 = TRR(((2 * 4 + 0) * 512 + 0), vnx_); va3 = TRR(((2 * 4 + 0) * 512 + 256), vnx_); SBAR(); \
    WAITL(4); SBAR(); \
    MF(o0[3], VF(vd, 0, 1), pa0[0]); E2(S1_, 8); l0a[0] += fadd_(fadd_(a0_, a1_), fadd_(a2_, a3_)); SBAR(); \
    MF(o1[3], VF(vd, 0, 1), pa1[0]); E2(S1_, 10); PK4(S0_, 0, pa0[0]); SBAR(); \
    MF(o0[3], VF(vd, 2, 3), pa0[1]); E2(S1_, 12); b0_ = SUM4(S1_, 0); SBAR(); \
    MF(o1[3], VF(vd, 2, 3), pa1[1]); E2(S1_, 14); PK4(S0_, 8, pa0[1]); b1_ = SUM4(S1_, 4); SBAR(); \
    PK4(S1_, 0, pa1[0]); PK4(S1_, 8, pa1[1]); l1a[0] += fadd_(fadd_(b0_, b1_), fadd_(SUM4(S1_, 8), SUM4(S1_, 12))); SBAR(); } while (0)
    if (first) { QDMA(b, h, qb); DMA_K(0); DMA_V(0); DMA_K(1); DMA_V(1); DMA_K(2); BARV(1); }
    else BARV(0);
    QRD(0, pq0, pq1, pq2, pq3); KRD(0, kbase, pk0, pk1, pk2, pk3); WAITL(0);
    DMA_K(3); DMA_V(2);
    STEP5(0, 0, 1);
    BARV(2);
#pragma unroll 1
    for (int j = 1; j + 1 < NT; ++j) {
        if (j + 3 < NT) DMA_K(j + 3);
        if (j + 2 < NT) DMA_V(j + 2);
        if (VAR == 3) STEP5(j, 1, 1); else STEP6(j);
        if (j + 3 < NT) BARV(2); else BARV(0);
    }
    STEP5(NT - 1, 1, 0);
    BARV(0);
    if (has_next) { QDMA(nb, nh, nqb); DMA_KN(0); DMA_VN(0); DMA_KN(1); DMA_VN(1); DMA_KN(2); }
    { const int vbx_ = vbase + ((NT - 1) & 3) * SLOT;
      s16x4 vb0, vb1, vb2, vb3, vc0, vc1, vc2, vc3, vd0, vd1, vd2, vd3;
      VRD4(vb0, vb1, vb2, vb3, 1, vbx_); WAITL(4); SBAR(); PVM2(va, 0, pa0, pa1); SBAR();
      VRD4(vc0, vc1, vc2, vc3, 2, vbx_); WAITL(4); SBAR(); PVM2(vb, 1, pa0, pa1); SBAR();
      VRD4(vd0, vd1, vd2, vd3, 3, vbx_); WAITL(4); SBAR(); PVM2(vc, 2, pa0, pa1); SBAR(); WAITL(0); SBAR(); PVM2(vd, 3, pa0, pa1); SBAR(); }
    float l0 = (l0a[0] + l0a[1]) + (l0b[0] + l0b[1]), l1 = (l1a[0] + l1a[1]) + (l1b[0] + l1b[1]);
    { auto rr = __builtin_amdgcn_permlane32_swap(__float_as_uint(l0), __float_as_uint(l0), false, false); l0 = __uint_as_float(rr[0]) + __uint_as_float(rr[1]); }
    { auto rr = __builtin_amdgcn_permlane32_swap(__float_as_uint(l1), __float_as_uint(l1), false, false); l1 = __uint_as_float(rr[0]) + __uint_as_float(rr[1]); }
    (void)li_l;
    if (do_store) {
        const float ra_ = __builtin_amdgcn_rcpf(l0), rb_ = lam * __builtin_amdgcn_rcpf(l1);
        float ss = 0.f;
#pragma unroll
        for (int d0 = 0; d0 < 4; ++d0)
#pragma unroll
            for (int r = 0; r < 16; ++r) { const float dv = o0[d0][r] * ra_ - o1[d0][r] * rb_; o0[d0][r] = dv; ss += dv * dv; }
        { auto rr = __builtin_amdgcn_permlane32_swap(__float_as_uint(ss), __float_as_uint(ss), false, false); ss = __uint_as_float(rr[0]) + __uint_as_float(rr[1]); }
        const float rs = rsqrtf(ss * (1.0f / 128.0f) + EPSN) * 0.8f;
        const int le_ = lane_id(), r32e = le_ & 31, hie = le_ >> 5;
        bf16_t* Ow = Ob + (qrow + r32e) * 2048 + 1024 + h * 128 + 4 * hie;
#pragma unroll
        for (int d0 = 0; d0 < 4; ++d0)
#pragma unroll
            for (int r4 = 0; r4 < 4; ++r4) {
                const f32x4 sg = *(const f32x4*)(subg + d0 * 32 + r4 * 8 + 4 * hie);
                u32x2 w; w.x = cvt_pk_bf16(o0[d0][4 * r4] * rs * sg[0], o0[d0][4 * r4 + 1] * rs * sg[1]); w.y = cvt_pk_bf16(o0[d0][4 * r4 + 2] * rs * sg[2], o0[d0][4 * r4 + 3] * rs * sg[3]);
                *(u32x2*)(Ow + d0 * 32 + r4 * 8) = w;
            }
    }
    if (!has_next) BARV(0);
#undef TB
#undef DMA_KN
#undef DMA_VN
#undef QDMA
#undef DMA_K
#undef DMA_V
#undef BARV
#undef WAITL
#undef LDK
#undef EX
#undef PK4
#undef LSUM2
#undef KRD
#undef QRD
#undef QKMF
#undef VRD4
#undef STEP5
#undef STEP6
#undef MF
#undef E2
#undef SUM4
#undef SMX_E
#undef SMX_P
#undef PVM2
#undef STEP4
#undef QF0
#undef QF1
#undef VRD
#undef VF
#undef PVM
}

__device__ __forceinline__ void attnB8_unit(const bf16_t* Qb, const bf16_t* __restrict__ KBp, const bf16_t* __restrict__ VBp, bf16_t* Ob, int b, int h, int qb, char* lds, const float* lamp, const float* subg, const int wid, const bool do_store, const int nb, const int nh, const int nqb, const bool first, const bool has_next) {
    const int lane = lane_id(), r32 = lane & 31, hi = lane >> 5;
    const int mp = wid & 1, g = wid >> 1;
    constexpr int SLOT = 8192, VRING = 4 * SLOT, QOFF = 8 * SLOT;
    f32x16 o0[4] = {}, o1[4] = {};
    const size_t qrow = (size_t)b * SEQ + qb * 256 + g * 64;
    const int q1a = (int)(uintptr_t)lds + QOFF + wid * 8192 + lane * 16;
    unsigned koff, voff;
    { const int p = wid * 64 + lane;
      { const int row = p >> 4, cpos = p & 15, chunk = cpos ^ (row & 15); koff = (unsigned)(row * 2048 + chunk * 16); }
      { const int st = p >> 5, kk7 = (p >> 2) & 7, ch = p & 3, kk = (st >> 2) * 8 + kk7, k = (kk & ~0xC) | ((kk & 4) << 1) | ((kk & 8) >> 1), c = (st & 3) * 32 + ch * 8; voff = (unsigned)(k * 2048 + c * 2); } }
    const char* Kg = (const char*)KBp; const char* Vg = (const char*)VBp;
    const unsigned lds0 = (unsigned)(uintptr_t)lds;
    const unsigned kdst = lds0 + wid * 1024, vdst = lds0 + VRING + wid * 1024;
#define TB(bb_, hh_, tile) (((tile) < 256 ? (size_t)(bb_) * SEQ + (size_t)(tile) * 32 : (size_t)T + (size_t)(bb_) * CTXL + (size_t)((tile) - 256) * 32) * 2048 + (size_t)(hh_) * 256)
#define DMA_K(tile) glds16s(Kg + TB(b, h, tile), koff, kdst + (unsigned)(((tile) & 3) * SLOT))
#define DMA_V(tile) glds16s(Vg + TB(b, h, tile), voff, vdst + (unsigned)(((tile) & 3) * SLOT))
#define DMA_KN(tile) glds16s(Kg + TB(nb, nh, tile), koff, kdst + (unsigned)(((tile) & 3) * SLOT))
#define DMA_VN(tile) glds16s(Vg + TB(nb, nh, tile), voff, vdst + (unsigned)(((tile) & 3) * SLOT))
#define QDMA(bb_, hh_, qq_) do { const int lq_ = lane_id(); const bf16_t* qs_ = Qb + ((size_t)(bb_) * SEQ + (size_t)(qq_) * 256 + g * 64) * 2048 + 1024 + (hh_) * 128 + mp * 64; const unsigned qo_ = (unsigned)((lq_ & 31) * 4096 + (lq_ >> 5) * 16); \
    _Pragma("unroll") for (int f = 0; f < 8; ++f) glds16s(qs_ + (f >> 2) * (32 * 2048) + (f & 3) * 16, qo_, lds0 + QOFF + wid * 8192 + f * 1024); } while (0)
#define BARV(N) asm volatile("s_waitcnt vmcnt(" #N ") lgkmcnt(0)\n\ts_barrier" ::: "memory")
#define WAITL(N) asm volatile("s_waitcnt lgkmcnt(" #N ")" ::: "memory")
#define LDK(dst, addr, OFF) asm volatile("ds_read_b128 %0, %1 offset:%2" : "=&v"(dst) : "v"(addr), "i"(OFF) : "memory")
    const int kbase = ((int)lds0 + r32 * 256 + ((hi ^ (r32 & 15)) << 4)) ^ (mp << 7);
    const int vbase = (int)(lds0 + VRING) + (((lane & 3) << 3) | (((lane >> 2) & 3) << 6) | (((lane >> 4) & 1) << 5) | ((lane >> 5) << 11));
    constexpr int NT = 264;
    float l0a = 0.f, l1a = 0.f;
#define EX(v) __builtin_amdgcn_exp2f(v)
#define PK4(P, BASE, OUT) do { u32x4 w_ = {cvt_pk_bf16(P[BASE + 0], P[BASE + 1]), cvt_pk_bf16(P[BASE + 2], P[BASE + 3]), cvt_pk_bf16(P[BASE + 4], P[BASE + 5]), cvt_pk_bf16(P[BASE + 6], P[BASE + 7])}; OUT = *reinterpret_cast<bf16x8*>(&w_); } while (0)
#define LSUM2(la, P, B) do { const float t0_ = (P[B] + P[B + 1]) + (P[B + 2] + P[B + 3]), t1_ = (P[B + 4] + P[B + 5]) + (P[B + 6] + P[B + 7]); la += t0_ + t1_; } while (0)
#define KRD(kb_) do { LDK(k0, (kb_) ^ (0 << 5), 0); LDK(k1, (kb_) ^ (1 << 5), 0); LDK(k2, (kb_) ^ (2 << 5), 0); LDK(k3, (kb_) ^ (3 << 5), 0); } while (0)
#define QKMF(S_, q0_, q1_, q2_, q3_) do { \
    S_ = __builtin_amdgcn_mfma_f32_32x32x16_bf16(k0, q0_, (f32x16){}, 0, 0, 0); S_ = __builtin_amdgcn_mfma_f32_32x32x16_bf16(k1, q1_, S_, 0, 0, 0); \
    S_ = __builtin_amdgcn_mfma_f32_32x32x16_bf16(k2, q2_, S_, 0, 0, 0); S_ = __builtin_amdgcn_mfma_f32_32x32x16_bf16(k3, q3_, S_, 0, 0, 0); } while (0)
#define SMX_E(S_) do { _Pragma("unroll") for (int r = 0; r < 16; ++r) S_[r] = EX(S_[r]); } while (0)
#define SMX_P(S_, PA, LA) do { PK4(S_, 0, PA[0]); PK4(S_, 8, PA[1]); LSUM2(LA, S_, 0); LSUM2(LA, S_, 8); } while (0)
#undef TRR
#define TRR(OFF_, vbx__) tr_read<OFF_>(vbx__)
#define VF(pre, a, b_) ((bf16x8){pre##a[0], pre##a[1], pre##a[2], pre##a[3], pre##b_[0], pre##b_[1], pre##b_[2], pre##b_[3]})
#define PVM2(pre, D0, PO0, PO1) do { \
    o0[D0] = __builtin_amdgcn_mfma_f32_32x32x16_bf16(VF(pre, 0, 1), PO0[0], o0[D0], 0, 0, 0); o1[D0] = __builtin_amdgcn_mfma_f32_32x32x16_bf16(VF(pre, 0, 1), PO1[0], o1[D0], 0, 0, 0); \
    o0[D0] = __builtin_amdgcn_mfma_f32_32x32x16_bf16(VF(pre, 2, 3), PO0[1], o0[D0], 0, 0, 0); o1[D0] = __builtin_amdgcn_mfma_f32_32x32x16_bf16(VF(pre, 2, 3), PO1[1], o1[D0], 0, 0, 0); } while (0)
#define VRD4(d0_, d1_, d2_, d3_, D0, vbx) do { d0_ = TRR(((0 * 4 + D0) * 512 + 0), vbx); d1_ = TRR(((0 * 4 + D0) * 512 + 256), vbx); d2_ = TRR(((2 * 4 + D0) * 512 + 0), vbx); d3_ = TRR(((2 * 4 + D0) * 512 + 256), vbx); } while (0)
    bf16x8 pa0[2], pa1[2];
    bf16x8 k0, k1, k2, k3;
    bf16x8 qa0, qa1, qa2, qa3, qb0, qb1, qb2, qb3;
#define STEP5(j, HASPV, HASNEXT) do { \
    const int knxt_ = kbase + (((j) + 1) & 3) * SLOT, vbx_ = vbase + (((j) - 1) & 3) * SLOT; \
    f32x16 S0_, S1_; s16x4 va0, va1, va2, va3; \
    SBAR(); \
    if (HASPV) { VRD4(va0, va1, va2, va3, 0, vbx_); } \
    QKMF(S0_, qa0, qa1, qa2, qa3); SBAR(); \
    if (HASPV) { \
        s16x4 vb0, vb1, vb2, vb3; VRD4(vb0, vb1, vb2, vb3, 1, vbx_); WAITL(4); SBAR(); \
        PVM2(va, 0, pa0, pa1); SBAR(); \
        QKMF(S1_, qb0, qb1, qb2, qb3); SBAR(); \
        { s16x4 vc0, vc1, vc2, vc3; VRD4(vc0, vc1, vc2, vc3, 2, vbx_); WAITL(4); SBAR(); PVM2(vb, 1, pa0, pa1); SMX_E(S0_); SBAR(); \
          { s16x4 vd0, vd1, vd2, vd3; VRD4(vd0, vd1, vd2, vd3, 3, vbx_); WAITL(4); SBAR(); PVM2(vc, 2, pa0, pa1); SMX_E(S1_); SBAR(); \
            if (HASNEXT) { KRD(knxt_); } \
            if (HASNEXT) WAITL(4); else WAITL(0); \
            SBAR(); \
            LSUM2(l0a, S0_, 0); LSUM2(l0a, S0_, 8); LSUM2(l1a, S1_, 0); LSUM2(l1a, S1_, 8); \
            o0[3] = __builtin_amdgcn_mfma_f32_32x32x16_bf16(VF(vd, 0, 1), pa0[0], o0[3], 0, 0, 0); o1[3] = __builtin_amdgcn_mfma_f32_32x32x16_bf16(VF(vd, 0, 1), pa1[0], o1[3], 0, 0, 0); SBAR(); \
            o0[3] = __builtin_amdgcn_mfma_f32_32x32x16_bf16(VF(vd, 2, 3), pa0[1], o0[3], 0, 0, 0); PK4(S0_, 0, pa0[0]); SBAR(); \
            o1[3] = __builtin_amdgcn_mfma_f32_32x32x16_bf16(VF(vd, 2, 3), pa1[1], o1[3], 0, 0, 0); PK4(S1_, 0, pa1[0]); SBAR(); \
            PK4(S0_, 8, pa0[1]); PK4(S1_, 8, pa1[1]); SBAR(); } } \
    } else { \
        QKMF(S1_, qb0, qb1, qb2, qb3); SBAR(); \
        if (HASNEXT) { KRD(knxt_); } \
        SMX_E(S0_); SMX_E(S1_); SMX_P(S0_, pa0, l0a); SMX_P(S1_, pa1, l1a); SBAR(); } \
    } while (0)
#define MF(acc_, a_, b_) acc_ = __builtin_amdgcn_mfma_f32_32x32x16_bf16(a_, b_, acc_, 0, 0, 0)
#define E2(S_, i_) do { S_[i_] = EX(S_[i_]); S_[(i_) + 1] = EX(S_[(i_) + 1]); } while (0)
#define SUM4(S_, i_) fadd_(fadd_(S_[i_], S_[(i_) + 1]), fadd_(S_[(i_) + 2], S_[(i_) + 3]))
#define STEP6(j) do { \
    const int knxt_ = kbase + (((j) + 1) & 3) * SLOT, vbx_ = vbase + (((j) - 1) & 3) * SLOT; \
    f32x16 S0_, S1_; s16x4 va0, va1, va2, va3, vb0, vb1, vb2, vb3, vc0, vc1, vc2, vc3, vd0, vd1, vd2, vd3; float b0_; \
    SBAR(); \
    S0_ = __builtin_amdgcn_mfma_f32_32x32x16_bf16(k0, qa0, (f32x16){}, 0, 0, 0); va0 = TRR(((0 * 4 + 0) * 512 + 0), vbx_); va1 = TRR(((0 * 4 + 0) * 512 + 256), vbx_); SBAR(); \
    MF(S0_, k1, qa1); va2 = TRR(((2 * 4 + 0) * 512 + 0), vbx_); va3 = TRR(((2 * 4 + 0) * 512 + 256), vbx_); SBAR(); \
    MF(S0_, k2, qa2); if ((j) + 3 < NT) DMA_K((j) + 3); SBAR(); \
    MF(S0_, k3, qa3); if ((j) + 2 < NT) DMA_V((j) + 2); SBAR(); \
    WAITL(0); SBAR(); \
    MF(o0[0], VF(va, 0, 1), pa0[0]); vb0 = TRR(((0 * 4 + 1) * 512 + 0), vbx_); vb1 = TRR(((0 * 4 + 1) * 512 + 256), vbx_); SBAR(); \
    MF(o1[0], VF(va, 0, 1), pa1[0]); vb2 = TRR(((2 * 4 + 1) * 512 + 0), vbx_); vb3 = TRR(((2 * 4 + 1) * 512 + 256), vbx_); SBAR(); \
    MF(o0[0], VF(va, 2, 3), pa0[1]); E2(S0_, 0); SBAR(); \
    MF(o1[0], VF(va, 2, 3), pa1[1]); E2(S0_, 2); SBAR(); \
    S1_ = __builtin_amdgcn_mfma_f32_32x32x16_bf16(k0, qb0, (f32x16){}, 0, 0, 0); E2(S0_, 4); SBAR(); \
    MF(S1_, k1, qb1); E2(S0_, 6); SBAR(); \
    MF(S1_, k2, qb2); E2(S0_, 8); SBAR(); \
    MF(S1_, k3, qb3); E2(S0_, 10); SBAR(); \
    WAITL(0); SBAR(); \
    MF(o0[1], VF(vb, 0, 1), pa0[0]); E2(S0_, 12); vc0 = TRR(((0 * 4 + 2) * 512 + 0), vbx_); vc1 = TRR(((0 * 4 + 2) * 512 + 256), vbx_); SBAR(); \
    MF(o1[1], VF(vb, 0, 1), pa1[0]); E2(S0_, 14); vc2 = TRR(((2 * 4 + 2) * 512 + 0), vbx_); vc3 = TRR(((2 * 4 + 2) * 512 + 256), vbx_); SBAR(); \
    MF(o0[1], VF(vb, 2, 3), pa0[1]); l0a += SUM4(S0_, 0); LDK(k0, knxt_ ^ (0 << 5), 0); LDK(k1, knxt_ ^ (1 << 5), 0); SBAR(); \
    MF(o1[1], VF(vb, 2, 3), pa1[1]); l0a += SUM4(S0_, 4); LDK(k2, knxt_ ^ (2 << 5), 0); LDK(k3, knxt_ ^ (3 << 5), 0); SBAR(); \
    WAITL(4); SBAR(); \
    MF(o0[2], VF(vc, 0, 1), pa0[0]); E2(S1_, 0); vd0 = TRR(((0 * 4 + 3) * 512 + 0), vbx_); vd1 = TRR(((0 * 4 + 3) * 512 + 256), vbx_); SBAR(); \
    MF(o1[2], VF(vc, 0, 1), pa1[0]); E2(S1_, 2); vd2 = TRR(((2 * 4 + 3) * 512 + 0), vbx_); vd3 = TRR(((2 * 4 + 3) * 512 + 256), vbx_); SBAR(); \
    MF(o0[2], VF(vc, 2, 3), pa0[1]); E2(S1_, 4); l0a += SUM4(S0_, 8); SBAR(); \
    MF(o1[2], VF(vc, 2, 3), pa1[1]); E2(S1_, 6); l0a += SUM4(S0_, 12); SBAR(); \
    WAITL(0); SBAR(); \
    MF(o0[3], VF(vd, 0, 1), pa0[0]); E2(S1_, 8); SBAR(); \
    MF(o1[3], VF(vd, 0, 1), pa1[0]); E2(S1_, 10); PK4(S0_, 0, pa0[0]); SBAR(); \
    MF(o0[3], VF(vd, 2, 3), pa0[1]); E2(S1_, 12); b0_ = SUM4(S1_, 0); SBAR(); \
    MF(o1[3], VF(vd, 2, 3), pa1[1]); E2(S1_, 14); PK4(S0_, 8, pa0[1]); b0_ = fadd_(b0_, SUM4(S1_, 4)); SBAR(); \
    PK4(S1_, 0, pa1[0]); PK4(S1_, 8, pa1[1]); l1a += fadd_(b0_, fadd_(SUM4(S1_, 8), SUM4(S1_, 12))); SBAR(); } while (0)
    if (first) { QDMA(b, h, qb); DMA_K(0); DMA_V(0); DMA_K(1); DMA_V(1); DMA_K(2); BARV(1); }
    else BARV(0);
    LDK(qa0, q1a, 0); LDK(qa1, q1a, 1024); LDK(qa2, q1a, 2048); LDK(qa3, q1a, 3072); LDK(qb0, q1a, 4096); LDK(qb1, q1a, 5120); LDK(qb2, q1a, 6144); LDK(qb3, q1a, 7168);
    KRD(kbase); WAITL(0);
    DMA_K(3); DMA_V(2);
    STEP5(0, 0, 1);
    BARV(2);
#pragma unroll 1
    for (int j = 1; j + 1 < NT; ++j) {
        STEP6(j);
        if (j + 3 < NT) BARV(2); else BARV(0);
    }
    STEP5(NT - 1, 1, 0);
    BARV(0);
    if (has_next) { QDMA(nb, nh, nqb); DMA_KN(0); DMA_VN(0); DMA_KN(1); DMA_VN(1); DMA_KN(2); }
    { const int vbx_ = vbase + ((NT - 1) & 3) * SLOT;
      s16x4 va0, va1, va2, va3, vb0, vb1, vb2, vb3, vc0, vc1, vc2, vc3, vd0, vd1, vd2, vd3;
      VRD4(va0, va1, va2, va3, 0, vbx_); VRD4(vb0, vb1, vb2, vb3, 1, vbx_); WAITL(4); SBAR(); PVM2(va, 0, pa0, pa1); SBAR();
      VRD4(vc0, vc1, vc2, vc3, 2, vbx_); WAITL(4); SBAR(); PVM2(vb, 1, pa0, pa1); SBAR();
      VRD4(vd0, vd1, vd2, vd3, 3, vbx_); WAITL(4); SBAR(); PVM2(vc, 2, pa0, pa1); SBAR(); WAITL(0); SBAR(); PVM2(vd, 3, pa0, pa1); SBAR(); }
    float l0 = l0a, l1 = l1a;
    { auto rr = __builtin_amdgcn_permlane32_swap(__float_as_uint(l0), __float_as_uint(l0), false, false); l0 = __uint_as_float(rr[0]) + __uint_as_float(rr[1]); }
    { auto rr = __builtin_amdgcn_permlane32_swap(__float_as_uint(l1), __float_as_uint(l1), false, false); l1 = __uint_as_float(rr[0]) + __uint_as_float(rr[1]); }
    {
        const float lamv = *(const volatile float*)lamp;
        const float fsel = mp ? lamv : 1.0f;
        const float sc0 = fsel * __builtin_amdgcn_rcpf(l0), sc1 = fsel * __builtin_amdgcn_rcpf(l1);
        LAS float* xb = (LAS float*)((LAS char*)lds + 139264) + g * 1024 + lane_id();
#define XCH(OA, SC) do { \
        if (mp) { _Pragma("unroll") for (int r = 0; r < 16; ++r) xb[r * 64] = OA[r] * SC; } \
        asm volatile("s_waitcnt lgkmcnt(0)\n\ts_barrier" ::: "memory"); \
        if (!mp) { _Pragma("unroll") for (int r = 0; r < 16; ++r) OA[r] = OA[r] * SC - xb[r * 64]; } \
        asm volatile("s_waitcnt lgkmcnt(0)\n\ts_barrier" ::: "memory"); } while (0)
#pragma unroll
        for (int d0 = 0; d0 < 4; ++d0) { XCH(o0[d0], sc0); XCH(o1[d0], sc1); }
#undef XCH
    }
    if (do_store && mp == 0) {
        float s0 = 0.f, s1 = 0.f;
#pragma unroll
        for (int d0 = 0; d0 < 4; ++d0)
#pragma unroll
            for (int r = 0; r < 16; ++r) { s0 += o0[d0][r] * o0[d0][r]; s1 += o1[d0][r] * o1[d0][r]; }
        { auto rr = __builtin_amdgcn_permlane32_swap(__float_as_uint(s0), __float_as_uint(s0), false, false); s0 = __uint_as_float(rr[0]) + __uint_as_float(rr[1]); }
        { auto rr = __builtin_amdgcn_permlane32_swap(__float_as_uint(s1), __float_as_uint(s1), false, false); s1 = __uint_as_float(rr[0]) + __uint_as_float(rr[1]); }
        const float rs0 = rsqrtf(s0 * (1.0f / 128.0f) + EPSN) * 0.8f, rs1 = rsqrtf(s1 * (1.0f / 128.0f) + EPSN) * 0.8f;
        const int le_ = lane_id(), r32e = le_ & 31, hie = le_ >> 5;
        bf16_t* Ow = Ob + (qrow + r32e) * 2048 + 1024 + h * 128 + 4 * hie;
#pragma unroll
        for (int d0 = 0; d0 < 4; ++d0)
#pragma unroll
            for (int r4 = 0; r4 < 4; ++r4) {
                const f32x4 sg = *(const f32x4*)(subg + d0 * 32 + r4 * 8 + 4 * hie);
                u32x2 w; w.x = cvt_pk_bf16(o0[d0][4 * r4] * rs0 * sg[0], o0[d0][4 * r4 + 1] * rs0 * sg[1]); w.y = cvt_pk_bf16(o0[d0][4 * r4 + 2] * rs0 * sg[2], o0[d0][4 * r4 + 3] * rs0 * sg[3]);
                *(u32x2*)(Ow + d0 * 32 + r4 * 8) = w;
                u32x2 w2; w2.x = cvt_pk_bf16(o1[d0][4 * r4] * rs1 * sg[0], o1[d0][4 * r4 + 1] * rs1 * sg[1]); w2.y = cvt_pk_bf16(o1[d0][4 * r4 + 2] * rs1 * sg[2], o1[d0][4 * r4 + 3] * rs1 * sg[3]);
                *(u32x2*)(Ow + 32 * 2048 + d0 * 32 + r4 * 8) = w2;
            }
    }
    if (!has_next) BARV(0);
#undef TB
#undef DMA_KN
#undef DMA_VN
#undef QDMA
#undef DMA_K
#undef DMA_V
#undef BARV
#undef WAITL
#undef LDK
#undef EX
#undef PK4
#undef LSUM2
#undef KRD
#undef QKMF
#undef VRD4
#undef STEP5
#undef STEP6
#undef MF
#undef E2
#undef SUM4
#undef SMX_E
#undef SMX_P
#undef PVM2
#undef TRR
#undef VF
}

__device__ __forceinline__ void attnB9_unit(const bf16_t* Qb, const bf16_t* __restrict__ KBp, const bf16_t* __restrict__ VBp, bf16_t* Ob, int b, int h, int qb, char* lds, const float* lamp, const float* subg, const int wid, const bool do_store, const int nb, const int nh, const int nqb, const bool first, const bool has_next) {
    const int lane = lane_id(), r32 = lane & 31, hi = lane >> 5;
    const int mp = wid & 1, g = wid >> 1;
    constexpr int SLOT = 8192, VRING = 8 * SLOT;
    f32x16 o0[4] = {}, o1[4] = {};
    const size_t qrow = (size_t)b * SEQ + qb * 256 + g * 64;
    unsigned koff, voff;
    { const int p = wid * 64 + lane;
      { const int row = p >> 4, cpos = p & 15, chunk = cpos ^ (row & 15); koff = (unsigned)(row * 2048 + chunk * 16); }
      { const int st = p >> 5, kk7 = (p >> 2) & 7, ch = p & 3, kk = (st >> 2) * 8 + kk7, k = (kk & ~0xC) | ((kk & 4) << 1) | ((kk & 8) >> 1), c = (st & 3) * 32 + ch * 8; voff = (unsigned)(k * 2048 + c * 2); } }
    const char* Kg = (const char*)KBp; const char* Vg = (const char*)VBp;
    const unsigned lds0 = (unsigned)(uintptr_t)lds;
    const unsigned kdst = lds0 + wid * 1024, vdst = lds0 + VRING + wid * 1024;
#define TB(bb_, hh_, tile) (((tile) < 256 ? (size_t)(bb_) * SEQ + (size_t)(tile) * 32 : (size_t)T + (size_t)(bb_) * CTXL + (size_t)((tile) - 256) * 32) * 2048 + (size_t)(hh_) * 256)
#define DMA_K(tile) glds16s(Kg + TB(b, h, tile), koff, kdst + (unsigned)(((tile) & 7) * SLOT))
#define DMA_V(tile) glds16s(Vg + TB(b, h, tile), voff, vdst + (unsigned)(((tile) & 7) * SLOT))
#define DMA_KN(tile) glds16s(Kg + TB(nb, nh, tile), koff, kdst + (unsigned)(((tile) & 7) * SLOT))
#define DMA_VN(tile) glds16s(Vg + TB(nb, nh, tile), voff, vdst + (unsigned)(((tile) & 7) * SLOT))
#define QLD() do { const bf16_t* qs_ = Qb + (qrow + r32) * 2048 + 1024 + h * 128 + mp * 64 + hi * 8; \
    qa0 = *(const bf16x8*)(qs_); qa1 = *(const bf16x8*)(qs_ + 16); qa2 = *(const bf16x8*)(qs_ + 32); qa3 = *(const bf16x8*)(qs_ + 48); \
    qb0 = *(const bf16x8*)(qs_ + 32 * 2048); qb1 = *(const bf16x8*)(qs_ + 32 * 2048 + 16); qb2 = *(const bf16x8*)(qs_ + 32 * 2048 + 32); qb3 = *(const bf16x8*)(qs_ + 32 * 2048 + 48); } while (0)
#define BARV(N) asm volatile("s_waitcnt vmcnt(" #N ") lgkmcnt(0)\n\ts_barrier" ::: "memory")
#define WAITL(N) asm volatile("s_waitcnt lgkmcnt(" #N ")" ::: "memory")
#define LDK(dst, addr, OFF) asm volatile("ds_read_b128 %0, %1 offset:%2" : "=&v"(dst) : "v"(addr), "i"(OFF) : "memory")
    const int kbase = ((int)lds0 + r32 * 256 + ((hi ^ (r32 & 15)) << 4)) ^ (mp << 7);
    const int vbase = (int)(lds0 + VRING) + (((lane & 3) << 3) | (((lane >> 2) & 3) << 6) | (((lane >> 4) & 1) << 5) | ((lane >> 5) << 11));
    constexpr int NT = 264;
    float l0a = 0.f, l1a = 0.f;
#define EX(v) __builtin_amdgcn_exp2f(v)
#define PK4(P, BASE, OUT) do { u32x4 w_ = {cvt_pk_bf16(P[BASE + 0], P[BASE + 1]), cvt_pk_bf16(P[BASE + 2], P[BASE + 3]), cvt_pk_bf16(P[BASE + 4], P[BASE + 5]), cvt_pk_bf16(P[BASE + 6], P[BASE + 7])}; OUT = *reinterpret_cast<bf16x8*>(&w_); } while (0)
#define LSUM2(la, P, B) do { const float t0_ = (P[B] + P[B + 1]) + (P[B + 2] + P[B + 3]), t1_ = (P[B + 4] + P[B + 5]) + (P[B + 6] + P[B + 7]); la += t0_ + t1_; } while (0)
#define KRD(kb_) do { LDK(k0, (kb_) ^ (0 << 5), 0); LDK(k1, (kb_) ^ (1 << 5), 0); LDK(k2, (kb_) ^ (2 << 5), 0); LDK(k3, (kb_) ^ (3 << 5), 0); } while (0)
#define QKMF(S_, q0_, q1_, q2_, q3_) do { \
    S_ = __builtin_amdgcn_mfma_f32_32x32x16_bf16(k0, q0_, (f32x16){}, 0, 0, 0); S_ = __builtin_amdgcn_mfma_f32_32x32x16_bf16(k1, q1_, S_, 0, 0, 0); \
    S_ = __builtin_amdgcn_mfma_f32_32x32x16_bf16(k2, q2_, S_, 0, 0, 0); S_ = __builtin_amdgcn_mfma_f32_32x32x16_bf16(k3, q3_, S_, 0, 0, 0); } while (0)
#define SMX_E(S_) do { _Pragma("unroll") for (int r = 0; r < 16; ++r) S_[r] = EX(S_[r]); } while (0)
#define SMX_P(S_, PA, LA) do { PK4(S_, 0, PA[0]); PK4(S_, 8, PA[1]); LSUM2(LA, S_, 0); LSUM2(LA, S_, 8); } while (0)
#undef TRR
#define TRR(OFF_, vbx__) tr_read<OFF_>(vbx__)
#define VF(pre, a, b_) ((bf16x8){pre##a[0], pre##a[1], pre##a[2], pre##a[3], pre##b_[0], pre##b_[1], pre##b_[2], pre##b_[3]})
#define PVM2(pre, D0, PO0, PO1) do { \
    o0[D0] = __builtin_amdgcn_mfma_f32_32x32x16_bf16(VF(pre, 0, 1), PO0[0], o0[D0], 0, 0, 0); o1[D0] = __builtin_amdgcn_mfma_f32_32x32x16_bf16(VF(pre, 0, 1), PO1[0], o1[D0], 0, 0, 0); \
    o0[D0] = __builtin_amdgcn_mfma_f32_32x32x16_bf16(VF(pre, 2, 3), PO0[1], o0[D0], 0, 0, 0); o1[D0] = __builtin_amdgcn_mfma_f32_32x32x16_bf16(VF(pre, 2, 3), PO1[1], o1[D0], 0, 0, 0); } while (0)
#define VRD4(d0_, d1_, d2_, d3_, D0, vbx) do { d0_ = TRR(((0 * 4 + D0) * 512 + 0), vbx); d1_ = TRR(((0 * 4 + D0) * 512 + 256), vbx); d2_ = TRR(((2 * 4 + D0) * 512 + 0), vbx); d3_ = TRR(((2 * 4 + D0) * 512 + 256), vbx); } while (0)
    bf16x8 pa0[2], pa1[2];
    bf16x8 k0, k1, k2, k3;
    bf16x8 qa0, qa1, qa2, qa3, qb0, qb1, qb2, qb3;
#define STEP5(j, HASPV, HASNEXT) do { \
    const int knxt_ = kbase + (((j) + 1) & 7) * SLOT, vbx_ = vbase + (((j) - 1) & 7) * SLOT; \
    f32x16 S0_, S1_; s16x4 va0, va1, va2, va3; \
    SBAR(); \
    if (HASPV) { VRD4(va0, va1, va2, va3, 0, vbx_); } \
    QKMF(S0_, qa0, qa1, qa2, qa3); SBAR(); \
    if (HASPV) { \
        s16x4 vb0, vb1, vb2, vb3; VRD4(vb0, vb1, vb2, vb3, 1, vbx_); WAITL(4); SBAR(); \
        PVM2(va, 0, pa0, pa1); SBAR(); \
        QKMF(S1_, qb0, qb1, qb2, qb3); SBAR(); \
        { s16x4 vc0, vc1, vc2, vc3; VRD4(vc0, vc1, vc2, vc3, 2, vbx_); WAITL(4); SBAR(); PVM2(vb, 1, pa0, pa1); SMX_E(S0_); SBAR(); \
          { s16x4 vd0, vd1, vd2, vd3; VRD4(vd0, vd1, vd2, vd3, 3, vbx_); WAITL(4); SBAR(); PVM2(vc, 2, pa0, pa1); SMX_E(S1_); SBAR(); \
            if (HASNEXT) { KRD(knxt_); } \
            if (HASNEXT) WAITL(4); else WAITL(0); \
            SBAR(); \
            LSUM2(l0a, S0_, 0); LSUM2(l0a, S0_, 8); LSUM2(l1a, S1_, 0); LSUM2(l1a, S1_, 8); \
            o0[3] = __builtin_amdgcn_mfma_f32_32x32x16_bf16(VF(vd, 0, 1), pa0[0], o0[3], 0, 0, 0); o1[3] = __builtin_amdgcn_mfma_f32_32x32x16_bf16(VF(vd, 0, 1), pa1[0], o1[3], 0, 0, 0); SBAR(); \
            o0[3] = __builtin_amdgcn_mfma_f32_32x32x16_bf16(VF(vd, 2, 3), pa0[1], o0[3], 0, 0, 0); PK4(S0_, 0, pa0[0]); SBAR(); \
            o1[3] = __builtin_amdgcn_mfma_f32_32x32x16_bf16(VF(vd, 2, 3), pa1[1], o1[3], 0, 0, 0); PK4(S1_, 0, pa1[0]); SBAR(); \
            PK4(S0_, 8, pa0[1]); PK4(S1_, 8, pa1[1]); SBAR(); } } \
    } else { \
        QKMF(S1_, qb0, qb1, qb2, qb3); SBAR(); \
        if (HASNEXT) { KRD(knxt_); } \
        SMX_E(S0_); SMX_E(S1_); SMX_P(S0_, pa0, l0a); SMX_P(S1_, pa1, l1a); SBAR(); } \
    } while (0)
#define MF(acc_, a_, b_) acc_ = __builtin_amdgcn_mfma_f32_32x32x16_bf16(a_, b_, acc_, 0, 0, 0)
#define E2(S_, i_) do { S_[i_] = EX(S_[i_]); S_[(i_) + 1] = EX(S_[(i_) + 1]); } while (0)
#define SUM4(S_, i_) fadd_(fadd_(S_[i_], S_[(i_) + 1]), fadd_(S_[(i_) + 2], S_[(i_) + 3]))
#define STEP6(j) do { \
    const int knxt_ = kbase + (((j) + 1) & 7) * SLOT, vbx_ = vbase + (((j) - 1) & 7) * SLOT; \
    f32x16 S0_, S1_; s16x4 va0, va1, va2, va3, vb0, vb1, vb2, vb3, vc0, vc1, vc2, vc3, vd0, vd1, vd2, vd3; float b0_; \
    SBAR(); \
    S0_ = __builtin_amdgcn_mfma_f32_32x32x16_bf16(k0, qa0, (f32x16){}, 0, 0, 0); va0 = TRR(((0 * 4 + 0) * 512 + 0), vbx_); va1 = TRR(((0 * 4 + 0) * 512 + 256), vbx_); SBAR(); \
    MF(S0_, k1, qa1); va2 = TRR(((2 * 4 + 0) * 512 + 0), vbx_); va3 = TRR(((2 * 4 + 0) * 512 + 256), vbx_); SBAR(); \
    MF(S0_, k2, qa2); if ((j) + 7 < NT) DMA_K((j) + 7); SBAR(); \
    MF(S0_, k3, qa3); if ((j) + 5 < NT) DMA_V((j) + 5); SBAR(); \
    WAITL(0); SBAR(); \
    MF(o0[0], VF(va, 0, 1), pa0[0]); vb0 = TRR(((0 * 4 + 1) * 512 + 0), vbx_); vb1 = TRR(((0 * 4 + 1) * 512 + 256), vbx_); SBAR(); \
    MF(o1[0], VF(va, 0, 1), pa1[0]); vb2 = TRR(((2 * 4 + 1) * 512 + 0), vbx_); vb3 = TRR(((2 * 4 + 1) * 512 + 256), vbx_); SBAR(); \
    MF(o0[0], VF(va, 2, 3), pa0[1]); E2(S0_, 0); SBAR(); \
    MF(o1[0], VF(va, 2, 3), pa1[1]); E2(S0_, 2); SBAR(); \
    S1_ = __builtin_amdgcn_mfma_f32_32x32x16_bf16(k0, qb0, (f32x16){}, 0, 0, 0); E2(S0_, 4); SBAR(); \
    MF(S1_, k1, qb1); E2(S0_, 6); SBAR(); \
    MF(S1_, k2, qb2); E2(S0_, 8); SBAR(); \
    MF(S1_, k3, qb3); E2(S0_, 10); SBAR(); \
    WAITL(0); SBAR(); \
    MF(o0[1], VF(vb, 0, 1), pa0[0]); E2(S0_, 12); vc0 = TRR(((0 * 4 + 2) * 512 + 0), vbx_); vc1 = TRR(((0 * 4 + 2) * 512 + 256), vbx_); SBAR(); \
    MF(o1[1], VF(vb, 0, 1), pa1[0]); E2(S0_, 14); vc2 = TRR(((2 * 4 + 2) * 512 + 0), vbx_); vc3 = TRR(((2 * 4 + 2) * 512 + 256), vbx_); SBAR(); \
    MF(o0[1], VF(vb, 2, 3), pa0[1]); l0a += SUM4(S0_, 0); LDK(k0, knxt_ ^ (0 << 5), 0); LDK(k1, knxt_ ^ (1 << 5), 0); SBAR(); \
    MF(o1[1], VF(vb, 2, 3), pa1[1]); l0a += SUM4(S0_, 4); LDK(k2, knxt_ ^ (2 << 5), 0); LDK(k3, knxt_ ^ (3 << 5), 0); SBAR(); \
    WAITL(4); SBAR(); \
    MF(o0[2], VF(vc, 0, 1), pa0[0]); E2(S1_, 0); vd0 = TRR(((0 * 4 + 3) * 512 + 0), vbx_); vd1 = TRR(((0 * 4 + 3) * 512 + 256), vbx_); SBAR(); \
    MF(o1[2], VF(vc, 0, 1), pa1[0]); E2(S1_, 2); vd2 = TRR(((2 * 4 + 3) * 512 + 0), vbx_); vd3 = TRR(((2 * 4 + 3) * 512 + 256), vbx_); SBAR(); \
    MF(o0[2], VF(vc, 2, 3), pa0[1]); E2(S1_, 4); l0a += SUM4(S0_, 8); SBAR(); \
    MF(o1[2], VF(vc, 2, 3), pa1[1]); E2(S1_, 6); l0a += SUM4(S0_, 12); SBAR(); \
    WAITL(0); SBAR(); \
    MF(o0[3], VF(vd, 0, 1), pa0[0]); E2(S1_, 8); SBAR(); \
    MF(o1[3], VF(vd, 0, 1), pa1[0]); E2(S1_, 10); PK4(S0_, 0, pa0[0]); SBAR(); \
    MF(o0[3], VF(vd, 2, 3), pa0[1]); E2(S1_, 12); b0_ = SUM4(S1_, 0); SBAR(); \
    MF(o1[3], VF(vd, 2, 3), pa1[1]); E2(S1_, 14); PK4(S0_, 8, pa0[1]); b0_ = fadd_(b0_, SUM4(S1_, 4)); SBAR(); \
    PK4(S1_, 0, pa1[0]); PK4(S1_, 8, pa1[1]); l1a += fadd_(b0_, fadd_(SUM4(S1_, 8), SUM4(S1_, 12))); SBAR(); } while (0)
    QLD();
    if (first) { DMA_K(0); DMA_V(0); DMA_K(1); DMA_K(2); DMA_K(3); DMA_V(1); DMA_K(4); DMA_V(2); DMA_K(5); DMA_V(3); DMA_K(6); DMA_V(4); }
    BARV(0);
    KRD(kbase); WAITL(0);
    DMA_K(7); DMA_V(5);
    STEP5(0, 0, 1);
    WAITL(0);
#pragma unroll 1
    for (int j = 1; j + 1 < NT; ++j) {
        STEP6(j);
        if (j & 1) { if (j + 7 < NT) BARV(8); else BARV(0); }
        else WAITL(0);
    }
    STEP5(NT - 1, 1, 0);
    BARV(0);
    if (has_next) { DMA_KN(0); DMA_VN(0); DMA_KN(1); DMA_KN(2); DMA_KN(3); DMA_VN(1); DMA_KN(4); DMA_VN(2); DMA_KN(5); DMA_VN(3); DMA_KN(6); DMA_VN(4); }
    { const int vbx_ = vbase + ((NT - 1) & 7) * SLOT;
      s16x4 va0, va1, va2, va3, vb0, vb1, vb2, vb3, vc0, vc1, vc2, vc3, vd0, vd1, vd2, vd3;
      VRD4(va0, va1, va2, va3, 0, vbx_); VRD4(vb0, vb1, vb2, vb3, 1, vbx_); WAITL(4); SBAR(); PVM2(va, 0, pa0, pa1); SBAR();
      VRD4(vc0, vc1, vc2, vc3, 2, vbx_); WAITL(4); SBAR(); PVM2(vb, 1, pa0, pa1); SBAR();
      VRD4(vd0, vd1, vd2, vd3, 3, vbx_); WAITL(4); SBAR(); PVM2(vc, 2, pa0, pa1); SBAR(); WAITL(0); SBAR(); PVM2(vd, 3, pa0, pa1); SBAR(); }
    float l0 = l0a, l1 = l1a;
    { auto rr = __builtin_amdgcn_permlane32_swap(__float_as_uint(l0), __float_as_uint(l0), false, false); l0 = __uint_as_float(rr[0]) + __uint_as_float(rr[1]); }
    { auto rr = __builtin_amdgcn_permlane32_swap(__float_as_uint(l1), __float_as_uint(l1), false, false); l1 = __uint_as_float(rr[0]) + __uint_as_float(rr[1]); }
    {
        const float lamv = *(const volatile float*)lamp;
        const float fsel = mp ? lamv : 1.0f;
        const float sc0 = fsel * __builtin_amdgcn_rcpf(l0), sc1 = fsel * __builtin_amdgcn_rcpf(l1);
        LAS float* xb = (LAS float*)((LAS char*)lds + 139264) + g * 1024 + lane_id();
#define XCH(OA, SC) do { \
        if (mp) { _Pragma("unroll") for (int r = 0; r < 16; ++r) xb[r * 64] = OA[r] * SC; } \
        asm volatile("s_waitcnt lgkmcnt(0)\n\ts_barrier" ::: "memory"); \
        if (!mp) { _Pragma("unroll") for (int r = 0; r < 16; ++r) OA[r] = OA[r] * SC - xb[r * 64]; } \
        asm volatile("s_waitcnt lgkmcnt(0)\n\ts_barrier" ::: "memory"); } while (0)
#pragma unroll
        for (int d0 = 0; d0 < 4; ++d0) { XCH(o0[d0], sc0); XCH(o1[d0], sc1); }
#undef XCH
    }
    if (do_store && mp == 0) {
        float s0 = 0.f, s1 = 0.f;
#pragma unroll
        for (int d0 = 0; d0 < 4; ++d0)
#pragma unroll
            for (int r = 0; r < 16; ++r) { s0 += o0[d0][r] * o0[d0][r]; s1 += o1[d0][r] * o1[d0][r]; }
        { auto rr = __builtin_amdgcn_permlane32_swap(__float_as_uint(s0), __float_as_uint(s0), false, false); s0 = __uint_as_float(rr[0]) + __uint_as_float(rr[1]); }
        { auto rr = __builtin_amdgcn_permlane32_swap(__float_as_uint(s1), __float_as_uint(s1), false, false); s1 = __uint_as_float(rr[0]) + __uint_as_float(rr[1]); }
        const float rs0 = rsqrtf(s0 * (1.0f / 128.0f) + EPSN) * 0.8f, rs1 = rsqrtf(s1 * (1.0f / 128.0f) + EPSN) * 0.8f;
        const int le_ = lane_id(), r32e = le_ & 31, hie = le_ >> 5;
        bf16_t* Ow = Ob + (qrow + r32e) * 2048 + 1024 + h * 128 + 4 * hie;
#pragma unroll
        for (int d0 = 0; d0 < 4; ++d0)
#pragma unroll
            for (int r4 = 0; r4 < 4; ++r4) {
                const f32x4 sg = *(const f32x4*)(subg + d0 * 32 + r4 * 8 + 4 * hie);
                u32x2 w; w.x = cvt_pk_bf16(o0[d0][4 * r4] * rs0 * sg[0], o0[d0][4 * r4 + 1] * rs0 * sg[1]); w.y = cvt_pk_bf16(o0[d0][4 * r4 + 2] * rs0 * sg[2], o0[d0][4 * r4 + 3] * rs0 * sg[3]);
                *(u32x2*)(Ow + d0 * 32 + r4 * 8) = w;
                u32x2 w2; w2.x = cvt_pk_bf16(o1[d0][4 * r4] * rs1 * sg[0], o1[d0][4 * r4 + 1] * rs1 * sg[1]); w2.y = cvt_pk_bf16(o1[d0][4 * r4 + 2] * rs1 * sg[2], o1[d0][4 * r4 + 3] * rs1 * sg[3]);
                *(u32x2*)(Ow + 32 * 2048 + d0 * 32 + r4 * 8) = w2;
            }
    }
    if (!has_next) BARV(0);
#undef TB
#undef DMA_KN
#undef DMA_VN
#undef QLD
#undef DMA_K
#undef DMA_V
#undef BARV
#undef WAITL
#undef LDK
#undef EX
#undef PK4
#undef LSUM2
#undef KRD
#undef QKMF
#undef VRD4
#undef STEP5
#undef STEP6
#undef MF
#undef E2
#undef SUM4
#undef SMX_E
#undef SMX_P
#undef PVM2
#undef TRR
#undef VF
}

__device__ __forceinline__ void attnA4_unit(const bf16_t* Qb, const bf16_t* __restrict__ KVAp, bf16_t* Ob, int b, int kvh, int qb, char* lds, const float* sink, const int wid, const bool do_store) {
    const int lane = lane_id(), r32 = lane & 31, hi = lane >> 5;
    constexpr int SLOT = 8192, VRING = 3 * SLOT;
    float* li_l = (float*)(lds + B2_WS) + wid * 64;
    const int head = kvh * 8 + wid, t0 = qb * 64;
    const size_t qrow = (size_t)b * SEQ + t0;
    f32x16 o[2][2] = {}; bf16x8 q[2][4];
#pragma unroll
    for (int rb = 0; rb < 2; ++rb)
#pragma unroll
        for (int d0 = 0; d0 < 4; ++d0) q[rb][d0] = *reinterpret_cast<const bf16x8*>(Qb + (qrow + rb * 32 + r32) * 2048 + head * 64 + hi * 8 + d0 * 16);
    const int p = wid * 64 + lane;
    const int krow = p >> 3, kchunk = (p & 7) ^ ((krow >> 1) & 7);
    const int vst_ = p >> 5, vkk = (vst_ >> 1) * 8 + ((p >> 2) & 7), vk = (vkk & ~0xC) | ((vkk & 4) << 1) | ((vkk & 8) >> 1), vc = (vst_ & 1) * 32 + (p & 3) * 8;
    const char* KVg = (const char*)KVAp + kvh * 128;
    const unsigned lds0 = (unsigned)(uintptr_t)lds;
    const unsigned kdst = lds0 + wid * 1024, vdst = lds0 + VRING + wid * 1024;
#define ROWA(v) ((v) < 256 ? (size_t)T + (size_t)b * CTXL + (v) : (size_t)b * SEQ + (size_t)min(max(t0 - 384 + (v), 0), SEQ - 1))
#define DMA_A(tile, slotoff) do { const unsigned so_ = (unsigned)__builtin_amdgcn_readfirstlane(slotoff); \
    glds16(KVg + ROWA((tile) * 64 + krow) * 512 + kchunk * 16, kdst + so_); glds16(KVg + ROWA((tile) * 64 + vk) * 512 + 256 + vc * 2, vdst + so_); } while (0)
#define BARV(N) asm volatile("s_waitcnt vmcnt(" #N ") lgkmcnt(0)\n\ts_barrier" ::: "memory")
#define WAITL(N) asm volatile("s_waitcnt lgkmcnt(" #N ")" ::: "memory")
#define LDK(dst, addr, OFF) asm volatile("ds_read_b128 %0, %1 offset:%2" : "=&v"(dst) : "v"(addr), "i"(OFF) : "memory")
    const int kbase = (int)lds0 + r32 * 128 + ((hi ^ ((r32 >> 1) & 7)) << 4);
    const int vbase = (int)(lds0 + VRING) + v_rd_base(lane);
    constexpr int NT = 9;
    float lsum[2] = {0.f, 0.f};
#define PK4(P, BASE, OUT) do { unsigned a0 = cvt_pk_bf16(P[BASE + 0], P[BASE + 1]), a1 = cvt_pk_bf16(P[BASE + 2], P[BASE + 3]);   \
    unsigned b0_ = cvt_pk_bf16(P[BASE + 4], P[BASE + 5]), b1_ = cvt_pk_bf16(P[BASE + 6], P[BASE + 7]);                              \
    auto r0 = __builtin_amdgcn_permlane32_swap(a0, b0_, false, false); auto r1 = __builtin_amdgcn_permlane32_swap(a1, b1_, false, false); \
    u32x4 w = {r0[0], r1[0], r0[1], r1[1]}; OUT = *reinterpret_cast<bf16x8*>(&w); } while (0)
#define VRDA(pre, D0, vbx) const s16x4 pre##0 = tr_read<((0 * 2 + D0) * 512)>(vbx), pre##1 = tr_read<((1 * 2 + D0) * 512)>(vbx), pre##2 = tr_read<((2 * 2 + D0) * 512)>(vbx), pre##3 = tr_read<((3 * 2 + D0) * 512)>(vbx), \
    pre##4 = tr_read<((4 * 2 + D0) * 512)>(vbx), pre##5 = tr_read<((5 * 2 + D0) * 512)>(vbx), pre##6 = tr_read<((6 * 2 + D0) * 512)>(vbx), pre##7 = tr_read<((7 * 2 + D0) * 512)>(vbx)
#define VF(pre, a, b_) ((bf16x8){pre##a[0], pre##a[1], pre##a[2], pre##a[3], pre##b_[0], pre##b_[1], pre##b_[2], pre##b_[3]})
    int sl_c = 0, sl_1 = SLOT, sl_2 = 2 * SLOT;
    DMA_A(0, sl_c); DMA_A(1, sl_1);
    BARV(2);
#pragma unroll 1
    for (int j = 0; j < NT; ++j) {
        if (j + 2 < NT) DMA_A(j + 2, sl_2);
        const int ka_ = kbase + sl_c, vbx_ = vbase + sl_c;
        bf16x8 pa[2][4];
#pragma unroll
        for (int rb = 0; rb < 2; ++rb) {
            f32x16 Sa, Sb; bf16x8 ka0, kb0, ka1, kb1;
            LDK(ka0, ka_ ^ (0 << 5), 0); LDK(kb0, ka_ ^ (0 << 5), 4096); LDK(ka1, ka_ ^ (1 << 5), 0); LDK(kb1, ka_ ^ (1 << 5), 4096);
            WAITL(2); SBAR();
            Sa = __builtin_amdgcn_mfma_f32_32x32x16_bf16(ka0, q[rb][0], (f32x16){}, 0, 0, 0); Sb = __builtin_amdgcn_mfma_f32_32x32x16_bf16(kb0, q[rb][0], (f32x16){}, 0, 0, 0); SBAR();
            LDK(ka0, ka_ ^ (2 << 5), 0); LDK(kb0, ka_ ^ (2 << 5), 4096);
            WAITL(2); SBAR();
            Sa = __builtin_amdgcn_mfma_f32_32x32x16_bf16(ka1, q[rb][1], Sa, 0, 0, 0); Sb = __builtin_amdgcn_mfma_f32_32x32x16_bf16(kb1, q[rb][1], Sb, 0, 0, 0); SBAR();
            LDK(ka1, ka_ ^ (3 << 5), 0); LDK(kb1, ka_ ^ (3 << 5), 4096);
            WAITL(2); SBAR();
            Sa = __builtin_amdgcn_mfma_f32_32x32x16_bf16(ka0, q[rb][2], Sa, 0, 0, 0); Sb = __builtin_amdgcn_mfma_f32_32x32x16_bf16(kb0, q[rb][2], Sb, 0, 0, 0); SBAR();
            WAITL(0); SBAR();
            Sa = __builtin_amdgcn_mfma_f32_32x32x16_bf16(ka1, q[rb][3], Sa, 0, 0, 0); Sb = __builtin_amdgcn_mfma_f32_32x32x16_bf16(kb1, q[rb][3], Sb, 0, 0, 0); SBAR();
            if (j >= 4) {
#pragma unroll
                for (int r = 0; r < 16; ++r) {
                    const int v0 = 64 * j + crow(r, hi), v1 = v0 + 32;
                    { const int k = t0 - 384 + v0, d = t0 + rb * 32 + r32 - k; if (!((k >= 0) && (k < SEQ) && (d <= 128) && (d >= -128))) Sa[r] = -INFINITY; }
                    { const int k = t0 - 384 + v1, d = t0 + rb * 32 + r32 - k; if (!((k >= 0) && (k < SEQ) && (d <= 128) && (d >= -128))) Sb[r] = -INFINITY; }
                }
            }
            float ls_ = 0.f;
#pragma unroll
            for (int r = 0; r < 16; ++r) { Sa[r] = __builtin_amdgcn_exp2f(Sa[r]); Sb[r] = __builtin_amdgcn_exp2f(Sb[r]); }
#pragma unroll
            for (int r = 0; r < 16; r += 4) ls_ += ((Sa[r] + Sa[r + 1]) + (Sa[r + 2] + Sa[r + 3])) + ((Sb[r] + Sb[r + 1]) + (Sb[r + 2] + Sb[r + 3]));
            lsum[rb] += ls_;
            PK4(Sa, 0, pa[rb][0]); PK4(Sa, 8, pa[rb][1]); PK4(Sb, 0, pa[rb][2]); PK4(Sb, 8, pa[rb][3]); SBAR();
        }
        { VRDA(va, 0, vbx_); WAITL(0); SBAR();
          o[0][0] = __builtin_amdgcn_mfma_f32_32x32x16_bf16(pa[0][0], VF(va, 0, 1), o[0][0], 0, 0, 0); o[1][0] = __builtin_amdgcn_mfma_f32_32x32x16_bf16(pa[1][0], VF(va, 0, 1), o[1][0], 0, 0, 0);
          o[0][0] = __builtin_amdgcn_mfma_f32_32x32x16_bf16(pa[0][1], VF(va, 2, 3), o[0][0], 0, 0, 0); o[1][0] = __builtin_amdgcn_mfma_f32_32x32x16_bf16(pa[1][1], VF(va, 2, 3), o[1][0], 0, 0, 0);
          o[0][0] = __builtin_amdgcn_mfma_f32_32x32x16_bf16(pa[0][2], VF(va, 4, 5), o[0][0], 0, 0, 0); o[1][0] = __builtin_amdgcn_mfma_f32_32x32x16_bf16(pa[1][2], VF(va, 4, 5), o[1][0], 0, 0, 0);
          o[0][0] = __builtin_amdgcn_mfma_f32_32x32x16_bf16(pa[0][3], VF(va, 6, 7), o[0][0], 0, 0, 0); o[1][0] = __builtin_amdgcn_mfma_f32_32x32x16_bf16(pa[1][3], VF(va, 6, 7), o[1][0], 0, 0, 0); SBAR(); }
        { VRDA(vb, 1, vbx_); WAITL(0); SBAR();
          o[0][1] = __builtin_amdgcn_mfma_f32_32x32x16_bf16(pa[0][0], VF(vb, 0, 1), o[0][1], 0, 0, 0); o[1][1] = __builtin_amdgcn_mfma_f32_32x32x16_bf16(pa[1][0], VF(vb, 0, 1), o[1][1], 0, 0, 0);
          o[0][1] = __builtin_amdgcn_mfma_f32_32x32x16_bf16(pa[0][1], VF(vb, 2, 3), o[0][1], 0, 0, 0); o[1][1] = __builtin_amdgcn_mfma_f32_32x32x16_bf16(pa[1][1], VF(vb, 2, 3), o[1][1], 0, 0, 0);
          o[0][1] = __builtin_amdgcn_mfma_f32_32x32x16_bf16(pa[0][2], VF(vb, 4, 5), o[0][1], 0, 0, 0); o[1][1] = __builtin_amdgcn_mfma_f32_32x32x16_bf16(pa[1][2], VF(vb, 4, 5), o[1][1], 0, 0, 0);
          o[0][1] = __builtin_amdgcn_mfma_f32_32x32x16_bf16(pa[0][3], VF(vb, 6, 7), o[0][1], 0, 0, 0); o[1][1] = __builtin_amdgcn_mfma_f32_32x32x16_bf16(pa[1][3], VF(vb, 6, 7), o[1][1], 0, 0, 0); SBAR(); }
        if (j + 2 < NT) BARV(2); else BARV(0);
        { const int t_ = sl_c; sl_c = sl_1; sl_1 = sl_2; sl_2 = t_; }
    }
    const float sk = __builtin_amdgcn_exp2f(sink[head] * 1.4426950408889634f);
#pragma unroll
    for (int rb = 0; rb < 2; ++rb) { float l_ = lsum[rb];
        { auto rr = __builtin_amdgcn_permlane32_swap(__float_as_uint(l_), __float_as_uint(l_), false, false); l_ = __uint_as_float(rr[0]) + __uint_as_float(rr[1]); }
        if (hi == 0) li_l[rb * 32 + r32] = __builtin_amdgcn_rcpf(l_ + sk); }
    asm volatile("s_waitcnt lgkmcnt(0)" ::: "memory");
    if (do_store) {
#pragma unroll
        for (int rb = 0; rb < 2; ++rb) { bf16_t* Ow = Ob + (qrow + rb * 32) * 2048 + head * 64;
#pragma unroll
            for (int r = 0; r < 16; ++r) { const float rl = li_l[rb * 32 + crow(r, hi)];
#pragma unroll
                for (int d0 = 0; d0 < 2; ++d0) { const unsigned w = cvt_pk_bf16(o[rb][d0][r] * rl, 0.f); Ow[(size_t)crow(r, hi) * 2048 + d0 * 32 + r32] = (bf16_t)(w & 0xffffu); } } }
    }
    BARV(0);
#undef ROWA
#undef DMA_A
#undef BARV
#undef WAITL
#undef LDK
#undef PK4
#undef VRDA
#undef VF
}
__device__ __forceinline__ void attnA5_unit(const bf16_t* Qb, const bf16_t* __restrict__ KVAp, bf16_t* Ob, int b, int kvh, int qb, char* lds, const float* sink, const int wid, const bool do_store, bf16x8 (&q)[2][4], const bool first, const bool has_next, const int nb, const int nkvh, const int nqb) {
    const int lane = lane_id(), r32 = lane & 31, hi = lane >> 5;
    constexpr int SLOT = 8192, VRING = 3 * SLOT;
    float* li_l = (float*)(lds + B2_WS) + wid * 64;
    const int head = kvh * 8 + wid, t0 = qb * 64;
    const size_t qrow = (size_t)b * SEQ + t0;
    f32x16 o[2][2] = {};
    if (first) {
#pragma unroll
        for (int rb = 0; rb < 2; ++rb)
#pragma unroll
            for (int d0 = 0; d0 < 4; ++d0) q[rb][d0] = *reinterpret_cast<const bf16x8*>(Qb + (qrow + rb * 32 + r32) * 2048 + head * 64 + hi * 8 + d0 * 16);
    }
    const int p = wid * 64 + lane;
    const int krow = p >> 3, kchunk = (p & 7) ^ ((krow >> 1) & 7);
    const int vst_ = p >> 5, vkk = (vst_ >> 1) * 8 + ((p >> 2) & 7), vk = (vkk & ~0xC) | ((vkk & 4) << 1) | ((vkk & 8) >> 1), vc = (vst_ & 1) * 32 + (p & 3) * 8;
    const char* KVg = (const char*)KVAp + kvh * 128;
    const unsigned lds0 = (unsigned)(uintptr_t)lds;
    const unsigned kdst = lds0 + wid * 1024, vdst = lds0 + VRING + wid * 1024;
#define ROWA(v) ((v) < 256 ? (size_t)T + (size_t)b * CTXL + (v) : (size_t)b * SEQ + (size_t)min(max(t0 - 384 + (v), 0), SEQ - 1))
#define DMA_A(tile, slotoff) do { const unsigned so_ = (unsigned)__builtin_amdgcn_readfirstlane(slotoff); \
    glds16(KVg + ROWA((tile) * 64 + krow) * 512 + kchunk * 16, kdst + so_); glds16(KVg + ROWA((tile) * 64 + vk) * 512 + 256 + vc * 2, vdst + so_); } while (0)
#define BARV(N) asm volatile("s_waitcnt vmcnt(" #N ") lgkmcnt(0)\n\ts_barrier" ::: "memory")
#define WAITL(N) asm volatile("s_waitcnt lgkmcnt(" #N ")" ::: "memory")
#define LDK(dst, addr, OFF) asm volatile("ds_read_b128 %0, %1 offset:%2" : "=&v"(dst) : "v"(addr), "i"(OFF) : "memory")
    const int kbase = (int)lds0 + r32 * 128 + ((hi ^ ((r32 >> 1) & 7)) << 4);
    const int vbase = (int)(lds0 + VRING) + (((lane & 3) << 3) | (((lane >> 2) & 3) << 6) | (((lane >> 4) & 1) << 5) | ((lane >> 5) << 10));
    constexpr int NT = 9;
    float lsum[2] = {0.f, 0.f};
#define PK4(P, BASE, OUT) do { u32x4 w_ = {cvt_pk_bf16(P[BASE + 0], P[BASE + 1]), cvt_pk_bf16(P[BASE + 2], P[BASE + 3]), cvt_pk_bf16(P[BASE + 4], P[BASE + 5]), cvt_pk_bf16(P[BASE + 6], P[BASE + 7])}; OUT = *reinterpret_cast<bf16x8*>(&w_); } while (0)
#define VRDA(pre, D0, vbx) const s16x4 pre##0 = tr_read<(((0) * 2 + D0) * 512 + 0)>(vbx), pre##1 = tr_read<(((0) * 2 + D0) * 512 + 256)>(vbx), pre##2 = tr_read<(((2) * 2 + D0) * 512 + 0)>(vbx), pre##3 = tr_read<(((2) * 2 + D0) * 512 + 256)>(vbx), \
    pre##4 = tr_read<(((4) * 2 + D0) * 512 + 0)>(vbx), pre##5 = tr_read<(((4) * 2 + D0) * 512 + 256)>(vbx), pre##6 = tr_read<(((6) * 2 + D0) * 512 + 0)>(vbx), pre##7 = tr_read<(((6) * 2 + D0) * 512 + 256)>(vbx)
#define VF(pre, a, b_) ((bf16x8){pre##a[0], pre##a[1], pre##a[2], pre##a[3], pre##b_[0], pre##b_[1], pre##b_[2], pre##b_[3]})
    int sl_c = 0, sl_1 = SLOT, sl_2 = 2 * SLOT;
    if (first) { DMA_A(0, sl_c); DMA_A(1, sl_1); BARV(2); }
    else if (do_store) BARV(18);
    else BARV(2);
#pragma unroll 1
    for (int j = 0; j < NT; ++j) {
        if (j + 2 < NT) DMA_A(j + 2, sl_2);
        const int ka_ = kbase + sl_c, vbx_ = vbase + sl_c;
        bf16x8 pa[2][4];
        f32x16 S_[2][2];
        { bf16x8 ka0, kb0, ka1, kb1;
          LDK(ka0, ka_ ^ (0 << 5), 0); LDK(kb0, ka_ ^ (0 << 5), 4096); LDK(ka1, ka_ ^ (1 << 5), 0); LDK(kb1, ka_ ^ (1 << 5), 4096);
          WAITL(2); SBAR();
#pragma unroll
          for (int rb = 0; rb < 2; ++rb) { S_[rb][0] = __builtin_amdgcn_mfma_f32_32x32x16_bf16(ka0, q[rb][0], (f32x16){}, 0, 0, 0); S_[rb][1] = __builtin_amdgcn_mfma_f32_32x32x16_bf16(kb0, q[rb][0], (f32x16){}, 0, 0, 0); }
          SBAR();
          LDK(ka0, ka_ ^ (2 << 5), 0); LDK(kb0, ka_ ^ (2 << 5), 4096);
          WAITL(2); SBAR();
#pragma unroll
          for (int rb = 0; rb < 2; ++rb) { S_[rb][0] = __builtin_amdgcn_mfma_f32_32x32x16_bf16(ka1, q[rb][1], S_[rb][0], 0, 0, 0); S_[rb][1] = __builtin_amdgcn_mfma_f32_32x32x16_bf16(kb1, q[rb][1], S_[rb][1], 0, 0, 0); }
          SBAR();
          LDK(ka1, ka_ ^ (3 << 5), 0); LDK(kb1, ka_ ^ (3 << 5), 4096);
          WAITL(2); SBAR();
#pragma unroll
          for (int rb = 0; rb < 2; ++rb) { S_[rb][0] = __builtin_amdgcn_mfma_f32_32x32x16_bf16(ka0, q[rb][2], S_[rb][0], 0, 0, 0); S_[rb][1] = __builtin_amdgcn_mfma_f32_32x32x16_bf16(kb0, q[rb][2], S_[rb][1], 0, 0, 0); }
          SBAR();
          WAITL(0); SBAR();
#pragma unroll
          for (int rb = 0; rb < 2; ++rb) { S_[rb][0] = __builtin_amdgcn_mfma_f32_32x32x16_bf16(ka1, q[rb][3], S_[rb][0], 0, 0, 0); S_[rb][1] = __builtin_amdgcn_mfma_f32_32x32x16_bf16(kb1, q[rb][3], S_[rb][1], 0, 0, 0); }
          SBAR(); }
        VRDA(va, 0, vbx_);
#pragma unroll
        for (int rb = 0; rb < 2; ++rb) {
            f32x16 Sa = S_[rb][0], Sb = S_[rb][1];
            if (j >= 4 && (j == 4 || j == 8 || qb == 0 || qb >= 126)) {
#pragma unroll
                for (int r = 0; r < 16; ++r) {
                    const int v0 = 64 * j + crow(r, hi), v1 = v0 + 32;
                    { const int k = t0 - 384 + v0, d = t0 + rb * 32 + r32 - k; if (!((k >= 0) && (k < SEQ) && (d <= 128) && (d >= -128))) Sa[r] = -INFINITY; }
                    { const int k = t0 - 384 + v1, d = t0 + rb * 32 + r32 - k; if (!((k >= 0) && (k < SEQ) && (d <= 128) && (d >= -128))) Sb[r] = -INFINITY; }
                }
            }
            float ls_ = 0.f;
#pragma unroll
            for (int r = 0; r < 16; ++r) { Sa[r] = __builtin_amdgcn_exp2f(Sa[r]); Sb[r] = __builtin_amdgcn_exp2f(Sb[r]); }
#pragma unroll
            for (int r = 0; r < 16; r += 4) ls_ += ((Sa[r] + Sa[r + 1]) + (Sa[r + 2] + Sa[r + 3])) + ((Sb[r] + Sb[r + 1]) + (Sb[r + 2] + Sb[r + 3]));
            lsum[rb] += ls_;
            PK4(Sa, 0, pa[rb][0]); PK4(Sa, 8, pa[rb][1]); PK4(Sb, 0, pa[rb][2]); PK4(Sb, 8, pa[rb][3]); SBAR();
        }
        { VRDA(vb, 1, vbx_); WAITL(8); SBAR();
          o[0][0] = __builtin_amdgcn_mfma_f32_32x32x16_bf16(VF(va, 0, 1), pa[0][0], o[0][0], 0, 0, 0); o[1][0] = __builtin_amdgcn_mfma_f32_32x32x16_bf16(VF(va, 0, 1), pa[1][0], o[1][0], 0, 0, 0);
          o[0][0] = __builtin_amdgcn_mfma_f32_32x32x16_bf16(VF(va, 2, 3), pa[0][1], o[0][0], 0, 0, 0); o[1][0] = __builtin_amdgcn_mfma_f32_32x32x16_bf16(VF(va, 2, 3), pa[1][1], o[1][0], 0, 0, 0);
          o[0][0] = __builtin_amdgcn_mfma_f32_32x32x16_bf16(VF(va, 4, 5), pa[0][2], o[0][0], 0, 0, 0); o[1][0] = __builtin_amdgcn_mfma_f32_32x32x16_bf16(VF(va, 4, 5), pa[1][2], o[1][0], 0, 0, 0);
          o[0][0] = __builtin_amdgcn_mfma_f32_32x32x16_bf16(VF(va, 6, 7), pa[0][3], o[0][0], 0, 0, 0); o[1][0] = __builtin_amdgcn_mfma_f32_32x32x16_bf16(VF(va, 6, 7), pa[1][3], o[1][0], 0, 0, 0); SBAR();
          WAITL(0); SBAR();
          o[0][1] = __builtin_amdgcn_mfma_f32_32x32x16_bf16(VF(vb, 0, 1), pa[0][0], o[0][1], 0, 0, 0); o[1][1] = __builtin_amdgcn_mfma_f32_32x32x16_bf16(VF(vb, 0, 1), pa[1][0], o[1][1], 0, 0, 0);
          o[0][1] = __builtin_amdgcn_mfma_f32_32x32x16_bf16(VF(vb, 2, 3), pa[0][1], o[0][1], 0, 0, 0); o[1][1] = __builtin_amdgcn_mfma_f32_32x32x16_bf16(VF(vb, 2, 3), pa[1][1], o[1][1], 0, 0, 0);
          o[0][1] = __builtin_amdgcn_mfma_f32_32x32x16_bf16(VF(vb, 4, 5), pa[0][2], o[0][1], 0, 0, 0); o[1][1] = __builtin_amdgcn_mfma_f32_32x32x16_bf16(VF(vb, 4, 5), pa[1][2], o[1][1], 0, 0, 0);
          o[0][1] = __builtin_amdgcn_mfma_f32_32x32x16_bf16(VF(vb, 6, 7), pa[0][3], o[0][1], 0, 0, 0); o[1][1] = __builtin_amdgcn_mfma_f32_32x32x16_bf16(VF(vb, 6, 7), pa[1][3], o[1][1], 0, 0, 0); SBAR(); }
        if (j + 2 < NT) BARV(2); else BARV(0);
        { const int t_ = sl_c; sl_c = sl_1; sl_1 = sl_2; sl_2 = t_; }
    }
    const float sk = __builtin_amdgcn_exp2f(sink[head] * 1.4426950408889634f);
    (void)li_l;
    if (has_next) {
        const int ln_ = lane_id(), r32n = ln_ & 31, hin = ln_ >> 5, nt0 = nqb * 64;
        const size_t nqrow = (size_t)nb * SEQ + nt0;
#pragma unroll
        for (int rb = 0; rb < 2; ++rb)
#pragma unroll
            for (int d0 = 0; d0 < 4; ++d0) q[rb][d0] = *reinterpret_cast<const bf16x8*>(Qb + (nqrow + rb * 32 + r32n) * 2048 + (nkvh * 8 + wid) * 64 + hin * 8 + d0 * 16);
        const char* KVn = (const char*)KVAp + nkvh * 128;
#define ROWAN(v) ((v) < 256 ? (size_t)T + (size_t)nb * CTXL + (v) : (size_t)nb * SEQ + (size_t)min(max(nt0 - 384 + (v), 0), SEQ - 1))
#pragma unroll
        for (int tl = 0; tl < 2; ++tl) { glds16(KVn + ROWAN(tl * 64 + krow) * 512 + kchunk * 16, kdst + (unsigned)(tl * SLOT)); glds16(KVn + ROWAN(tl * 64 + vk) * 512 + 256 + vc * 2, vdst + (unsigned)(tl * SLOT)); }
#undef ROWAN
    }
    if (do_store) {
        const int le_ = lane_id(), r32e = le_ & 31, hie = le_ >> 5;
#pragma unroll
        for (int rb = 0; rb < 2; ++rb) { float l_ = lsum[rb];
            { auto rr = __builtin_amdgcn_permlane32_swap(__float_as_uint(l_), __float_as_uint(l_), false, false); l_ = __uint_as_float(rr[0]) + __uint_as_float(rr[1]); }
            const float rl = __builtin_amdgcn_rcpf(l_ + sk);
            bf16_t* Ow = Ob + (qrow + rb * 32 + r32e) * 2048 + head * 64 + 4 * hie;
#pragma unroll
            for (int d0 = 0; d0 < 2; ++d0)
#pragma unroll
                for (int r4 = 0; r4 < 4; ++r4) { u32x2 w; w.x = cvt_pk_bf16(o[rb][d0][4 * r4] * rl, o[rb][d0][4 * r4 + 1] * rl); w.y = cvt_pk_bf16(o[rb][d0][4 * r4 + 2] * rl, o[rb][d0][4 * r4 + 3] * rl);
                    *(u32x2*)(Ow + d0 * 32 + r4 * 8) = w; } }
    }
    if (!has_next) BARV(0);
#undef ROWA
#undef DMA_A
#undef BARV
#undef WAITL
#undef LDK
#undef PK4
#undef VRDA
#undef VF
}
#undef SBAR
}

template <class RowMap>
__device__ __forceinline__ void transpose_item(const float* W, int ldn, int k0, int n0, bf16_t* WT, int ldt, int koff, const RowMap& rm, LAS float* scr, int lane) {
#pragma unroll 8
    for (int i = 0; i < 32; ++i) { const int kk = 2 * i + (lane >> 5); scr[kk * 33 + (lane & 31)] = W[(size_t)(k0 + kk) * ldn + n0 + (lane & 31)]; }
    LDS_WAIT(); asm volatile("" ::: "memory");
    const int c = lane & 7;
#pragma unroll
    for (int j = 0; j < 4; ++j) { const int n = (lane >> 3) + 8 * j; const LAS float* s = scr + (8 * c) * 33 + n;
        u32x4 o; o.x = cvt_pk_bf16(s[0 * 33], s[1 * 33]); o.y = cvt_pk_bf16(s[2 * 33], s[3 * 33]); o.z = cvt_pk_bf16(s[4 * 33], s[5 * 33]); o.w = cvt_pk_bf16(s[6 * 33], s[7 * 33]);
        *(u32x4*)(WT + (size_t)rm(n0 + n) * ldt + koff + k0 + 8 * c) = o; }
    LDS_WAIT(); asm volatile("" ::: "memory");
}
struct RowNat { __device__ __forceinline__ int operator()(int c) const { return c; } };
struct RowPerm { __device__ __forceinline__ int operator()(int c) const { return (c & ~31) | inv32(c & 31); } };
struct RowHead { __device__ __forceinline__ int operator()(int c) const { const int ci = c & 255; return (c & ~255) + 128 * ((ci >> 5) & 1) + 32 * (ci >> 6) + inv32(ci & 31); } };
struct RowP16 { __device__ __forceinline__ int operator()(int c) const { const int ci = c & 255; return (c & ~255) + 128 * ((ci >> 3) & 1) + 32 * (ci >> 6) + 16 * ((ci >> 2) & 1) + 4 * ((ci >> 4) & 3) + (ci & 3); } };
struct RowWin {
    __device__ __forceinline__ int operator()(int c) const {
        const int pn = c >> 8, ci = c & 255;
        const bool ropet = (pn >= 1 && pn <= 4) || (pn >= 9 && pn <= 16);
        if (pn == 0) { const int wc = ci >> 6, bj = (ci >> 5) & 1, p = ci & 31; return 128 * bj + 32 * wc + (wc < 2 ? p : inv32(p)); }
        if (ropet) { const int wc = ci >> 6, bj = (ci >> 5) & 1, p = ci & 31; return pn * 256 + 128 * bj + 32 * wc + p; }
        { const int wc = ci >> 6, bj = (ci >> 5) & 1, p = ci & 31; return pn * 256 + 128 * bj + 32 * wc + inv32(p); }
    }
};
struct RowGU { int up; __device__ __forceinline__ int operator()(int ch) const { const int pn = ch >> 7, c7 = ch & 127; return 256 * pn + 128 * up + (c7 & ~31) + inv32(c7 & 31); } };

__device__ __forceinline__ void modrow(const float* src, bf16_t* dst, const float* gain, const float* modr, const float* bada, int sh_off, int sc_off, int lane) {
    const f32x4* xr = (const f32x4*)src + lane;
    f32x4 v[4]; float s2 = 0.f;
#pragma unroll
    for (int j = 0; j < 4; ++j) { v[j] = xr[64 * j]; s2 += (v[j][0] * v[j][0] + v[j][1] * v[j][1]) + (v[j][2] * v[j][2] + v[j][3] * v[j][3]); }
    const float rstd = rsqrtf(wave_sum(s2) * (1.f / DM) + EPSN);
    u32x2* o8 = (u32x2*)dst + lane;
#pragma unroll
    for (int j = 0; j < 4; ++j) { const int k4 = (lane + 64 * j) * 4;
        const f32x4 g = *(const f32x4*)(gain + k4);
        const f32x4 sc = *(const f32x4*)(modr + sc_off + k4);
        const f32x4 sh = *(const f32x4*)(modr + sh_off + k4);
        const f32x4 hh = v[j] * rstd * g * (1.0f + sc) + sh;
        u32x2 w; w.x = cvt_pk_bf16(hh[0], hh[1]); w.y = cvt_pk_bf16(hh[2], hh[3]); o8[64 * j] = w; }
}

__device__ __forceinline__ void modrow2(const float* srcA, const float* srcB, bf16_t* dstA, bf16_t* dstB, const float* gain, const float* modA, const float* modB, int sh_off, int sc_off, int lane) {
    const f32x4* xa = (const f32x4*)srcA + lane; const f32x4* xb = (const f32x4*)srcB + lane;
    f32x4 va[4], vb[4]; float sa = 0.f, sb = 0.f;
#pragma unroll
    for (int j = 0; j < 4; ++j) { va[j] = __builtin_nontemporal_load(xa + 64 * j); vb[j] = __builtin_nontemporal_load(xb + 64 * j); }
#pragma unroll
    for (int j = 0; j < 4; ++j) { sa += (va[j][0] * va[j][0] + va[j][1] * va[j][1]) + (va[j][2] * va[j][2] + va[j][3] * va[j][3]); sb += (vb[j][0] * vb[j][0] + vb[j][1] * vb[j][1]) + (vb[j][2] * vb[j][2] + vb[j][3] * vb[j][3]); }
#pragma unroll
    for (int o = 1; o < 64; o <<= 1) { sa += __shfl_xor(sa, o); sb += __shfl_xor(sb, o); }
    const float ra = rsqrtf(sa * (1.f / DM) + EPSN), rb = rsqrtf(sb * (1.f / DM) + EPSN);
    u32x2* oa = (u32x2*)dstA + lane; u32x2* ob = (u32x2*)dstB + lane;
#pragma unroll
    for (int j = 0; j < 4; ++j) { const int k4 = (lane + 64 * j) * 4;
        const f32x4 g = *(const f32x4*)(gain + k4);
        const f32x4 ha = va[j] * ra * g * (1.0f + *(const f32x4*)(modA + sc_off + k4)) + *(const f32x4*)(modA + sh_off + k4);
        const f32x4 hb = vb[j] * rb * g * (1.0f + *(const f32x4*)(modB + sc_off + k4)) + *(const f32x4*)(modB + sh_off + k4);
        u32x2 wa; wa.x = cvt_pk_bf16(ha[0], ha[1]); wa.y = cvt_pk_bf16(ha[2], ha[3]); oa[64 * j] = wa;
        u32x2 wb; wb.x = cvt_pk_bf16(hb[0], hb[1]); wb.y = cvt_pk_bf16(hb[2], hb[3]); ob[64 * j] = wb; }
}

__device__ __forceinline__ void modrow2b(const bf16_t* srcA, const bf16_t* srcB, bf16_t* dstA, bf16_t* dstB, const float* gain, const float* modA, const float* modB, int sh_off, int sc_off, int lane) {
    const u32x2* xa = (const u32x2*)srcA + lane; const u32x2* xb = (const u32x2*)srcB + lane;
    u32x2 pa[4], pb[4]; f32x4 va[4], vb[4]; float sa = 0.f, sb = 0.f;
#pragma unroll
    for (int j = 0; j < 4; ++j) { pa[j] = __builtin_nontemporal_load(xa + 64 * j); pb[j] = __builtin_nontemporal_load(xb + 64 * j); }
#pragma unroll
    for (int j = 0; j < 4; ++j) { va[j] = (f32x4){bf_lo(pa[j].x), bf_hi(pa[j].x), bf_lo(pa[j].y), bf_hi(pa[j].y)}; vb[j] = (f32x4){bf_lo(pb[j].x), bf_hi(pb[j].x), bf_lo(pb[j].y), bf_hi(pb[j].y)};
        sa += (va[j][0] * va[j][0] + va[j][1] * va[j][1]) + (va[j][2] * va[j][2] + va[j][3] * va[j][3]); sb += (vb[j][0] * vb[j][0] + vb[j][1] * vb[j][1]) + (vb[j][2] * vb[j][2] + vb[j][3] * vb[j][3]); }
#pragma unroll
    for (int o = 1; o < 64; o <<= 1) { sa += __shfl_xor(sa, o); sb += __shfl_xor(sb, o); }
    const float ra = rsqrtf(sa * (1.f / DM) + EPSN), rb = rsqrtf(sb * (1.f / DM) + EPSN);
    u32x2* oa = (u32x2*)dstA + lane; u32x2* ob = (u32x2*)dstB + lane;
#pragma unroll
    for (int j = 0; j < 4; ++j) { const int k4 = (lane + 64 * j) * 4;
        const f32x4 g = *(const f32x4*)(gain + k4);
        const f32x4 ha = va[j] * ra * g * (1.0f + *(const f32x4*)(modA + sc_off + k4)) + *(const f32x4*)(modA + sh_off + k4);
        const f32x4 hb = vb[j] * rb * g * (1.0f + *(const f32x4*)(modB + sc_off + k4)) + *(const f32x4*)(modB + sh_off + k4);
        u32x2 wa; wa.x = cvt_pk_bf16(ha[0], ha[1]); wa.y = cvt_pk_bf16(ha[2], ha[3]); oa[64 * j] = wa;
        u32x2 wb; wb.x = cvt_pk_bf16(hb[0], hb[1]); wb.y = cvt_pk_bf16(hb[2], hb[3]); ob[64 * j] = wb; }
}

struct SchedP1 {
    int G, c; const char* A; const char* B;
    __device__ __forceinline__ bool next(int i, Unit& u) const {
        long L = (long)i * G + c; if (L >= 6472) return false;
        if (L < 6400) { int wgid = (int)L; { const int xcd = wgid % 8, off = wgid / 8; wgid = xcd * 800 + off; }
            const int gid = wgid / 200; u.pm = gid * 8 + ((wgid % 200) % 8); u.pn = (wgid % 200) / 8; }
        else { const int l2 = (int)(L - 6400); u.pm = 256 + l2 / 9; u.pn = l2 % 9; }
        u.A = A + (size_t)u.pm * 256 * 2048; u.B = B + (size_t)u.pn * 256 * 2048; u.tok = nullptr; u.x0 = 0; return true;
    }
};
struct SchedG1 {
    int t0, nu, r, W_; const char* A; const char* W; const int* texp; const int* rtok;
    __device__ __forceinline__ void init(int ntiles, int G, int v) { const int nx = G >= 8 ? 8 : 1, wpx = G / nx, x = v / wpx; r = v % wpx; W_ = wpx; const int base = ntiles / nx, rem = ntiles % nx; t0 = x * base + (x < rem ? x : rem); nu = 2 * (base + (x < rem ? 1 : 0)); }
    __device__ __forceinline__ bool next(int i, Unit& u) const {
        const int uu = i * W_ + r; if (uu >= nu) return false;
        const int tile = t0 + (uu >> 1); u.pm = tile; u.pn = uu & 1;
        const int e = texp[tile]; u.x0 = e;
        u.A = A; u.tok = rtok + (size_t)tile * 256; u.B = W + (size_t)e * (512 * 2048) + (size_t)u.pn * (256 * 2048); return true;
    }
};
struct SchedG2 {
    int t0, nu, r, W_; const char* A; const char* W; const int* texp; const char* Ws;
    __device__ __forceinline__ void init(int ntiles, int G, int v) { const int nx = G >= 8 ? 8 : 1, wpx = G / nx, x = v / wpx; r = v % wpx; W_ = wpx; const int base = ntiles / nx, rem = ntiles % nx; t0 = x * base + (x < rem ? x : rem); nu = 4 * (base + (x < rem ? 1 : 0)); }
    __device__ __forceinline__ bool next(int i, Unit& u) const {
        const int uu = i * W_ + r; if (uu >= nu) return false;
        const int tile = t0 + (nu >> 2) - 1 - (uu >> 2); u.pm = tile; u.pn = uu & 3;
        const int e = texp[tile]; u.x0 = e; u.tok = nullptr;
        u.A = A + (size_t)tile * 256 * 512; u.B = (e < NEXP ? W + (size_t)e * (1024 * 512) : Ws) + (size_t)u.pn * (256 * 512); return true;
    }
};

constexpr int NPHASE = 12;
struct Args { const float* in[30]; float* out; unsigned char* ws; int ph_lo, ph_hi, flags, pad; };
__global__ void __launch_bounds__(512, 2) fwd(Args args) {
    extern __shared__ __attribute__((aligned(16))) unsigned char lds[];
    LAS unsigned char* ldsl = (LAS unsigned char*)lds;
    volatile LAS unsigned* MISC = (volatile LAS unsigned*)(ldsl + MISC_OFF);
    const int wave = __builtin_amdgcn_readfirstlane(threadIdx.x >> 6);
#define TIDX (wave * 64 + lane_id())
    const int G = gridDim.x, bx = blockIdx.x;
    const int vcu = (G % 8 == 0) ? (bx % 8) * (G / 8) + bx / 8 : bx;
    unsigned char* ws = args.ws;
    unsigned* ctl = (unsigned*)(ws + WS_CTL);
    for (int u = TIDX; u < (LDS_BYTES - LDSCTL_OFF) / 4; u += 512) ((LAS unsigned*)(ldsl + LDSCTL_OFF))[u] = 0u;
    __syncthreads();
    XcdBarrier bar; bar.bar = ctl + CW_BAR; bar.x = 0; bar.st = nullptr;
#if MK_ONE_LAUNCH
    bar = xcd_barrier_post(ctl + CW_BAR, MISC + 8, TIDX == 0);
#define GRID_BAR() xcd_barrier(bar, TIDX == 0)
#else
#define GRID_BAR() do {} while (0)
#endif
    const int lo = args.ph_lo, hi = args.ph_hi;
#ifndef PH_MASK
#define PH_MASK 0xFFFFFFFFu
#endif
#define IN(k) (((PH_MASK >> (k)) & 1u) && lo <= (k) && (k) < hi)
#ifndef REP_MASK
#define REP_MASK 0u
#endif
#define NREP(k) ((((REP_MASK) >> (k)) & 1u) ? 2 : 1)
#define SEAM(k) do { if (IN(k) && IN((k) + 1)) GRID_BAR(); } while (0)
#define x_ (args.in[0])
#define cvec (args.in[1])
#define ctx (args.in[2])
#define c_ctx (args.in[3])
#define w_ada (args.in[4])
#define b_ada (args.in[5])
#define norm1_g (args.in[6])
#define norm2_g (args.in[7])
#define w_in (args.in[8])
#define modacc ((float*)(ws + WS_MOD))
#define Win_t ((bf16_t*)(ws + WS_WIN))
#define Wpab_t ((bf16_t*)(ws + WS_WPAB))
#define Wo_t ((bf16_t*)(ws + WS_WO))
#define Wr_t ((bf16_t*)(ws + WS_WR))
#define rope ((float*)(ws + WS_ROPE))
#define scal ((float*)(ws + WS_SCAL))
#define texp ((int*)(ws + WS_TEXP))
#define ridx ((int*)(ws + WS_IDX))
#define rwts ((float*)(ws + WS_WTS))
#define rrnk ((int*)(ws + WS_RNK))
#define wgb ((int*)(ws + WS_WGB))
#define rtok ((int*)(ws + WS_RTOK))
#define rw ((float*)(ws + WS_RW))
#define rdst ((int*)(ws + WS_RDST))
#define Hb ((bf16_t*)(ws + WS_H))
#define Qb ((bf16_t*)(ws + WS_Q))
#define KVAb ((bf16_t*)(ws + WS_KVA))
#define KBb ((bf16_t*)(ws + WS_KB))
#define VBb ((bf16_t*)(ws + WS_VB))
#define Gb ((bf16_t*)(ws + WS_G))
#define Zb ((bf16_t*)(ws + WS_H))
#define ACT ((bf16_t*)(ws + WS_ACT))
#define Wd_t ((bf16_t*)args.out)
#define Wds_t ((bf16_t*)(ws + WS_WDS))
#define X1 ((bf16_t*)(ws + WS_X1))
#define Wgu_t ((bf16_t*)(ws + WS_WGU))
#define H2 ((bf16_t*)(ws + WS_H2))
#define LT ((float*)(ws + WS_LT))
#define Y2 ((bf16_t*)(ws + WS_Y2))
#define cnt (ctl + CW_CNT)
    const int gw = vcu * 8 + wave, NGW = G * 8;

    if (IN(0)) {
        const int lane = lane_id(), tid = wave * 64 + lane;
        LAS float* sil = (LAS float*)ldsl;
        for (int i = tid; i < 9 * 1024; i += 512) { const int r = i >> 10, k = i & 1023; const float v = r < 8 ? cvec[r * 1024 + k] : c_ctx[k]; sil[i] = v / (1.0f + __expf(-v)); }
        __syncthreads();
        if (bx < 96) {
            LAS float* part = sil + 9 * 1024;
            const int j = bx * 64 + lane;
            float a[9];
#pragma unroll
            for (int r = 0; r < 9; ++r) a[r] = 0.f;
#pragma unroll 8
            for (int kk = 0; kk < 128; ++kk) { const int k = wave * 128 + kk; const float w = w_ada[(size_t)k * 6144 + j];
#pragma unroll
                for (int r = 0; r < 9; ++r) a[r] += sil[r * 1024 + k] * w; }
#pragma unroll
            for (int r = 0; r < 9; ++r) part[(wave * 9 + r) * 64 + lane] = a[r];
            __syncthreads();
            for (int i = tid; i < 9 * 64; i += 512) { const int r = i >> 6, l = i & 63; float sacc = 0.f;
#pragma unroll
                for (int w = 0; w < 8; ++w) sacc += part[(w * 9 + r) * 64 + l];
                modacc[r * 6144 + bx * 64 + l] = sacc + b_ada[bx * 64 + l]; }
        }
        __syncthreads();
        LAS float* scr = (LAS float*)(ldsl + wave * 16384);
        constexpr int I_IN = 16 * 200, I_SQ = 16 * 32, I_R = 16 * 8;
        for (int it = gw; it < I_IN + 3 * I_SQ + I_R; it += NGW) {
            int r = it;
            if (r < I_IN) { transpose_item(w_in, INW, 64 * (r / 200), 32 * (r % 200), Win_t, 1024, 0, RowWin{}, scr, lane); continue; } r -= I_IN;
            if (r < I_SQ) { transpose_item(args.in[19], 1024, 64 * (r / 32), 32 * (r % 32), Wpab_t, 2048, 0, RowHead{}, scr, lane); continue; } r -= I_SQ;
            if (r < I_SQ) { transpose_item(args.in[20], 1024, 64 * (r / 32), 32 * (r % 32), Wpab_t, 2048, 1024, RowHead{}, scr, lane); continue; } r -= I_SQ;
            if (r < I_SQ) { transpose_item(args.in[21], 1024, 64 * (r / 32), 32 * (r % 32), Wo_t, 1024, 0, RowHead{}, scr, lane); continue; } r -= I_SQ;
            transpose_item(args.in[22], 256, 64 * (r / 8), 32 * (r % 8), Wr_t, 1024, 0, RowNat{}, scr, lane);
        }
        for (int i = bx * 512 + tid; i < 2048; i += G * 512) { const int pos = i >> 4, j = i & 15; const float fr_ = powf(10000.0f, -(float)j / 16.0f); const float ang = (float)pos * fr_; rope[i] = cosf(ang); rope[2048 + i] = sinf(ang); }
        if (bx == 0 && wave == 0) {
            const float a = wave_sum(args.in[14][lane] * args.in[15][lane]), b2 = wave_sum(args.in[16][lane] * args.in[17][lane]);
            if (lane == 0) scal[0] = expf(a) - expf(b2) + 0.2f;
            float mq = fabsf(args.in[12][lane]), mk = fabsf(args.in[13][lane]);
#pragma unroll
            for (int o_ = 1; o_ < 64; o_ <<= 1) { mq = fmaxf(mq, __shfl_xor(mq, o_)); mk = fmaxf(mk, __shfl_xor(mk, o_)); }
            if (lane == 0) scal[2] = -11.55f * mq * mk;
            float aq = fabsf(args.in[9][lane]), ak = fabsf(args.in[10][lane]);
#pragma unroll
            for (int o_ = 1; o_ < 64; o_ <<= 1) { aq = fmaxf(aq, __shfl_xor(aq, o_)); ak = fmaxf(ak, __shfl_xor(ak, o_)); }
            if (lane == 0) scal[3] = -11.55f * aq * ak;
        }
        __syncthreads();
    }
    SEAM(0);

    if (IN(1)) {
        const int lane = lane_id();
        for (int m = gw; m < T; m += 2 * NGW) modrow2(x_ + (size_t)m * DM, x_ + (size_t)(m + NGW) * DM, Hb + (size_t)m * DM, Hb + (size_t)(m + NGW) * DM, norm1_g, modacc + (m >> 13) * 6144, modacc + ((m + NGW) >> 13) * 6144, 0, 1024, lane);
        for (int m = T + gw; m < TT; m += NGW) modrow(ctx + (size_t)(m - T) * DM, Hb + (size_t)m * DM, norm1_g, modacc + 8 * 6144, b_ada, 0, 1024, lane);
    }
    SEAM(1);

    if (IN(2)) {
        SchedP1 S{G, bx, (const char*)Hb, (const char*)Win_t};
        EpiP1 E{KVAb, KBb, VBb, Qb, Gb, args.in[9], args.in[10], args.in[12], args.in[13], rope, (args.flags >> 5) & 3};
        pg8::gemm_phase<EpiP1, SchedP1, true, false>(ldsl, 1024, S, E, wave);
    }
    SEAM(2);

    if (IN(3)) {
        const float lam = scal[0], negMb = scal[2];
        const int xq = vcu >> 5, rk = vcu & 31;
        if (G == 256) {
#ifdef PROBE_VAR
            for (int i = 0; i < 8; ++i) att::attnB7_unit<PROBE_VAR>(Qb, KBb, VBb, Qb, (xq * 8 + i) >> 3, (xq * 8 + i) & 7, rk, (char*)lds, lam, args.in[18], wave, lo > 0, 0, 0, 0, true, false);
#endif
            if (!(args.flags & 8)) { if (negMb > -100.f) { for (int i = 0; i < 8; ++i) att::attnB9_unit(Qb, KBb, VBb, Qb, (xq * 8 + i) >> 3, (xq * 8 + i) & 7, rk, (char*)lds, scal, args.in[18], wave, !(args.flags & 2), (xq * 8 + i + 1) >> 3, (xq * 8 + i + 1) & 7, rk, i == 0, i < 7); }
                else for (int i = 0; i < 16; ++i) { const int pair = xq * 8 + (i >> 1), qb = rk * 2 + (i & 1); att::attnB_unit(Qb, KBb, VBb, Qb, pair >> 3, pair & 7, qb, (char*)lds, lam, args.in[18], wave); } }
            if (!(args.flags & 4)) { if (scal[3] > -100.f) { bf16x8 qA[2][4]; for (int i = 0; i < 8; ++i) { const int uu = vcu * 8 + i, un = uu + 1; att::attnA5_unit(Qb, KVAb, Qb, uu >> 8, (uu >> 7) & 1, uu & 127, (char*)lds, args.in[11], wave, !(args.flags & 1), qA, i == 0, i < 7, un >> 8, (un >> 7) & 1, un & 127); } }
                else for (int i = 0; i < 16; ++i) { const int uu = vcu * 16 + i; att::attnA_unit(Qb, KVAb, Qb, uu >> 9, (uu >> 8) & 1, uu & 255, (char*)lds, args.in[11], wave, !(args.flags & 1)); } }
        } else {
            for (int uu = bx; uu < 4096; uu += G) att::attnB_unit(Qb, KBb, VBb, Qb, uu >> 9, (uu >> 6) & 7, uu & 63, (char*)lds, lam, args.in[18], wave);
            for (int uu = bx; uu < 4096; uu += G) att::attnA_unit(Qb, KVAb, Qb, uu >> 9, (uu >> 8) & 1, uu & 255, (char*)lds, args.in[11], wave);
        }
    }
    SEAM(3);

    if (IN(4)) {
        pg8::SchedMN S{256, 4, 1024, G, bx, 2048, (const char*)Qb, (const char*)Wpab_t};
        EpiZ E{Gb, Zb};
        pg8::gemm_phase<EpiZ, pg8::SchedMN, true, false>(ldsl, 2048, S, E, wave);
    }
    SEAM(4);

    if (IN(5)) {
        pg8::SchedMN S{256, 4, 1024, G, bx, 1024, (const char*)Zb, (const char*)Wo_t};
        EpiX1 E{x_, X1, modacc, b_ada};
        pg8::gemm_phase<EpiX1, pg8::SchedMN, true, false>(ldsl, 1024, S, E, wave);
    }
    SEAM(5);

    if (IN(6)) {
        const int lane = lane_id();
        LAS float* scr = (LAS float*)(ldsl + wave * 16384);
        {
            float va_[32], vb_[32];
#define CV_DESC(it_, src_, ldn_, k0_, n0_) const int e_##it_ = (it_) / 384, r_##it_ = (it_) % 384, mtx_##it_ = r_##it_ >> 7, q_##it_ = r_##it_ & 127; \
            const float* src_ = mtx_##it_ < 2 ? (e_##it_ < NEXP ? args.in[24 + mtx_##it_] + (size_t)e_##it_ * 262144 : args.in[27 + mtx_##it_]) : (e_##it_ < NEXP ? args.in[26] + (size_t)e_##it_ * 262144 : args.in[29]); \
            const int ldn_ = mtx_##it_ < 2 ? 256 : 1024, k0_ = mtx_##it_ < 2 ? 64 * (q_##it_ >> 3) : 64 * (q_##it_ >> 5), n0_ = mtx_##it_ < 2 ? 32 * (q_##it_ & 7) : 32 * (q_##it_ & 31);
#define CV_LOAD(v_, it_) do { CV_DESC(it_, s_, l_, k_, n_) \
            _Pragma("unroll") for (int i = 0; i < 32; ++i) v_[i] = __builtin_nontemporal_load(s_ + (size_t)(k_ + 2 * i + (lane >> 5)) * l_ + n_ + (lane & 31)); } while (0)
#define CV_STORE(v_, it_) do { CV_DESC(it_, s_, l_, k_, n_) (void)s_; (void)l_; \
            _Pragma("unroll") for (int i = 0; i < 32; ++i) scr[(2 * i + (lane >> 5)) * 33 + (lane & 31)] = v_[i]; \
            LDS_WAIT(); asm volatile("" ::: "memory"); \
            const int c_ = lane & 7; \
            _Pragma("unroll") for (int jj = 0; jj < 4; ++jj) { const int n = (lane >> 3) + 8 * jj; const LAS float* sp = scr + (8 * c_) * 33 + n; \
                u32x4 o; o.x = cvt_pk_bf16(sp[0 * 33], sp[1 * 33]); o.y = cvt_pk_bf16(sp[2 * 33], sp[3 * 33]); o.z = cvt_pk_bf16(sp[4 * 33], sp[5 * 33]); o.w = cvt_pk_bf16(sp[6 * 33], sp[7 * 33]); \
                if (mtx_##it_ < 2) { const RowGU rm{mtx_##it_}; *(u32x4*)(Wgu_t + (size_t)e_##it_ * 524288 + (size_t)rm(n_ + n) * 1024 + k_ + 8 * c_) = o; } \
                else { const RowP16 rm; *(u32x4*)((e_##it_ < NEXP ? Wd_t + (size_t)e_##it_ * 262144 : Wds_t) + (size_t)rm(n_ + n) * 256 + k_ + 8 * c_) = o; } } \
            LDS_WAIT(); asm volatile("" ::: "memory"); } while (0)
            const int NIT = NE1 * 384;
            int it = gw;
            if (it < NIT) CV_LOAD(va_, it);
            for (; it < NIT; it += 2 * NGW) {
                const int it1 = it + NGW, it2 = it + 2 * NGW;
                if (it1 < NIT) CV_LOAD(vb_, it1);
                CV_STORE(va_, it);
                if (it1 < NIT) { if (it2 < NIT) CV_LOAD(va_, it2); CV_STORE(vb_, it1); }
            }
#undef CV_DESC
#undef CV_LOAD
#undef CV_STORE
        }
            for (int m = gw; m < T; m += 2 * NGW) modrow2b(X1 + (size_t)m * DM, X1 + (size_t)(m + NGW) * DM, H2 + (size_t)m * DM, H2 + (size_t)(m + NGW) * DM, norm2_g, modacc + (m >> 13) * 6144, modacc + ((m + NGW) >> 13) * 6144, 3072, 4096, lane);
    }
    SEAM(6);

    if (IN(7)) {
        pg8::SchedMN S{256, 1, 256, G, bx, 1024, (const char*)H2, (const char*)Wr_t};
        EpiRoute E{args.in[23], ridx, rwts, rrnk, (args.flags & 16) ? wgb + 65536 : wgb, (args.flags & 16) ? cnt + 1024 : cnt};
        pg8::gemm_phase<EpiRoute, pg8::SchedMN, false, false>(ldsl, 1024, S, E, wave);
    }
    SEAM(7);

    if (IN(8)) {
        const int tid = TIDX;
        LAS int* pst = (LAS int*)ldsl;
        LAS int* pcn = pst + 512;
        if (tid < NEXP) pcn[tid] = ((int)cnt[tid] + 255) & ~255;
        __syncthreads();
        if (tid < 64) {
            const int a0 = pcn[4 * tid], a1 = pcn[4 * tid + 1], a2 = pcn[4 * tid + 2], a3 = pcn[4 * tid + 3];
            const int tot = a0 + a1 + a2 + a3; int inc = tot;
#pragma unroll
            for (int o = 1; o < 64; o <<= 1) { const int v = __shfl_up(inc, o); if (tid >= o) inc += v; }
            const int ex = inc - tot;
            pst[4 * tid] = ex; pst[4 * tid + 1] = ex + a0; pst[4 * tid + 2] = ex + a0 + a1; pst[4 * tid + 3] = ex + a0 + a1 + a2;
            if (tid == 63) { pst[256] = inc; pst[257] = inc + T; }
        }
        __syncthreads();
        for (int pm = bx; pm < 256; pm += G) {
            if (tid < 256) { const int t = pm * 256 + tid;
#pragma unroll
                for (int k = 0; k < 8; ++k) { const int e = ridx[t * 8 + k]; const int pos = pst[e] + wgb[pm * 256 + e] + rrnk[t * 8 + k]; rtok[pos] = t; rw[pos] = rwts[t * 8 + k]; rdst[pos] = t * NSLOT + k; }
                const int ps = pst[256] + t; rtok[ps] = t; rw[ps] = 1.0f; rdst[ps] = t * NSLOT + 8; }
        }
        for (int e = bx; e < NEXP; e += G) {
            const int c = (int)cnt[e], p0 = pst[e], p1 = pst[e + 1];
            for (int r = p0 + c + tid; r < p1; r += 512) { rtok[r] = 0; rw[r] = 0.f; rdst[r] = T * NSLOT; }
            for (int tl = (p0 >> 8) + tid; tl < (p1 >> 8); tl += 512) texp[tl] = e;
        }
        if (bx == 0) { for (int tl = (pst[256] >> 8) + tid; tl < (pst[257] >> 8); tl += 512) texp[tl] = 256; if (tid == 0) ((int*)scal)[1] = pst[257] >> 8; }
        __syncthreads();
    }
    SEAM(8);

    if (IN(9)) {
        const int ntiles = ((const int*)scal)[1];
        SchedG1 S{0, 0, 0, 0, (const char*)H2, (const char*)Wgu_t, texp, rtok}; S.init(ntiles, G, vcu);
        EpiAct E{ACT, rw};
        pg8::gemm_phase<EpiAct, SchedG1, true, true>(ldsl, 1024, S, E, wave);
    }
    SEAM(9);

    if (IN(10)) {
        const int ntiles = ((const int*)scal)[1];
        SchedG2 S{0, 0, 0, 0, (const char*)ACT, (const char*)Wd_t, texp, (const char*)Wds_t}; S.init(ntiles, G, vcu);
        EpiY2 E{(unsigned char*)Y2, rdst};
        pg8::gemm_phase<EpiY2, SchedG2, false, false>(ldsl, 256, S, E, wave);
    }
    SEAM(10);

    if (IN(11)) {
        const int lane = lane_id();
#define COMB_LOAD(P, t_) const unsigned char* P##yr = (const unsigned char*)Y2 + (size_t)(t_) * NSLOT * 1024 + lane * 16; u32x4 P##w[NSLOT]; \
            _Pragma("unroll") for (int k = 0; k < NSLOT; ++k) P##w[k] = __builtin_nontemporal_load((const u32x4*)(P##yr + k * 1024)); \
            float* P##op = args.out + (size_t)(t_) * DM + lane * 16; const u32x4* P##xp = (const u32x4*)(X1 + (size_t)(t_) * DM + lane * 16); const u32x4 P##xa = __builtin_nontemporal_load(P##xp), P##xb = __builtin_nontemporal_load(P##xp + 1); f32x4 P##x[4]; \
            P##x[0] = (f32x4){bf_lo(P##xa.x), bf_hi(P##xa.x), bf_lo(P##xa.y), bf_hi(P##xa.y)}; P##x[1] = (f32x4){bf_lo(P##xa.z), bf_hi(P##xa.z), bf_lo(P##xa.w), bf_hi(P##xa.w)}; P##x[2] = (f32x4){bf_lo(P##xb.x), bf_hi(P##xb.x), bf_lo(P##xb.y), bf_hi(P##xb.y)}; P##x[3] = (f32x4){bf_lo(P##xb.z), bf_hi(P##xb.z), bf_lo(P##xb.w), bf_hi(P##xb.w)};
#define COMB_DONE(P, t_) { const float* g2p = modacc + ((t_) >> 13) * 6144 + 5120 + lane * 16; \
            _Pragma("unroll") for (int q = 0; q < 4; ++q) { f32x4 s_ = {0.f, 0.f, 0.f, 0.f}; \
                _Pragma("unroll") for (int k = 0; k < NSLOT; ++k) { const f32x2 a = __builtin_amdgcn_cvt_pk_f32_fp8((int)P##w[k][q], false), b_ = __builtin_amdgcn_cvt_pk_f32_fp8((int)P##w[k][q], true); s_[0] += a[0]; s_[1] += a[1]; s_[2] += b_[0]; s_[3] += b_[1]; } \
                *(f32x4*)(P##op + 4 * q) = P##x[q] + *(const f32x4*)(g2p + 4 * q) * s_; } }
        for (int t = gw; t < T; t += 2 * NGW) {
            COMB_LOAD(a_, t) COMB_LOAD(b_, t + NGW)
            COMB_DONE(a_, t) COMB_DONE(b_, t + NGW)
        }
#undef COMB_LOAD
#undef COMB_DONE
    }
#undef IN
#undef SEAM
}

extern "C" void kernel_launch(void* const* d_in, const int* in_sizes, int n_in, void* d_out, int out_size, void* d_ws, size_t ws_size, hipStream_t stream) {
    static int grid = 0;
    if (grid == 0) {
        if (n_in != 30 || out_size != T * DM || ws_size < WS_END) { fprintf(stderr, "kernel_launch: unexpected shapes (n_in %d, out %d, ws %zu)\n", n_in, out_size, ws_size); grid = -1; return; }
        int dev = 0, cus = 0, per_cu = 0;
        if (hipGetDevice(&dev) != hipSuccess || hipDeviceGetAttribute(&cus, hipDeviceAttributeMultiprocessorCount, dev) != hipSuccess) { grid = -1; return; }
        if (hipFuncSetAttribute((const void*)fwd, hipFuncAttributeMaxDynamicSharedMemorySize, LDS_BYTES) != hipSuccess) { fprintf(stderr, "kernel_launch: hipFuncSetAttribute failed\n"); grid = -1; return; }
        if (hipOccupancyMaxActiveBlocksPerMultiprocessor(&per_cu, (const void*)fwd, 512, LDS_BYTES) != hipSuccess || per_cu < 1) fprintf(stderr, "kernel_launch: occupancy query reports %d\n", per_cu);
        (void)hipGetLastError();
        grid = cus;
    }
    if (grid < 0) return;
    if (hipMemsetAsync((char*)d_ws + WS_CTL, 0, CTL_BYTES, stream) != hipSuccess) return;
    Args a{};
    for (int i = 0; i < 30; ++i) a.in[i] = (const float*)d_in[i];
    a.out = (float*)d_out; a.ws = (unsigned char*)d_ws;
#if MK_ONE_LAUNCH
    a.ph_lo = 0; a.ph_hi = NPHASE;
    hipLaunchKernelGGL(fwd, dim3(grid), dim3(512), LDS_BYTES, stream, a);
#else
#ifdef PROBE_SEQ
    { const int seq[] = {PROBE_SEQ}; for (int k = 0; k < (int)(sizeof(seq) / sizeof(int)); ++k) { const int p = seq[k] & 0xff; a.ph_lo = p; a.ph_hi = p + 1; a.flags = seq[k] >> 8; hipLaunchKernelGGL(fwd, dim3(grid), dim3(512), LDS_BYTES, stream, a); } }
#else
    for (int p = 0; p < NPHASE; ++p) { a.ph_lo = p; a.ph_hi = p + 1; hipLaunchKernelGGL(fwd, dim3(grid), dim3(512), LDS_BYTES, stream, a); }
#endif
#endif
    const hipError_t le = hipPeekAtLastError();
    if (le != hipSuccess) fprintf(stderr, "kernel_launch: launch failed: %s\n", hipGetErrorName(le));
}
```

```cpp
#include <hip/hip_runtime.h>
#include <cstdio>
#include <cstdint>

#ifndef MK_ONE_LAUNCH
#define MK_ONE_LAUNCH 1
#endif

#define GAS __attribute__((address_space(1)))
#define LAS __attribute__((address_space(3)))
typedef unsigned short bf16_t;
typedef short bf16x8 __attribute__((ext_vector_type(8)));
typedef short s16x4 __attribute__((ext_vector_type(4)));
typedef float f32x4 __attribute__((ext_vector_type(4)));
typedef float f32x2 __attribute__((ext_vector_type(2)));
typedef float f32x16 __attribute__((ext_vector_type(16)));
typedef unsigned u32x4 __attribute__((ext_vector_type(4)));
typedef unsigned u32x2 __attribute__((ext_vector_type(2)));

constexpr int DM = 1024, NBATCH = 8, SEQ = 8192, CTXL = 256;
constexpr int T = NBATCH * SEQ;
constexpr int TC = NBATCH * CTXL;
constexpr int TT = T + TC;
constexpr int INW = 6400;
constexpr int NEXP = 256, NE1 = 257;
constexpr int DEXP = 256;
constexpr float EPSN = 1e-6f;
constexpr float QSCALE = 0.125f * 1.4426950408889634f;
constexpr int NSLOT = 9;
constexpr int PMAX = T * NSLOT + 256 * 256;

constexpr size_t MiB = 1u << 20;
constexpr size_t WS_CTL = 0, CTL_BYTES = 2 * MiB;
constexpr size_t WS_WIN = 2 * MiB;
constexpr size_t WS_WPAB = 15 * MiB;
constexpr size_t WS_WO = 19 * MiB;
constexpr size_t WS_WR = 21 * MiB;
constexpr size_t WS_ROPE = 22 * MiB;
constexpr size_t WS_SCAL = 22 * MiB + 65536;
constexpr size_t WS_TEXP = 22 * MiB + 131072;
constexpr size_t WS_MOD = 22 * MiB + 262144;
constexpr size_t WS_IDX = 23 * MiB;
constexpr size_t WS_WTS = 25 * MiB;
constexpr size_t WS_RNK = 27 * MiB;
constexpr size_t WS_WGB = 29 * MiB;
constexpr size_t WS_RTOK = 30 * MiB;
constexpr size_t WS_RW = 33 * MiB;
constexpr size_t WS_RDST = 36 * MiB;
constexpr size_t WS_H = 40 * MiB;
constexpr size_t WS_Q = 172 * MiB;
constexpr size_t WS_KVA = 428 * MiB;
constexpr size_t WS_KB = 461 * MiB;
constexpr size_t WS_VB = 593 * MiB;
constexpr size_t WS_G = 725 * MiB;
constexpr size_t WS_ACT = 40 * MiB;
constexpr size_t WS_X1 = 360 * MiB;
constexpr size_t WS_WDS = 488 * MiB;
constexpr size_t WS_WGU = 489 * MiB;
constexpr size_t WS_H2 = 746 * MiB;
constexpr size_t WS_LT = 874 * MiB;
constexpr size_t WS_Y2 = 489 * MiB;
constexpr size_t WS_END = 1066 * MiB;
static_assert(WS_Y2 + ((size_t)T * NSLOT + 1) * 1024 <= WS_END, "Y2 overlay");
static_assert(WS_ACT + (size_t)PMAX * 512 <= WS_X1 && WS_X1 + (size_t)T * 2048 <= WS_WDS && WS_WDS + (size_t)1024 * 512 <= WS_WGU && WS_WGU + (size_t)NE1 * 512 * 2048 <= WS_H2, "moe map");
static_assert(WS_RTOK + (size_t)PMAX * 4 <= WS_RW && WS_RW + (size_t)PMAX * 4 <= WS_RDST && WS_RDST + (size_t)PMAX * 4 <= WS_H, "routing map");

constexpr int CW_TMO = 0;
constexpr int CW_BAR = 4096;
constexpr int CW_CNT = 16384;
constexpr int CW_MOD = 32768;
static_assert((CW_MOD + 9 * 6144) * 4 <= (int)CTL_BYTES, "ctl");

constexpr int RING_BYTES = 131072;
constexpr int LDSCTL_OFF = RING_BYTES, MISC_OFF = LDSCTL_OFF + 320;
constexpr int LDS_BYTES = 163840;

#define LDS_WAIT() asm volatile("s_waitcnt lgkmcnt(0)" ::: "memory")
#define VM_WAIT() asm volatile("s_waitcnt vmcnt(0)" ::: "memory")
__device__ __forceinline__ unsigned cvt_pk_bf16(float lo, float hi) { unsigned r; asm volatile("v_cvt_pk_bf16_f32 %0, %1, %2" : "=v"(r) : "v"(lo), "v"(hi)); return r; }
__device__ __forceinline__ float bf_lo(unsigned w) { return __uint_as_float(w << 16); }
__device__ __forceinline__ float bf_hi(unsigned w) { return __uint_as_float(w & 0xffff0000u); }
__device__ __forceinline__ float wave_sum(float v) {
#pragma unroll
    for (int o = 1; o < 64; o <<= 1) v += __shfl_xor(v, o);
    return v;
}
__device__ __forceinline__ int lane_id() { int l; asm volatile("v_mbcnt_lo_u32_b32 %0, -1, 0\n\tv_mbcnt_hi_u32_b32 %0, -1, %0" : "=v"(l)); return l; }
__device__ __forceinline__ float sigmoidf_(float x) { return __builtin_amdgcn_rcpf(1.0f + __builtin_amdgcn_exp2f(x * -1.4426950408889634f)); }

#define XB_TMO      128
#define XB_XCNT(j)  (256  + 64 * (j))
#define XB_XSUB(j)  (1280 + 64 * (j))
#define XB_XGEN(j)  (2304 + 64 * (j))
#define XB_TOP      3328
#define XB_TOPGEN   3392
#define XCD_BAR_WORDS 3456
#define XB_SPIN_CAP (1u << 18)
__device__ __forceinline__ unsigned xb_ld(unsigned* p)              { return __hip_atomic_load(p, __ATOMIC_RELAXED, __HIP_MEMORY_SCOPE_AGENT); }
__device__ __forceinline__ unsigned xb_add(unsigned* p, unsigned v) { return __hip_atomic_fetch_add(p, v, __ATOMIC_RELAXED, __HIP_MEMORY_SCOPE_AGENT); }
__device__ __forceinline__ unsigned xb_xcc_id() { return (unsigned)__builtin_amdgcn_s_getreg((3 << 11) | 20) & 0xFu; }
#define XB_SPIN(cond, bar) do { unsigned _sp = 0; while (cond) { __builtin_amdgcn_s_sleep(1); \
    if ((++_sp & 255u) == 0u) { if (xb_ld(&(bar)[XB_TMO])) break; if (_sp > XB_SPIN_CAP) { atomicAdd(&(bar)[XB_TMO], 1u); break; } } } } while (0)
struct XcdBarrier { unsigned* bar; unsigned x; volatile LAS unsigned* st; };
__device__ __forceinline__ XcdBarrier xcd_barrier_post(unsigned* bar, volatile LAS unsigned* st, bool leader) {
    XcdBarrier b; b.bar = bar; b.x = xb_xcc_id(); b.st = st;
    if (leader) (void)xb_add(&bar[XB_XCNT(b.x)], 1u);
    return b;
}
__device__ __forceinline__ void xcd_barrier_complete(unsigned* bar, unsigned x, unsigned& nloc, unsigned& nx) {
    const unsigned G = gridDim.x * gridDim.y * gridDim.z;
    unsigned sum, cnt, mine, sp = 0u;
    for (;;) {
        sum = 0u; cnt = 0u; mine = 0u;
#pragma unroll
        for (unsigned j = 0; j < 16; ++j) { const unsigned c = xb_ld(&bar[XB_XCNT(j)]); sum += c; cnt += (c > 0u) ? 1u : 0u; mine = (j == x) ? c : mine; }
        if (sum == G) break;
        __builtin_amdgcn_s_sleep(1);
        if ((++sp & 255u) == 0u) { if (xb_ld(&bar[XB_TMO])) break; if (sp > XB_SPIN_CAP) { atomicAdd(&bar[XB_TMO], 1u); break; } }
    }
    nloc = mine > 0u ? mine : 1u; nx = cnt > 0u ? cnt : 1u;
}
__device__ __forceinline__ void xcd_barrier(const XcdBarrier& b, bool leader) {
    asm volatile("s_waitcnt vmcnt(0)" ::: "memory");
    __syncthreads();
    if (leader) {
        unsigned* bar = b.bar;
        __builtin_amdgcn_s_waitcnt(0);
        unsigned nloc = b.st[0], nx = b.st[1];
        if (nloc == 0u) { xcd_barrier_complete(bar, b.x, nloc, nx); b.st[0] = nloc; b.st[1] = nx; }
        const unsigned old = xb_add(&bar[XB_XSUB(b.x)], 1u);
        const unsigned gen = old / nloc;
        if (old + 1u == (gen + 1u) * nloc) {
            __builtin_amdgcn_fence(__ATOMIC_RELEASE, "agent");
            asm volatile("s_waitcnt vmcnt(0)" ::: "memory");
            const unsigned og = xb_add(&bar[XB_TOP], 1u);
            const unsigned tg = og / nx;
            if (og + 1u == (tg + 1u) * nx) xb_add(&bar[XB_TOPGEN], 1u);
            else XB_SPIN(xb_ld(&bar[XB_TOPGEN]) == tg, bar);
            __builtin_amdgcn_fence(__ATOMIC_ACQUIRE, "agent");
            xb_add(&bar[XB_XGEN(b.x)], 1u);
            asm volatile("s_waitcnt vmcnt(0)" ::: "memory");
        } else {
            XB_SPIN(xb_ld(&bar[XB_XGEN(b.x)]) == gen, bar);
            __builtin_amdgcn_fence(__ATOMIC_ACQUIRE, "agent");
            asm volatile("s_waitcnt vmcnt(0)" ::: "memory");
        }
    }
    __syncthreads();
}

__device__ __forceinline__ void glds16_sv(const void* sbase, unsigned voff, unsigned lds_dst) { unsigned keep;
    asm volatile("s_mov_b32 %0, m0\n\ts_mov_b32 m0, %3\n\ts_nop 0\n\tglobal_load_lds_dwordx4 %1, %2\n\ts_mov_b32 m0, %0" : "=&s"(keep) : "v"(voff), "s"(sbase), "s"(lds_dst) : "memory"); }
__device__ __forceinline__ void glds4_sv(const void* sbase, unsigned voff, unsigned lds_dst) { unsigned keep;
    asm volatile("s_mov_b32 %0, m0\n\ts_mov_b32 m0, %3\n\ts_nop 0\n\tglobal_load_lds_dword %1, %2\n\ts_mov_b32 m0, %0" : "=&s"(keep) : "v"(voff), "s"(sbase), "s"(lds_dst) : "memory"); }
constexpr int EPI_TAB_OFF = 139264;
constexpr int TOK_TAB_OFF = EPI_TAB_OFF + 2048;
constexpr int EXP_TAB_OFF = EPI_TAB_OFF + 4096;
namespace pg8 {
constexpr int BM = 256, BK = 64, HALF = 128, HTB = HALF * BK * 2, STAGE_BYTES = 8 * HTB;
__host__ __device__ __forceinline__ int lds_byte(int r, int c) { const int st = (r >> 4) * 2 + (c >> 5), rr = r & 15, cc = c & 31, ob = rr * 64 + cc * 2; return st * 1024 + (ob ^ (((ob >> 9) & 1) << 5)); }
__host__ __device__ __forceinline__ void stage_rc(int b, int& R, int& C) { const int st = b / 1024, sb = b % 1024, swz = sb ^ (((sb >> 9) & 1) << 5); R = (st >> 1) * 16 + swz / 64; C = (st & 1) * 32 + (swz % 64) / 2; }

struct Unit { const char* A; const char* B; const int* tok; int pm, pn, x0; };

template <class Epi, class Sched, bool ALIGN_EPI, bool GATHER>
__device__ __forceinline__ void gemm_phase(LAS unsigned char* lds, const int K, const Sched& S, const Epi& E, const int wid) {
    const int lane = lane_id(), tid = wid * 64 + lane, wr = wid >> 2, wc = wid & 3, fr = lane & 15, fq = lane >> 4;
    const int nt = K / BK;
    unsigned voffA[2], voffB[2]; int RA[2], CA[2];
#pragma unroll
    for (int i = 0; i < 2; ++i) { int R, C; stage_rc(tid * 16 + i * 8192, R, C); RA[i] = R; CA[i] = C; voffA[i] = (unsigned)(R * K + C) * 2u; voffB[i] = voffA[i]; }
    const size_t kstep = (size_t)(BK * 2);
    const size_t hstep = (size_t)HALF * K * 2;
    const unsigned ldsw = (unsigned)wid * 1024u;
    const unsigned ldsb = (unsigned)(uintptr_t)lds + ldsw;
    const int aoff = lds_byte(wr * 64 + fr, fq * 8), boff = lds_byte(wc * 32 + fr, fq * 8);
#define PG8_SA(b, h) (((b) * 2 + (h)) * HTB)
#define PG8_SB(b, h) ((4 + (b) * 2 + (h)) * HTB)
#define PG8_STAGE(bufoff, gbase, voff) do { _Pragma("unroll") for (int _i = 0; _i < 2; ++_i) \
        glds16_sv((const void*)(gbase), (voff)[_i], ldsb + (unsigned)((bufoff) + _i * 8192)); } while (0)
#define PG8_LDA(dst, b, h) do { _Pragma("unroll") for (int m = 0; m < 4; ++m) _Pragma("unroll") for (int k = 0; k < 2; ++k) dst[m][k] = *(const LAS bf16x8*)(lds + PG8_SA(b, h) + aoff + m * 2048 + k * 1024); } while (0)
#define PG8_LDB(dst, b, h) do { _Pragma("unroll") for (int n = 0; n < 2; ++n) _Pragma("unroll") for (int k = 0; k < 2; ++k) dst[n][k] = *(const LAS bf16x8*)(lds + PG8_SB(b, h) + boff + n * 2048 + k * 1024); } while (0)
#define PG8_MMA(ai, bj, At, Bt) do { __builtin_amdgcn_s_setprio(1); _Pragma("unroll") for (int m = 0; m < 4; ++m) _Pragma("unroll") for (int n = 0; n < 2; ++n) _Pragma("unroll") for (int k = 0; k < 2; ++k) \
        acc[ai][bj][m][n] = __builtin_amdgcn_mfma_f32_16x16x32_bf16(Bt[n][k], At[m][k], acc[ai][bj][m][n], 0, 0, 0); __builtin_amdgcn_s_setprio(0); } while (0)
#define PG8_MMAZ(ai, bj, At, Bt) do { __builtin_amdgcn_s_setprio(1); _Pragma("unroll") for (int m = 0; m < 4; ++m) _Pragma("unroll") for (int n = 0; n < 2; ++n) { \
        acc[ai][bj][m][n] = __builtin_amdgcn_mfma_f32_16x16x32_bf16(Bt[n][0], At[m][0], (f32x4){0.f, 0.f, 0.f, 0.f}, 0, 0, 0); acc[ai][bj][m][n] = __builtin_amdgcn_mfma_f32_16x16x32_bf16(Bt[n][1], At[m][1], acc[ai][bj][m][n], 0, 0, 0); } __builtin_amdgcn_s_setprio(0); } while (0)
#define PG8_WAIT_V(n) asm volatile("s_waitcnt vmcnt(" #n ")" ::: "memory")
#define PG8_WAIT_L(n) asm volatile("s_waitcnt lgkmcnt(" #n ")" ::: "memory")
#define PG8_BAR __builtin_amdgcn_s_barrier()
#define PG8_SCHED __builtin_amdgcn_sched_barrier(0)
    Unit cur, nxt; int ui = 0;
    if (!S.next(0, cur)) return;
    f32x4 acc[2][2][4][2];
    bf16x8 At[4][2], B0[2][2], B1[2][2];
    const char *cA0, *cA1, *nA0, *nA1; const char* cB = cur.B; const char* nB;
    unsigned cv0[2] = {0u, 0u}, cv1[2] = {0u, 0u}, nv0[2] = {0u, 0u}, nv1[2] = {0u, 0u};
#define PG8_SEL(g) { GATHER ? (g)[0] : voffA[0], GATHER ? (g)[1] : voffA[1] }
    if constexpr (GATHER) {
        cA0 = cur.A; cA1 = cur.A;
#pragma unroll
        for (int i = 0; i < 2; ++i) { cv0[i] = (unsigned)cur.tok[RA[i]] * (unsigned)(K * 2) + (unsigned)CA[i] * 2u; cv1[i] = (unsigned)cur.tok[HALF + RA[i]] * (unsigned)(K * 2) + (unsigned)CA[i] * 2u; }
    } else {
        cA0 = cur.A; cA1 = cur.A + hstep;
    }
    { const unsigned p0_[2] = PG8_SEL(cv0), p1_[2] = PG8_SEL(cv1);
    PG8_STAGE(PG8_SB(0, 0), cB, voffB); PG8_STAGE(PG8_SB(0, 1), cB + hstep, voffB); PG8_STAGE(PG8_SA(0, 0), cA0, p0_); PG8_STAGE(PG8_SA(0, 1), cA1, p1_);
    if (wr == 1) PG8_BAR;
    PG8_WAIT_V(2); PG8_BAR;
    PG8_STAGE(PG8_SB(1, 0), cB + kstep, voffB); PG8_STAGE(PG8_SA(1, 0), cA0 + kstep, p0_); PG8_STAGE(PG8_SB(1, 1), cB + hstep + kstep, voffB); }
    PG8_WAIT_V(6); PG8_BAR;
    for (;;) {
        const bool has_next = S.next(ui + 1, nxt);
        if (has_next) {
            nB = nxt.B;
            if constexpr (GATHER) {
                nA0 = nxt.A; nA1 = nxt.A;
                if (wid < 4) glds4_sv((const void*)nxt.tok, (unsigned)(wid * 64 + lane_id()) * 4u, (unsigned)(uintptr_t)lds + (unsigned)(TOK_TAB_OFF + ((ui + 1) & 1) * 1024 + wid * 256));
            } else {
                nA0 = nxt.A; nA1 = nxt.A + hstep;
            }
        } else {
            nB = cB; nA0 = cA0; nA1 = cA1;
            if constexpr (GATHER) {
#pragma unroll
                for (int i = 0; i < 2; ++i) { nv0[i] = cv0[i]; nv1[i] = cv1[i]; } }
        }
        { const int t = 0;
            const bool last = (t == nt - 2);
            if constexpr (Epi::HAS_PRE) { if (t == 0) E.pre(cur, ui, wid, (unsigned)(uintptr_t)lds); }
            if constexpr (Epi::HAS_MID) { if (t == nt / 2) E.mid(acc, cur, wr, wc, fr, fq); }
            const char* a1h1 = cA1 + (size_t)(t + 1) * kstep;
            const char* a2h0 = last ? nA0 : cA0 + (size_t)(t + 2) * kstep;
            const char* a2h1 = last ? nA1 : cA1 + (size_t)(t + 2) * kstep;
            const char* b2 = last ? nB : cB + (size_t)(t + 2) * kstep;
            const char* a3h0 = a2h0 + kstep; const char* b3 = b2 + kstep;
            const unsigned x0[2] = { GATHER ? (last ? nv0[0] : cv0[0]) : voffA[0], GATHER ? (last ? nv0[1] : cv0[1]) : voffA[1] };
            const unsigned x1[2] = { GATHER ? (last ? nv1[0] : cv1[0]) : voffA[0], GATHER ? (last ? nv1[1] : cv1[1]) : voffA[1] };
            const unsigned c1_[2] = PG8_SEL(cv1);
            PG8_LDB(B0, 0, 0); PG8_LDB(B1, 0, 1); PG8_SCHED; PG8_LDA(At, 0, 0); PG8_STAGE(PG8_SA(1, 1), a1h1, c1_);
            PG8_WAIT_V(8); PG8_WAIT_L(0); PG8_BAR; PG8_MMAZ(0, 0, At, B0); PG8_MMAZ(0, 1, At, B1); PG8_BAR; PG8_SCHED;
            PG8_LDA(At, 0, 1); PG8_STAGE(PG8_SB(0, 0), b2, voffB); PG8_STAGE(PG8_SB(0, 1), b2 + hstep, voffB); PG8_STAGE(PG8_SA(0, 0), a2h0, x0);
            PG8_WAIT_V(8); PG8_WAIT_L(0); PG8_BAR; PG8_MMAZ(1, 0, At, B0); PG8_MMAZ(1, 1, At, B1); PG8_BAR; PG8_SCHED;
            PG8_LDB(B0, 1, 0); PG8_LDB(B1, 1, 1); PG8_SCHED; PG8_LDA(At, 1, 0); PG8_STAGE(PG8_SA(0, 1), a2h1, x1);
            PG8_WAIT_V(8); PG8_WAIT_L(0); PG8_BAR; PG8_MMA(0, 0, At, B0); PG8_MMA(0, 1, At, B1); PG8_BAR; PG8_SCHED;
            PG8_LDA(At, 1, 1); PG8_STAGE(PG8_SB(1, 0), b3, voffB); PG8_STAGE(PG8_SB(1, 1), b3 + hstep, voffB); PG8_STAGE(PG8_SA(1, 0), a3h0, x0);
            PG8_WAIT_V(8); PG8_WAIT_L(0); PG8_BAR; PG8_MMA(1, 0, At, B0); PG8_MMA(1, 1, At, B1); PG8_BAR; PG8_SCHED;
        }
#pragma unroll 1
        for (int t = 2; t < nt; t += 2) {
            const bool last = (t == nt - 2);
            if constexpr (GATHER) { if (last && has_next) { const LAS int* tb_ = (const LAS int*)(lds + TOK_TAB_OFF + ((ui + 1) & 1) * 1024);
#pragma unroll
                for (int i = 0; i < 2; ++i) { nv0[i] = (unsigned)tb_[RA[i]] * (unsigned)(K * 2) + (unsigned)CA[i] * 2u; nv1[i] = (unsigned)tb_[HALF + RA[i]] * (unsigned)(K * 2) + (unsigned)CA[i] * 2u; } } }
            if constexpr (Epi::HAS_PRE) { if (t == 0) E.pre(cur, ui, wid, (unsigned)(uintptr_t)lds); }
            if constexpr (Epi::HAS_MID) { if (t == nt / 2) E.mid(acc, cur, wr, wc, fr, fq); }
            const char* a1h1 = cA1 + (size_t)(t + 1) * kstep;
            const char* a2h0 = last ? nA0 : cA0 + (size_t)(t + 2) * kstep;
            const char* a2h1 = last ? nA1 : cA1 + (size_t)(t + 2) * kstep;
            const char* b2 = last ? nB : cB + (size_t)(t + 2) * kstep;
            const char* a3h0 = a2h0 + kstep; const char* b3 = b2 + kstep;
            const unsigned x0[2] = { GATHER ? (last ? nv0[0] : cv0[0]) : voffA[0], GATHER ? (last ? nv0[1] : cv0[1]) : voffA[1] };
            const unsigned x1[2] = { GATHER ? (last ? nv1[0] : cv1[0]) : voffA[0], GATHER ? (last ? nv1[1] : cv1[1]) : voffA[1] };
            const unsigned c1_[2] = PG8_SEL(cv1);
            PG8_LDB(B0, 0, 0); PG8_LDB(B1, 0, 1); PG8_SCHED; PG8_LDA(At, 0, 0); PG8_STAGE(PG8_SA(1, 1), a1h1, c1_);
            PG8_WAIT_V(8); PG8_WAIT_L(0); PG8_BAR; PG8_MMA(0, 0, At, B0); PG8_MMA(0, 1, At, B1); PG8_BAR; PG8_SCHED;
            PG8_LDA(At, 0, 1); PG8_STAGE(PG8_SB(0, 0), b2, voffB); PG8_STAGE(PG8_SB(0, 1), b2 + hstep, voffB); PG8_STAGE(PG8_SA(0, 0), a2h0, x0);
            PG8_WAIT_V(8); PG8_WAIT_L(0); PG8_BAR; PG8_MMA(1, 0, At, B0); PG8_MMA(1, 1, At, B1); PG8_BAR; PG8_SCHED;
            PG8_LDB(B0, 1, 0); PG8_LDB(B1, 1, 1); PG8_SCHED; PG8_LDA(At, 1, 0); PG8_STAGE(PG8_SA(0, 1), a2h1, x1);
            PG8_WAIT_V(8); PG8_WAIT_L(0); PG8_BAR; PG8_MMA(0, 0, At, B0); PG8_MMA(0, 1, At, B1); PG8_BAR; PG8_SCHED;
            PG8_LDA(At, 1, 1); PG8_STAGE(PG8_SB(1, 0), b3, voffB); PG8_STAGE(PG8_SB(1, 1), b3 + hstep, voffB); PG8_STAGE(PG8_SA(1, 0), a3h0, x0);
            PG8_WAIT_V(8); PG8_WAIT_L(0); PG8_BAR; PG8_MMA(1, 0, At, B0); PG8_MMA(1, 1, At, B1); PG8_BAR; PG8_SCHED;
        }
        if constexpr (ALIGN_EPI) { if (wr == 0) PG8_BAR; }
        if constexpr (!Epi::AFTER_DRAIN) { if constexpr (Epi::HAS_PRE) E.run(acc, cur, wr, wc, fr, fq, lds, ui); else E(acc, cur, wr, wc, fr, fq); }
        if (!has_next) break;
        cur = nxt; cA0 = nA0; cA1 = nA1; cB = nB; ++ui;
        if constexpr (GATHER) {
#pragma unroll
            for (int i = 0; i < 2; ++i) { cv0[i] = nv0[i]; cv1[i] = nv1[i]; } }
        if constexpr (ALIGN_EPI) { if (wr == 1) PG8_BAR; }
    }
    PG8_WAIT_V(0);
    if constexpr (!ALIGN_EPI) { if (wr == 0) PG8_BAR; }
    PG8_BAR;
    if constexpr (Epi::AFTER_DRAIN) { E.fused(acc, cur, wr, wc, fr, fq, lds, wid, lane); }
#undef PG8_SA
#undef PG8_SB
#undef PG8_STAGE
#undef PG8_LDA
#undef PG8_LDB
#undef PG8_MMA
#undef PG8_MMAZ
#undef PG8_WAIT_V
#undef PG8_WAIT_L
#undef PG8_BAR
#undef PG8_SCHED
#undef PG8_SEL
}

struct SchedMN {
    int nM, nN, nwg, G, c, K; const char* A; const char* B;
    __device__ __forceinline__ bool next(int i, Unit& u) const {
        const long L = (long)i * G + c; if (L >= nwg) return false;
        int wgid = (int)L; { const int q = nwg / 8, r = nwg % 8, xcd = wgid % 8, off = wgid / 8; wgid = (xcd < r ? xcd * (q + 1) : r * (q + 1) + (xcd - r) * q) + off; }
        const int nig = 8 * nN, gid = wgid / nig, fm = gid * 8, gsz = (nM - fm) < 8 ? (nM - fm) : 8;
        u.pm = fm + ((wgid % nig) % gsz); u.pn = (wgid % nig) / gsz;
        u.A = A + (size_t)u.pm * 256 * K * 2; u.B = B + (size_t)u.pn * 256 * K * 2; u.tok = nullptr; u.x0 = 0; return true;
    }
};
}

using pg8::Unit;
__host__ __device__ __forceinline__ int inv32(int p) { return 16 * ((p >> 2) & 1) + 4 * (p >> 3) + (p & 3); }

struct EpiP1 {
    static constexpr bool AFTER_DRAIN = false, HAS_MID = false; static constexpr bool HAS_PRE = false;
    bf16_t *KVA, *KB, *VB, *Q, *G; const float *qna, *kna, *qnb, *knb; const float* rope; int skip;
    __device__ __forceinline__ void operator()(const f32x4 (&acc)[2][2][4][2], const Unit& u, int wr, int wc, int fr, int fq) const {
        if (skip == 1) { if (acc[0][0][0][0][0] == 1.2345e-30f) KVA[0] = 0; return; }
        const int pn = u.pn; const int row0 = u.pm * 256 + wr * 64 + fr;
        int kind;
        bf16_t* dst; int ld; int coloff; const float* gain = nullptr; float qs = 1.0f;
        if (pn == 0) { dst = KVA; ld = 256; coloff = 0; if (wc < 2) { kind = 0; gain = kna; } else kind = 3; }
        else if (pn < 5) { dst = KB; ld = 1024; coloff = 256 * (pn - 1); kind = 0; gain = knb; }
        else if (pn < 9) { dst = VB; ld = 1024; coloff = 256 * (pn - 5); kind = 1; }
        else if (pn < 13) { dst = Q; ld = 2048; coloff = 256 * (pn - 9); kind = 0; gain = qna; qs = QSCALE; }
        else if (pn < 17) { dst = Q; ld = 2048; coloff = 1024 + 256 * (pn - 13); kind = 0; gain = qnb; qs = QSCALE; }
        else { dst = G; ld = 2048; coloff = 256 * (pn - 17); kind = 2; }
        if (kind == 0) {
            const bool latent = u.pm < 256;
            f32x4 g[2][2];
#pragma unroll
            for (int bj = 0; bj < 2; ++bj)
#pragma unroll
                for (int n = 0; n < 2; ++n) g[bj][n] = *(const f32x4*)(gain + 32 * bj + 16 * n + 4 * fq);
            f32x4 cA[2], sA[2], cB[4], sB[4];
            if (latent) {
#pragma unroll
                for (int ai = 0; ai < 2; ++ai) { const int pos = ((row0 + ai * 128) & (SEQ - 1)) >> 6; cA[ai] = *(const f32x4*)(rope + pos * 16 + 4 * fq); sA[ai] = *(const f32x4*)(rope + 2048 + pos * 16 + 4 * fq); }
#pragma unroll
                for (int m = 0; m < 4; ++m) { const int pos = (row0 + m * 16) & 63; cB[m] = *(const f32x4*)(rope + pos * 16 + 4 * fq); sB[m] = *(const f32x4*)(rope + 2048 + pos * 16 + 4 * fq); }
            }
#pragma unroll
            for (int ai = 0; ai < 2; ++ai)
#pragma unroll
                for (int m = 0; m < 4; ++m) {
                    const int row = row0 + ai * 128 + m * 16;
                    float ss = 0.f;
#pragma unroll
                    for (int bj = 0; bj < 2; ++bj)
#pragma unroll
                        for (int n = 0; n < 2; ++n) { const f32x4 v = acc[ai][bj][m][n]; ss += (v[0] * v[0] + v[1] * v[1]) + (v[2] * v[2] + v[3] * v[3]); }
                    ss += __shfl_xor(ss, 16); ss += __shfl_xor(ss, 32);
                    const float rs = rsqrtf(ss * (1.0f / 64.0f) + EPSN) * qs;
#pragma unroll
                    for (int bj = 0; bj < 2; ++bj) {
                        f32x4 y0 = acc[ai][bj][m][0] * rs * g[bj][0], y1 = acc[ai][bj][m][1] * rs * g[bj][1];
                        f32x4 o0 = y0, o1 = y1;
                        if (latent) {
                            const f32x4 cs = (bj == 0) ? cA[ai] : cB[m], sn = (bj == 0) ? sA[ai] : sB[m];
                            o0 = y0 * cs - y1 * sn; o1 = y1 * cs + y0 * sn;
                        }
                        u32x4 w; w.x = cvt_pk_bf16(o0[0], o0[1]); w.y = cvt_pk_bf16(o0[2], o0[3]); w.z = cvt_pk_bf16(o1[0], o1[1]); w.w = cvt_pk_bf16(o1[2], o1[3]);
                        if (skip != 2 || w.x == 0x12345678u) *(u32x4*)(dst + (size_t)row * ld + coloff + 64 * wc + 32 * bj + 8 * fq) = w;
                    }
                    asm volatile("" ::: "memory");
                }
        } else {
#pragma unroll
            for (int ai = 0; ai < 2; ++ai)
#pragma unroll
                for (int m = 0; m < 4; ++m) {
                    const int row = row0 + ai * 128 + m * 16;
#pragma unroll
                    for (int bj = 0; bj < 2; ++bj) {
                        f32x4 v0 = acc[ai][bj][m][0], v1 = acc[ai][bj][m][1];
                        if (kind == 2) {
#pragma unroll
                            for (int i = 0; i < 4; ++i) { v0[i] = sigmoidf_(v0[i]); v1[i] = sigmoidf_(v1[i]); }
                        }
                        const int col = coloff + 64 * wc + 32 * bj + 8 * fq;
                        u32x4 w; w.x = cvt_pk_bf16(v0[0], v0[1]); w.y = cvt_pk_bf16(v0[2], v0[3]); w.z = cvt_pk_bf16(v1[0], v1[1]); w.w = cvt_pk_bf16(v1[2], v1[3]);
                        if (skip != 2 || w.x == 0x12345678u) *(u32x4*)(dst + (size_t)row * ld + col) = w;
                    }
                }
        }
    }
};

struct EpiZ {
    static constexpr bool AFTER_DRAIN = false, HAS_MID = true; static constexpr bool HAS_PRE = false;
    const bf16_t* G; bf16_t* Z;
    __device__ __forceinline__ void mid(f32x4 (&acc)[2][2][4][2], const Unit& u, int wr, int wc, int fr, int fq) const {
        const int row0 = u.pm * 256 + wr * 64 + fr, col0 = u.pn * 256 + wc * 64 + 8 * fq;
        u32x4 gq[3][4];
#define ZM_LOAD(i_, B_) do { const bf16_t* gp_ = G + (size_t)(row0 + ((i_) >> 2) * 128 + ((i_) & 3) * 16) * 2048 + col0; \
        gq[B_][0] = *(const u32x4*)gp_; gq[B_][1] = *(const u32x4*)(gp_ + 1024); gq[B_][2] = *(const u32x4*)(gp_ + 32); gq[B_][3] = *(const u32x4*)(gp_ + 1024 + 32); } while (0)
        ZM_LOAD(0, 0); ZM_LOAD(1, 1);
#pragma unroll
        for (int i = 0; i < 8; ++i) {
            if (i + 2 < 8) ZM_LOAD(i + 2, (i + 2) % 3);
            const int ai = i >> 2, m = i & 3;
#pragma unroll
            for (int bj = 0; bj < 2; ++bj) {
                const u32x4 a = gq[i % 3][2 * bj], b = gq[i % 3][2 * bj + 1];
                f32x4 r0, r1;
                r0[0] = bf_lo(a.x) * __builtin_amdgcn_rcpf(fmaxf(bf_lo(b.x), 1e-30f)); r0[1] = bf_hi(a.x) * __builtin_amdgcn_rcpf(fmaxf(bf_hi(b.x), 1e-30f)); r0[2] = bf_lo(a.y) * __builtin_amdgcn_rcpf(fmaxf(bf_lo(b.y), 1e-30f)); r0[3] = bf_hi(a.y) * __builtin_amdgcn_rcpf(fmaxf(bf_hi(b.y), 1e-30f));
                r1[0] = bf_lo(a.z) * __builtin_amdgcn_rcpf(fmaxf(bf_lo(b.z), 1e-30f)); r1[1] = bf_hi(a.z) * __builtin_amdgcn_rcpf(fmaxf(bf_hi(b.z), 1e-30f)); r1[2] = bf_lo(a.w) * __builtin_amdgcn_rcpf(fmaxf(bf_lo(b.w), 1e-30f)); r1[3] = bf_hi(a.w) * __builtin_amdgcn_rcpf(fmaxf(bf_hi(b.w), 1e-30f));
                acc[ai][bj][m][0] *= r0; acc[ai][bj][m][1] *= r1;
            }
            asm volatile("" ::: "memory");
        }
#undef ZM_LOAD
    }
    __device__ __forceinline__ void operator()(const f32x4 (&acc)[2][2][4][2], const Unit& u, int wr, int wc, int fr, int fq) const {
        const int row0 = u.pm * 256 + wr * 64 + fr, col0 = u.pn * 256 + wc * 64 + 8 * fq;
        u32x4 gbv[2][4][2];
#pragma unroll
        for (int ai = 0; ai < 2; ++ai)
#pragma unroll
            for (int m = 0; m < 4; ++m)
#pragma unroll
                for (int bj = 0; bj < 2; ++bj) gbv[ai][m][bj] = *(const u32x4*)(G + (size_t)(row0 + ai * 128 + m * 16) * 2048 + 1024 + col0 + bj * 32);
#pragma unroll
        for (int ai = 0; ai < 2; ++ai)
#pragma unroll
            for (int m = 0; m < 4; ++m)
#pragma unroll
                for (int bj = 0; bj < 2; ++bj) {
                    const size_t off = (size_t)(row0 + ai * 128 + m * 16);
                    const u32x4 b = gbv[ai][m][bj];
                    const f32x4 v0 = acc[ai][bj][m][0], v1 = acc[ai][bj][m][1];
                    u32x4 w;
                    w.x = cvt_pk_bf16(v0[0] * fmaxf(bf_lo(b.x), 1e-30f), v0[1] * fmaxf(bf_hi(b.x), 1e-30f)); w.y = cvt_pk_bf16(v0[2] * fmaxf(bf_lo(b.y), 1e-30f), v0[3] * fmaxf(bf_hi(b.y), 1e-30f));
                    w.z = cvt_pk_bf16(v1[0] * fmaxf(bf_lo(b.z), 1e-30f), v1[1] * fmaxf(bf_hi(b.z), 1e-30f)); w.w = cvt_pk_bf16(v1[2] * fmaxf(bf_lo(b.w), 1e-30f), v1[3] * fmaxf(bf_hi(b.w), 1e-30f));
                    *(u32x4*)(Z + off * 1024 + col0 + bj * 32) = w;
                    if (bj == 1) asm volatile("" ::: "memory");
                }
    }
};

struct EpiX1 {
    static constexpr bool AFTER_DRAIN = false, HAS_MID = false; static constexpr bool HAS_PRE = false;
    const float* x; bf16_t* x1; const float* modacc; const float* bada;
    __device__ __forceinline__ void operator()(const f32x4 (&acc)[2][2][4][2], const Unit& u, int wr, int wc, int fr, int fq) const {
        const int row0 = u.pm * 256 + wr * 64 + fr, col0 = u.pn * 256 + wc * 64 + 8 * fq;
        const int b = (u.pm * 256) >> 13;
        f32x4 g1[2][2];
#pragma unroll
        for (int bj = 0; bj < 2; ++bj)
#pragma unroll
            for (int n = 0; n < 2; ++n) { const int c = col0 + bj * 32 + n * 4; g1[bj][n] = *(const f32x4*)(modacc + b * 6144 + 2048 + c); }
        f32x4 xb[3][4];
#define X1_LOAD(i_, B_) do { const size_t off_ = (size_t)(row0 + ((i_) >> 2) * 128 + ((i_) & 3) * 16) * 1024 + col0; \
        xb[B_][0] = *(const f32x4*)(x + off_); xb[B_][1] = *(const f32x4*)(x + off_ + 4); xb[B_][2] = *(const f32x4*)(x + off_ + 32); xb[B_][3] = *(const f32x4*)(x + off_ + 36); } while (0)
        X1_LOAD(0, 0); X1_LOAD(1, 1);
#pragma unroll
        for (int i = 0; i < 8; ++i) {
            if (i + 2 < 8) X1_LOAD(i + 2, (i + 2) % 3);
            const int ai = i >> 2, m = i & 3;
            const size_t off = (size_t)(row0 + ai * 128 + m * 16) * 1024 + col0;
#pragma unroll
            for (int bj = 0; bj < 2; ++bj) {
                const f32x4 r0 = xb[i % 3][2 * bj] + g1[bj][0] * acc[ai][bj][m][0], r1 = xb[i % 3][2 * bj + 1] + g1[bj][1] * acc[ai][bj][m][1];
                u32x4 w; w.x = cvt_pk_bf16(r0[0], r0[1]); w.y = cvt_pk_bf16(r0[2], r0[3]); w.z = cvt_pk_bf16(r1[0], r1[1]); w.w = cvt_pk_bf16(r1[2], r1[3]);
                *(u32x4*)(x1 + off + bj * 32) = w;
            }
            asm volatile("" ::: "memory");
        }
#undef X1_LOAD
    }
};

struct EpiAct {
    static constexpr bool AFTER_DRAIN = false, HAS_MID = false; static constexpr bool HAS_PRE = true;
    bf16_t* act; const float* rw;
    __device__ __forceinline__ void pre(const Unit& u, int ui, int wid, unsigned ldsbase) const {
        if (wid < 4) glds4_sv((const void*)(rw + (size_t)u.pm * 256), (unsigned)(wid * 64 + lane_id()) * 4u, ldsbase + (unsigned)(EPI_TAB_OFF + (ui & 1) * 1024 + wid * 256));
    }
    __device__ __forceinline__ void run(const f32x4 (&acc)[2][2][4][2], const Unit& u, int wr, int wc, int fr, int fq, LAS unsigned char* lds, int ui) const {
        const int row0 = u.pm * 256 + wr * 64 + fr, col0 = u.pn * 128 + wc * 32 + 8 * fq;
        const LAS float* tab = (const LAS float*)(lds + EPI_TAB_OFF + (ui & 1) * 1024) + wr * 64 + fr;
        float wv[2][4];
#pragma unroll
        for (int ai = 0; ai < 2; ++ai)
#pragma unroll
            for (int m = 0; m < 4; ++m) wv[ai][m] = tab[ai * 128 + m * 16];
#pragma unroll
        for (int ai = 0; ai < 2; ++ai)
#pragma unroll
            for (int m = 0; m < 4; ++m) {
                const int row = row0 + ai * 128 + m * 16;
                const float w = wv[ai][m];
                const f32x4 g0 = acc[ai][0][m][0], g1 = acc[ai][0][m][1], u0 = acc[ai][1][m][0], u1 = acc[ai][1][m][1];
                float a[8];
#pragma unroll
                for (int i = 0; i < 4; ++i) { a[i] = g0[i] * sigmoidf_(g0[i]) * u0[i] * w; a[4 + i] = g1[i] * sigmoidf_(g1[i]) * u1[i] * w; }
                u32x4 o; o.x = cvt_pk_bf16(a[0], a[1]); o.y = cvt_pk_bf16(a[2], a[3]); o.z = cvt_pk_bf16(a[4], a[5]); o.w = cvt_pk_bf16(a[6], a[7]);
                *(u32x4*)(act + (size_t)row * 256 + col0) = o;
            }
    }
};

struct EpiY2 {
    static constexpr bool AFTER_DRAIN = false, HAS_MID = false; static constexpr bool HAS_PRE = true;
    unsigned char* Y2; const int* rdst;
    __device__ __forceinline__ void pre(const Unit& u, int ui, int wid, unsigned ldsbase) const {
        if (wid < 4) glds4_sv((const void*)(rdst + (size_t)u.pm * 256), (unsigned)(wid * 64 + lane_id()) * 4u, ldsbase + (unsigned)(EPI_TAB_OFF + (ui & 1) * 1024 + wid * 256));
    }
    __device__ __forceinline__ void run(const f32x4 (&acc)[2][2][4][2], const Unit& u, int wr, int wc, int fr, int fq, LAS unsigned char* lds, int ui) const {
        const LAS int* tab = (const LAS int*)(lds + EPI_TAB_OFF + (ui & 1) * 1024) + wr * 64 + fr;
        const int row0 = u.pm * 256 + wr * 64 + fr, col0 = u.pn * 256 + wc * 64 + 16 * fq;
        int dv[2][4];
#pragma unroll
        for (int ai = 0; ai < 2; ++ai)
#pragma unroll
            for (int m = 0; m < 4; ++m) dv[ai][m] = tab[ai * 128 + m * 16];
#pragma unroll
        for (int ai = 0; ai < 2; ++ai)
#pragma unroll
            for (int m = 0; m < 4; ++m) {
                const int d = dv[ai][m];
                u32x4 o;
#pragma unroll
                for (int bj = 0; bj < 2; ++bj) {
                    const f32x4 v0 = acc[ai][bj][m][0], v1 = acc[ai][bj][m][1];
                    int w0 = __builtin_amdgcn_cvt_pk_fp8_f32(v0[0], v0[1], 0, false); w0 = __builtin_amdgcn_cvt_pk_fp8_f32(v0[2], v0[3], w0, true);
                    int w1 = __builtin_amdgcn_cvt_pk_fp8_f32(v1[0], v1[1], 0, false); w1 = __builtin_amdgcn_cvt_pk_fp8_f32(v1[2], v1[3], w1, true);
                    if (bj == 0) { o.x = (unsigned)w0; o.y = (unsigned)w1; } else { o.z = (unsigned)w0; o.w = (unsigned)w1; }
                }
                *(u32x4*)(Y2 + (size_t)d * 1024 + col0) = o;
            }
    }
};

struct EpiRoute {
    static constexpr bool AFTER_DRAIN = true, HAS_MID = false; static constexpr bool HAS_PRE = false;
    const float* rbias; int* idx; float* wts; int* rnk; int* wgb; unsigned* cnt;
    __device__ __forceinline__ void fused(const f32x4 (&acc)[2][2][4][2], const Unit& u, int wr, int wc, int fr, int fq, LAS unsigned char* lds, int wid, int lane) const {
        LAS float* sc = (LAS float*)lds;
        LAS unsigned* hist = (LAS unsigned*)(lds + 131072 + 1024);
        LAS float* xg = (LAS float*)(lds + 131072 + 2048);
        LAS float* mv = (LAS float*)(lds + 131072 + 6144);
        const int tid = wid * 64 + lane;
        if (tid < 256) hist[tid] = 0u;
#pragma unroll
        for (int ai = 0; ai < 2; ++ai) {
            __syncthreads();
#pragma unroll
            for (int m = 0; m < 4; ++m) { const int r = wr * 64 + m * 16 + fr;
#pragma unroll
                for (int bj = 0; bj < 2; ++bj)
#pragma unroll
                    for (int n = 0; n < 2; ++n)
#pragma unroll
                        for (int i = 0; i < 4; ++i) sc[(bj * 128 + wc * 32 + n * 16 + fq * 4 + i) * 128 + r] = acc[ai][bj][m][n][i]; }
            __syncthreads();
            const int row = tid & 127, half = (tid >> 7) & 1;
            float gs[4];
            if (tid < 256) {
#pragma unroll
                for (int g = 0; g < 4; ++g) { float m1 = -INFINITY, m2 = -INFINITY;
#pragma unroll 8
                    for (int j = 0; j < 32; ++j) { const int e = (half * 4 + g) * 32 + j; const float sg_ = sigmoidf_(sc[e * 128 + row]); sc[e * 128 + row] = sg_; const float b = sg_ + rbias[e]; if (b > m1) { m2 = m1; m1 = b; } else if (b > m2) m2 = b; }
                    gs[g] = m1 + m2; xg[row * 8 + half * 4 + g] = gs[g]; }
            }
            __syncthreads();
            float Lv[8]; int Li[8];
            if (tid < 256) {
                float ga[8];
#pragma unroll
                for (int h = 0; h < 8; ++h) ga[h] = xg[row * 8 + h];
#pragma unroll
                for (int k = 0; k < 8; ++k) { Lv[k] = -INFINITY; Li[k] = 0; }
#pragma unroll
                for (int g = 0; g < 4; ++g) { const int gg = half * 4 + g; int rank = 0;
#pragma unroll
                    for (int h = 0; h < 8; ++h) rank += (ga[h] > gs[g] || (ga[h] == gs[g] && h < gg)) ? 1 : 0;
                    if (rank < 4) {
#pragma unroll 1
                        for (int j = 0; j < 32; ++j) { const int e = gg * 32 + j; float v = sc[e * 128 + row] + rbias[e]; int ei = e;
#pragma unroll
                            for (int k = 0; k < 8; ++k) { if (v > Lv[k]) { const float tv = Lv[k]; const int ti = Li[k]; Lv[k] = v; Li[k] = ei; v = tv; ei = ti; } } } } }
                if (half == 1) {
#pragma unroll
                    for (int k = 0; k < 8; ++k) { mv[(row * 8 + k) * 2 + 0] = Lv[k]; ((LAS int*)mv)[(row * 8 + k) * 2 + 1] = Li[k]; } }
            }
            __syncthreads();
            if (tid < 128) {
#pragma unroll 1
                for (int q = 0; q < 8; ++q) { float v = mv[(row * 8 + q) * 2 + 0]; int ei = ((LAS int*)mv)[(row * 8 + q) * 2 + 1];
#pragma unroll
                    for (int k = 0; k < 8; ++k) { if (v > Lv[k]) { const float tv = Lv[k]; const int ti = Li[k]; Lv[k] = v; Li[k] = ei; v = tv; ei = ti; } } }
                float Ls[8]; float sum = 0.f;
#pragma unroll
                for (int k = 0; k < 8; ++k) { Ls[k] = sc[Li[k] * 128 + row]; sum += Ls[k]; }
                const float inv = 2.5f / sum;
                const int t = u.pm * 256 + ai * 128 + row;
#pragma unroll
                for (int k = 0; k < 8; ++k) { const unsigned rk = atomicAdd((unsigned*)&hist[Li[k]], 1u); idx[t * 8 + k] = Li[k]; wts[t * 8 + k] = Ls[k] * inv; rnk[t * 8 + k] = (int)rk; }
            }
        }
        __syncthreads();
        if (tid < 256) { const unsigned c = hist[tid]; unsigned base = 0u; if (c) base = atomicAdd(cnt + tid, c); wgb[u.pm * 256 + tid] = (int)base; }
        __syncthreads();
    }
};

namespace att {
#define SBAR() __builtin_amdgcn_sched_barrier(0)
__device__ __forceinline__ int crow(int r, int hi) { return (r & 3) + 8 * (r >> 2) + 4 * hi; }
constexpr float THR = 8.f;
__device__ __forceinline__ void partialSM(f32x16& p0, f32x16& p1, float& m_reg, float& alpha) {
    float pmax = p0[0];
#pragma unroll
    for (int r = 1; r < 16; ++r) pmax = fmaxf(pmax, p0[r]);
#pragma unroll
    for (int r = 0; r < 16; ++r) pmax = fmaxf(pmax, p1[r]);
    { auto rr = __builtin_amdgcn_permlane32_swap(__float_as_uint(pmax), __float_as_uint(pmax), false, false);
      pmax = fmaxf(__uint_as_float(rr[0]), __uint_as_float(rr[1])); }
    float mn;
    if (__builtin_expect(__all(pmax - m_reg <= THR), 1)) { mn = m_reg; alpha = 1.f; }
    else { mn = fmaxf(m_reg, pmax); alpha = __builtin_amdgcn_exp2f(m_reg - mn); m_reg = mn; }
#pragma unroll
    for (int r = 0; r < 16; ++r) { p0[r] -= mn; p1[r] -= mn; }
#pragma unroll
    for (int r = 0; r < 16; ++r) p0[r] = __builtin_amdgcn_exp2f(p0[r]);
}
__device__ __forceinline__ void finishSM(f32x16& p0, f32x16& p1, float alpha, float& l_reg, bf16x8& pa0, bf16x8& pa1, bf16x8& pa2, bf16x8& pa3) {
#pragma unroll
    for (int r = 0; r < 16; ++r) p1[r] = __builtin_amdgcn_exp2f(p1[r]);
    float ps = 0;
#pragma unroll
    for (int r = 0; r < 16; ++r) ps += p0[r];
#pragma unroll
    for (int r = 0; r < 16; ++r) ps += p1[r];
    { auto rr = __builtin_amdgcn_permlane32_swap(__float_as_uint(ps), __float_as_uint(ps), false, false);
      ps = __uint_as_float(rr[0]) + __uint_as_float(rr[1]); }
    l_reg = l_reg * alpha + ps;
#define PK4(P, BASE, OUT) do { unsigned a0 = cvt_pk_bf16(P[BASE + 0], P[BASE + 1]), a1 = cvt_pk_bf16(P[BASE + 2], P[BASE + 3]);   \
    unsigned b0 = cvt_pk_bf16(P[BASE + 4], P[BASE + 5]), b1 = cvt_pk_bf16(P[BASE + 6], P[BASE + 7]);                              \
    auto r0 = __builtin_amdgcn_permlane32_swap(a0, b0, false, false); auto r1 = __builtin_amdgcn_permlane32_swap(a1, b1, false, false); \
    u32x4 w = {r0[0], r1[0], r0[1], r1[1]}; OUT = *reinterpret_cast<bf16x8*>(&w); } while (0)
    PK4(p0, 0, pa0); PK4(p0, 8, pa1); PK4(p1, 0, pa2); PK4(p1, 8, pa3);
#undef PK4
}
template <int NCB> __device__ __forceinline__ int v_st(int k, int c) { const int kk = (k & ~0xC) | ((k & 4) << 1) | ((k & 8) >> 1); return ((kk >> 3) * NCB + (c >> 5)) * 512 + ((kk & 7) * 32 + (c & 31)) * 2; }
__device__ __forceinline__ int v_rd_base(int lane) { return ((lane & 3) << 3) | (((lane >> 2) & 3) << 6) | (((lane >> 4) & 1) << 5) | (((lane >> 5) & 1) << 8); }
template <int OFF> __device__ __forceinline__ s16x4 tr_read(int vb) { s16x4 r; asm volatile("ds_read_b64_tr_b16 %0, %1 offset:%2" : "=&v"(r) : "v"(vb), "i"(OFF) : "memory"); return r; }
template <int OFF> __device__ __forceinline__ s16x4 tr_fake(int vb) { s16x4 r; asm volatile("" : "=v"(r) : "v"(vb)); return r; }
template <int NCB, int D0> __device__ __forceinline__ void pv_one(f32x16& od, int vb, bf16x8 pa0, bf16x8 pa1, bf16x8 pa2, bf16x8 pa3) {
#define VOFF(ks, half) (((2 * (ks) + (half)) * NCB + D0) * 512)
    const s16x4 l0 = tr_read<VOFF(0, 0)>(vb), h0 = tr_read<VOFF(0, 1)>(vb), l1 = tr_read<VOFF(1, 0)>(vb), h1 = tr_read<VOFF(1, 1)>(vb);
    const s16x4 l2 = tr_read<VOFF(2, 0)>(vb), h2 = tr_read<VOFF(2, 1)>(vb), l3 = tr_read<VOFF(3, 0)>(vb), h3 = tr_read<VOFF(3, 1)>(vb);
#undef VOFF
    asm volatile("s_waitcnt lgkmcnt(0)" ::: "memory"); SBAR();
#define PK(L, H) (bf16x8){L[0], L[1], L[2], L[3], H[0], H[1], H[2], H[3]}
    od = __builtin_amdgcn_mfma_f32_32x32x16_bf16(pa0, PK(l0, h0), od, 0, 0, 0);
    od = __builtin_amdgcn_mfma_f32_32x32x16_bf16(pa1, PK(l1, h1), od, 0, 0, 0);
    od = __builtin_amdgcn_mfma_f32_32x32x16_bf16(pa2, PK(l2, h2), od, 0, 0, 0);
    od = __builtin_amdgcn_mfma_f32_32x32x16_bf16(pa3, PK(l3, h3), od, 0, 0, 0);
#undef PK
}

__device__ __forceinline__ void glds16(const void* gsrc, unsigned lds_dst) { unsigned keep;
    asm volatile("s_mov_b32 %0, m0\n\ts_mov_b32 m0, %2\n\ts_nop 0\n\tglobal_load_lds_dwordx4 %1, off\n\ts_mov_b32 m0, %0" : "=&s"(keep) : "v"(gsrc), "s"(lds_dst) : "memory"); }
__device__ __forceinline__ void glds16s(const void* sbase, unsigned voff, unsigned lds_dst) { unsigned keep;
    asm volatile("s_mov_b32 %0, m0\n\ts_mov_b32 m0, %3\n\ts_nop 0\n\tglobal_load_lds_dwordx4 %1, %2\n\ts_mov_b32 m0, %0" : "=&s"(keep) : "v"(voff), "s"(sbase), "s"(lds_dst) : "memory"); }
__device__ __forceinline__ float fadd_(float a, float b) { float r; asm("v_add_f32_e32 %0, %1, %2" : "=v"(r) : "v"(a), "v"(b)); return r; }
constexpr int B2_WS = 131072 + 4096;
constexpr int B_SHM_V = 16384, B_SHM_K = 16384;
#define KSWZB(row, colB) ((row) * 256 + ((colB) ^ (((row) & 7) << 4)))
__device__ __forceinline__ void qktB(f32x16& p0, f32x16& p1, const char* Ks, const bf16x8* qr, int r32, int hi, int map) {
    p0 = f32x16{}; p1 = f32x16{};
#pragma unroll
    for (int d0 = 0; d0 < 4; ++d0) { const int cb = ((map * 4 + d0) * 16 + hi * 8) * 2;
        const bf16x8 b0 = *reinterpret_cast<const bf16x8*>(Ks + KSWZB(r32, cb));
        const bf16x8 b1 = *reinterpret_cast<const bf16x8*>(Ks + KSWZB(32 + r32, cb));
        p0 = __builtin_amdgcn_mfma_f32_32x32x16_bf16(b0, qr[d0], p0, 0, 0, 0);
        p1 = __builtin_amdgcn_mfma_f32_32x32x16_bf16(b1, qr[d0], p1, 0, 0, 0); }
}
__device__ __forceinline__ void attnB_unit(const bf16_t* Qb, const bf16_t* __restrict__ KBp, const bf16_t* __restrict__ VBp, bf16_t* Ob, int b, int h, int qb, char* lds, float lam, const float* subg, const int wid) {
    const int lane = lane_id(), tid = wid * 64 + lane, r32 = lane & 31, hi = lane >> 5, map = wid >> 2, rg = wid & 3;
    char* V_lds = lds; char* K_lds = lds + 2 * B_SHM_V;
    float* ws = (float*)(lds + 2 * B_SHM_V + 2 * B_SHM_K) + wid * 64; float* li_l = ws; float* al_l = ws + 32;
    float m_reg = -1e30f, l_reg = 0; f32x16 o[4] = {}; bf16x8 qr[4];
    const size_t qrow = (size_t)b * SEQ + qb * 128 + rg * 32;
    const bf16_t* Qw = Qb + (qrow + r32) * 2048 + 1024 + h * 128 + map * 64 + hi * 8;
#pragma unroll
    for (int d0 = 0; d0 < 4; ++d0) qr[d0] = *reinterpret_cast<const bf16x8*>(Qw + d0 * 16);
    const int sr = tid >> 4, sc = (tid & 15) * 8, vst0 = v_st<4>(sr, sc), vst1 = v_st<4>(32 + sr, sc);
    const int vb0 = (int)(uintptr_t)V_lds + v_rd_base(lane);
    const bf16_t* Kh = KBp + h * 128 + sc; const bf16_t* Vh = VBp + h * 128 + sc;
    struct { bf16x8 vs0, vs1, ks0, ks1; } sr_[2];
#define ROWOF(tile) ((tile) < 128 ? (size_t)b * SEQ + (size_t)(tile) * 64 : (size_t)T + (size_t)b * CTXL + (size_t)((tile) - 128) * 64)
#define SLOAD(i, tile) do { const size_t r0_ = ROWOF(tile) + sr; sr_[i].vs0 = *(const bf16x8*)(Vh + r0_ * 1024); sr_[i].vs1 = *(const bf16x8*)(Vh + (r0_ + 32) * 1024); \
    sr_[i].ks0 = *(const bf16x8*)(Kh + r0_ * 1024); sr_[i].ks1 = *(const bf16x8*)(Kh + (r0_ + 32) * 1024); } while (0)
#define SWRITE(bu, i) do { *(bf16x8*)(V_lds + (bu) * B_SHM_V + vst0) = sr_[i].vs0; *(bf16x8*)(V_lds + (bu) * B_SHM_V + vst1) = sr_[i].vs1; const int kc = sc * 2; \
    *(bf16x8*)(K_lds + (bu) * B_SHM_K + KSWZB(sr, kc)) = sr_[i].ks0; *(bf16x8*)(K_lds + (bu) * B_SHM_K + KSWZB(32 + sr, kc)) = sr_[i].ks1; } while (0)
#define SWAIT() asm volatile("s_waitcnt vmcnt(4)" ::: "memory")
#define RESC(a) do { if (__any((a) < 1.f)) { if (hi == 0) al_l[r32] = (a); asm volatile("s_waitcnt lgkmcnt(0)" ::: "memory"); \
    _Pragma("unroll") for (int d = 0; d < 4; ++d) _Pragma("unroll") for (int r = 0; r < 16; ++r) o[d][r] *= al_l[crow(r, hi)]; } } while (0)
#define PVALL(vbx) do { pv_one<4, 0>(o[0], vbx, pa0, pa1, pa2, pa3); pv_one<4, 1>(o[1], vbx, pa0, pa1, pa2, pa3); pv_one<4, 2>(o[2], vbx, pa0, pa1, pa2, pa3); pv_one<4, 3>(o[3], vbx, pa0, pa1, pa2, pa3); } while (0)
    f32x16 pA0, pA1, pB0, pB1; float alA, alB; bf16x8 pa0, pa1, pa2, pa3; constexpr int NT = 132;
    SLOAD(0, 0); asm volatile("s_waitcnt vmcnt(0)" ::: "memory"); SWRITE(0, 0); __syncthreads();
    qktB(pA0, pA1, K_lds, qr, r32, hi, map); partialSM(pA0, pA1, m_reg, alA);
    SLOAD(1, 1); SLOAD(0, 2);
    SWAIT(); SWRITE(1, 1); __syncthreads();
    for (int j = 1; j + 1 < NT; j += 2) {
        SBAR(); qktB(pB0, pB1, K_lds + B_SHM_K, qr, r32, hi, map);
        finishSM(pA0, pA1, alA, l_reg, pa0, pa1, pa2, pa3); SBAR();
        SLOAD(1, j + 2); SBAR();
        PVALL(vb0); partialSM(pB0, pB1, m_reg, alB);
        __syncthreads(); SWAIT(); SWRITE(0, 0);
        RESC(alB); __syncthreads();
        SBAR(); qktB(pA0, pA1, K_lds, qr, r32, hi, map);
        finishSM(pB0, pB1, alB, l_reg, pa0, pa1, pa2, pa3); SBAR();
        if (j + 3 < NT) SLOAD(0, j + 3); SBAR();
        PVALL(vb0 + B_SHM_V); partialSM(pA0, pA1, m_reg, alA);
        __syncthreads(); SWAIT(); SWRITE(1, 1);
        RESC(alA); __syncthreads();
    }
    SBAR(); qktB(pB0, pB1, K_lds + B_SHM_K, qr, r32, hi, map);
    finishSM(pA0, pA1, alA, l_reg, pa0, pa1, pa2, pa3); SBAR();
    PVALL(vb0); partialSM(pB0, pB1, m_reg, alB);
    __syncthreads(); RESC(alB);
    finishSM(pB0, pB1, alB, l_reg, pa0, pa1, pa2, pa3); SBAR();
    PVALL(vb0 + B_SHM_V);
    if (hi == 0) li_l[r32] = l_reg; asm volatile("s_waitcnt lgkmcnt(0)" ::: "memory");
    float rli[16];
#pragma unroll
    for (int r = 0; r < 16; ++r) rli[r] = __builtin_amdgcn_rcpf(li_l[crow(r, hi)]);
    __syncthreads();
    float* X = (float*)lds + rg * 4096;
    if (map == 1) {
#pragma unroll
        for (int r = 0; r < 16; ++r)
#pragma unroll
            for (int d0 = 0; d0 < 4; ++d0) X[crow(r, hi) * 128 + d0 * 32 + r32] = o[d0][r] * rli[r] * lam;
    }
    __syncthreads();
    if (map == 0) {
        float sg[4];
#pragma unroll
        for (int d0 = 0; d0 < 4; ++d0) sg[d0] = subg[d0 * 32 + r32] * 0.8f;
        bf16_t* Ow = Ob + qrow * 2048 + 1024 + h * 128;
#pragma unroll
        for (int r = 0; r < 16; ++r) {
            float dv[4]; float ss = 0.f;
#pragma unroll
            for (int d0 = 0; d0 < 4; ++d0) { dv[d0] = o[d0][r] * rli[r] - X[crow(r, hi) * 128 + d0 * 32 + r32]; ss += dv[d0] * dv[d0]; }
#pragma unroll
            for (int s = 1; s < 32; s <<= 1) ss += __shfl_xor(ss, s);
            const float rs = rsqrtf(ss * (1.0f / 128.0f) + EPSN);
#pragma unroll
            for (int d0 = 0; d0 < 4; ++d0) { const unsigned w = cvt_pk_bf16(dv[d0] * rs * sg[d0], 0.f); Ow[(size_t)crow(r, hi) * 2048 + d0 * 32 + r32] = (bf16_t)(w & 0xffffu); }
        }
    }
    __syncthreads();
#undef ROWOF
#undef SLOAD
#undef SWRITE
#undef SWAIT
#undef RESC
#undef PVALL
}

constexpr int A_SHM = 8192;
#define KSWZA(row, chunk) ((row) * 128 + ((((chunk) ^ ((row) >> 1)) & 7) << 4))
__device__ __forceinline__ void qktA(f32x16& p0, f32x16& p1, const char* Ks, const bf16x8* qr, int r32, int hi) {
    p0 = f32x16{}; p1 = f32x16{};
#pragma unroll
    for (int d0 = 0; d0 < 4; ++d0) { const int ch = 2 * d0 + hi;
        const bf16x8 b0 = *reinterpret_cast<const bf16x8*>(Ks + KSWZA(r32, ch));
        const bf16x8 b1 = *reinterpret_cast<const bf16x8*>(Ks + KSWZA(32 + r32, ch));
        p0 = __builtin_amdgcn_mfma_f32_32x32x16_bf16(b0, qr[d0], p0, 0, 0, 0);
        p1 = __builtin_amdgcn_mfma_f32_32x32x16_bf16(b1, qr[d0], p1, 0, 0, 0); }
}
__device__ __forceinline__ void maskA(f32x16& p0, f32x16& p1, int tile, int t0, int r32, int hi) {
#pragma unroll
    for (int r = 0; r < 16; ++r) {
        const int v0 = 64 * tile + crow(r, hi), v1 = v0 + 32;
        { const int k = t0 - 384 + v0, d = t0 + r32 - k; const bool ok = (v0 < 544) && (k >= 0) && (k < SEQ) && (d <= 128) && (d >= -128); if (!ok) p0[r] = -INFINITY; }
        { const int k = t0 - 384 + v1, d = t0 + r32 - k; const bool ok = (v1 < 544) && (k >= 0) && (k < SEQ) && (d <= 128) && (d >= -128); if (!ok) p1[r] = -INFINITY; }
    }
}
__device__ __forceinline__ void attnA_unit(const bf16_t* Qb, const bf16_t* __restrict__ KVAp, bf16_t* Ob, int b, int kvh, int qb, char* lds, const float* sink, const int wid, const bool do_store = true) {
    const int lane = lane_id(), tid = wid * 64 + lane, r32 = lane & 31, hi = lane >> 5;
    char* V_lds = lds; char* K_lds = lds + 2 * A_SHM;
    float* ws = (float*)(lds + 4 * A_SHM) + wid * 64; float* li_l = ws; float* al_l = ws + 32;
    float m_reg = -1e30f, l_reg = 0; f32x16 o[2] = {}; bf16x8 qr[4];
    const int head = kvh * 8 + wid, t0 = qb * 32;
    const size_t qrow = (size_t)b * SEQ + t0;
    const bf16_t* Qw = Qb + (qrow + r32) * 2048 + head * 64 + hi * 8;
#pragma unroll
    for (int d0 = 0; d0 < 4; ++d0) qr[d0] = *reinterpret_cast<const bf16x8*>(Qw + d0 * 16);
    const int srow = tid >> 3, sch = tid & 7, vst = v_st<2>(srow, sch * 8), kst = KSWZA(srow, sch);
    const int vb0 = (int)(uintptr_t)V_lds + v_rd_base(lane);
    const bf16_t* KVh = KVAp + kvh * 64 + sch * 8;
    struct { bf16x8 vs, ks; } sr_[2];
#define ROWOFA(v) ((v) < 256 ? (size_t)T + (size_t)b * CTXL + (v) : ((v) < 544 ? (size_t)b * SEQ + (size_t)min(max(t0 - 384 + (v), 0), SEQ - 1) : (size_t)T + (size_t)b * CTXL))
#define SLOAD(i, tile) do { const int v_ = (tile) * 64 + srow; const size_t r0_ = ROWOFA(v_); sr_[i].ks = *(const bf16x8*)(KVh + r0_ * 256); sr_[i].vs = *(const bf16x8*)(KVh + r0_ * 256 + 128); } while (0)
#define SWRITE(bu, i) do { *(bf16x8*)(V_lds + (bu) * A_SHM + vst) = sr_[i].vs; *(bf16x8*)(K_lds + (bu) * A_SHM + kst) = sr_[i].ks; } while (0)
#define SWAIT() asm volatile("s_waitcnt vmcnt(2)" ::: "memory")
#define RESC(a) do { if (__any((a) < 1.f)) { if (hi == 0) al_l[r32] = (a); asm volatile("s_waitcnt lgkmcnt(0)" ::: "memory"); \
    _Pragma("unroll") for (int d = 0; d < 2; ++d) _Pragma("unroll") for (int r = 0; r < 16; ++r) o[d][r] *= al_l[crow(r, hi)]; } } while (0)
#define PVALL(vbx) do { pv_one<2, 0>(o[0], vbx, pa0, pa1, pa2, pa3); pv_one<2, 1>(o[1], vbx, pa0, pa1, pa2, pa3); } while (0)
    f32x16 pA0, pA1, pB0, pB1; float alA, alB; bf16x8 pa0, pa1, pa2, pa3; constexpr int NT = 10;
    SLOAD(0, 0); asm volatile("s_waitcnt vmcnt(0)" ::: "memory"); SWRITE(0, 0); __syncthreads();
    qktA(pA0, pA1, K_lds, qr, r32, hi); partialSM(pA0, pA1, m_reg, alA);
    SLOAD(1, 1); SLOAD(0, 2);
    SWAIT(); SWRITE(1, 1); __syncthreads();
    for (int j = 1; j + 1 < NT; j += 2) {
        SBAR(); qktA(pB0, pB1, K_lds + A_SHM, qr, r32, hi); if (j >= 4) maskA(pB0, pB1, j, t0, r32, hi);
        finishSM(pA0, pA1, alA, l_reg, pa0, pa1, pa2, pa3); SBAR();
        SLOAD(1, j + 2); SBAR();
        PVALL(vb0); partialSM(pB0, pB1, m_reg, alB);
        __syncthreads(); SWAIT(); SWRITE(0, 0);
        RESC(alB); __syncthreads();
        SBAR(); qktA(pA0, pA1, K_lds, qr, r32, hi); if (j + 1 >= 4) maskA(pA0, pA1, j + 1, t0, r32, hi);
        finishSM(pB0, pB1, alB, l_reg, pa0, pa1, pa2, pa3); SBAR();
        if (j + 3 < NT) SLOAD(0, j + 3); SBAR();
        PVALL(vb0 + A_SHM); partialSM(pA0, pA1, m_reg, alA);
        __syncthreads(); SWAIT(); SWRITE(1, 1);
        RESC(alA); __syncthreads();
    }
    SBAR(); qktA(pB0, pB1, K_lds + A_SHM, qr, r32, hi); maskA(pB0, pB1, NT - 1, t0, r32, hi);
    finishSM(pA0, pA1, alA, l_reg, pa0, pa1, pa2, pa3); SBAR();
    PVALL(vb0); partialSM(pB0, pB1, m_reg, alB);
    __syncthreads(); RESC(alB);
    finishSM(pB0, pB1, alB, l_reg, pa0, pa1, pa2, pa3); SBAR();
    PVALL(vb0 + A_SHM);
    l_reg += __builtin_amdgcn_exp2f(sink[head] * 1.4426950408889634f - m_reg);
    if (hi == 0) li_l[r32] = l_reg; asm volatile("s_waitcnt lgkmcnt(0)" ::: "memory");
    bf16_t* Ow = Ob + qrow * 2048 + head * 64;
    if (do_store)
#pragma unroll
    for (int r = 0; r < 16; ++r) { const float rl = __builtin_amdgcn_rcpf(li_l[crow(r, hi)]);
#pragma unroll
        for (int d0 = 0; d0 < 2; ++d0) { const unsigned w = cvt_pk_bf16(o[d0][r] * rl, 0.f); Ow[(size_t)crow(r, hi) * 2048 + d0 * 32 + r32] = (bf16_t)(w & 0xffffu); } }
    __syncthreads();
#undef ROWOFA
#undef SLOAD
#undef SWRITE
#undef SWAIT
#undef RESC
#undef PVALL
}


template <int VAR> __device__ __forceinline__ void attnB6_unit(const bf16_t* Qb, const bf16_t* __restrict__ KBp, const bf16_t* __restrict__ VBp, bf16_t* Ob, int b, int h, int qb, char* lds, float lam, const float* subg, const int wid, const bool do_store) {
    const int lane = lane_id(), r32 = lane & 31, hi = lane >> 5;
    constexpr int SLOT = 8192, VRING = 4 * SLOT, QOFF = 8 * SLOT;
    float* li_l = (float*)(lds + B2_WS) + wid * 64;
    f32x16 o0[4] = {}, o1[4] = {};
    const size_t qrow = (size_t)b * SEQ + qb * 256 + wid * 32;
    const bf16_t* Qw = Qb + (qrow + r32) * 2048 + 1024 + h * 128 + hi * 8;
    const int q1a = (int)(uintptr_t)lds + QOFF + wid * 8192 + lane * 16;
#pragma unroll
    for (int d0 = 0; d0 < 8; ++d0) { const bf16x8 t_ = *reinterpret_cast<const bf16x8*>(Qw + d0 * 16); *reinterpret_cast<bf16x8*>(lds + QOFF + wid * 8192 + d0 * 1024 + lane * 16) = t_; }
    asm volatile("s_waitcnt lgkmcnt(0)" ::: "memory");
    unsigned koff, voff;
    { const int p = wid * 64 + lane;
      { const int row = p >> 4, cpos = p & 15, chunk = cpos ^ (row & 15); koff = (unsigned)(row * 2048 + h * 256 + chunk * 16); }
      { const int st = p >> 5, kk7 = (p >> 2) & 7, ch = p & 3, kk = (st >> 2) * 8 + kk7, k = (kk & ~0xC) | ((kk & 4) << 1) | ((kk & 8) >> 1), c = (st & 3) * 32 + ch * 8; voff = (unsigned)(k * 2048 + h * 256 + c * 2); } }
    const char* Kg = (const char*)KBp; const char* Vg = (const char*)VBp;
    const unsigned lds0 = (unsigned)(uintptr_t)lds;
    const unsigned kdst = lds0 + wid * 1024, vdst = lds0 + VRING + wid * 1024;
#define TBASE(tile) (((tile) < 256 ? (size_t)b * SEQ + (size_t)(tile) * 32 : (size_t)T + (size_t)b * CTXL + (size_t)((tile) - 256) * 32) * 2048)
#define DMA_K(tile) do { if (VAR == 1) break; glds16(Kg + TBASE(tile) + koff, kdst + (unsigned)(((tile) & 3) * SLOT)); } while (0)
#define DMA_V(tile) do { if (VAR == 1) break; glds16(Vg + TBASE(tile) + voff, vdst + (unsigned)(((tile) & 3) * SLOT)); } while (0)
#define BARV(N) do { if (VAR == 4) asm volatile("s_waitcnt vmcnt(" #N ") lgkmcnt(0)" ::: "memory"); else asm volatile("s_waitcnt vmcnt(" #N ") lgkmcnt(0)\n\ts_barrier" ::: "memory"); } while (0)
#define WAITL(N) asm volatile("s_waitcnt lgkmcnt(" #N ")" ::: "memory")
#define LDK(dst, addr, OFF) do { if (VAR == 6 || VAR == 7) { asm volatile("" : "=v"(dst)); } else asm volatile("ds_read_b128 %0, %1 offset:%2" : "=&v"(dst) : "v"(addr), "i"(OFF) : "memory"); } while (0)
    const int kbase = (int)lds0 + r32 * 256 + ((hi ^ (r32 & 15)) << 4);
    const int vbase = (int)(lds0 + VRING) + v_rd_base(lane);
    constexpr int NT = 264;
    f32x2 l0a = {0.f, 0.f}, l0b = {0.f, 0.f}, l1a = {0.f, 0.f}, l1b = {0.f, 0.f};
#define EX(v) ((VAR == 2) ? (v) * 0.5f : (VAR == 6) ? (v) : __builtin_amdgcn_exp2f(v))
#define PK4(P, BASE, OUT) do { if (VAR == 6 || VAR == 8) break; unsigned a0 = cvt_pk_bf16(P[BASE + 0], P[BASE + 1]), a1 = cvt_pk_bf16(P[BASE + 2], P[BASE + 3]);   \
    unsigned b0_ = cvt_pk_bf16(P[BASE + 4], P[BASE + 5]), b1_ = cvt_pk_bf16(P[BASE + 6], P[BASE + 7]);                              \
    auto r0 = __builtin_amdgcn_permlane32_swap(a0, b0_, false, false); auto r1 = __builtin_amdgcn_permlane32_swap(a1, b1_, false, false); \
    u32x4 w = {r0[0], r1[0], r0[1], r1[1]}; OUT = *reinterpret_cast<bf16x8*>(&w); } while (0)
#define LSUM2(la, lb, P, B) do { if (VAR == 6 || VAR == 8) break; const float t0_ = (P[B] + P[B + 1]) + (P[B + 2] + P[B + 3]), t1_ = (P[B + 4] + P[B + 5]) + (P[B + 6] + P[B + 7]); la[0] += t0_ + t1_; } while (0)
#define KRD(MP, kb_, k0_, k1_, k2_, k3_) do { LDK(k0_, (kb_) ^ (((MP) * 4 + 0) << 5), 0); LDK(k1_, (kb_) ^ (((MP) * 4 + 1) << 5), 0); LDK(k2_, (kb_) ^ (((MP) * 4 + 2) << 5), 0); LDK(k3_, (kb_) ^ (((MP) * 4 + 3) << 5), 0); } while (0)
#define QRD(MP, q0_, q1_, q2_, q3_) do { LDK(q0_, q1a, (MP) * 4096 + 0); LDK(q1_, q1a, (MP) * 4096 + 1024); LDK(q2_, q1a, (MP) * 4096 + 2048); LDK(q3_, q1a, (MP) * 4096 + 3072); } while (0)
#define QKMF(S_, k0_, k1_, k2_, k3_, q0_, q1_, q2_, q3_) do { \
    S_ = __builtin_amdgcn_mfma_f32_32x32x16_bf16(k0_, q0_, (f32x16){}, 0, 0, 0); S_ = __builtin_amdgcn_mfma_f32_32x32x16_bf16(k1_, q1_, S_, 0, 0, 0); \
    S_ = __builtin_amdgcn_mfma_f32_32x32x16_bf16(k2_, q2_, S_, 0, 0, 0); S_ = __builtin_amdgcn_mfma_f32_32x32x16_bf16(k3_, q3_, S_, 0, 0, 0); } while (0)
#define SMX_E(S_) do { _Pragma("unroll") for (int r = 0; r < 16; ++r) S_[r] = EX(S_[r]); } while (0)
#define SMX_P(S_, PA, LA, LB) do { PK4(S_, 0, PA[0]); PK4(S_, 8, PA[1]); LSUM2(LA, LB, S_, 0); LSUM2(LA, LB, S_, 8); } while (0)
#define QF0(d) qf0[d]
#define QF1(d) qf1[d]
#define TRR(OFF_, vbx__) ((VAR == 6 || VAR == 7) ? tr_fake<OFF_>(vbx__) : tr_read<OFF_>(vbx__))
#define VRD(pre, D0, vbx) const s16x4 pre##0 = TRR(((0 * 4 + D0) * 512), vbx), pre##1 = TRR(((1 * 4 + D0) * 512), vbx), pre##2 = TRR(((2 * 4 + D0) * 512), vbx), pre##3 = TRR(((3 * 4 + D0) * 512), vbx)
#define VF(pre, a, b_) ((bf16x8){pre##a[0], pre##a[1], pre##a[2], pre##a[3], pre##b_[0], pre##b_[1], pre##b_[2], pre##b_[3]})
#define PVM(pre, D0) do { \
    o0[D0] = __builtin_amdgcn_mfma_f32_32x32x16_bf16(pa0[0], VF(pre, 0, 1), o0[D0], 0, 0, 0); o1[D0] = __builtin_amdgcn_mfma_f32_32x32x16_bf16(pa1[0], VF(pre, 0, 1), o1[D0], 0, 0, 0); \
    o0[D0] = __builtin_amdgcn_mfma_f32_32x32x16_bf16(pa0[1], VF(pre, 2, 3), o0[D0], 0, 0, 0); o1[D0] = __builtin_amdgcn_mfma_f32_32x32x16_bf16(pa1[1], VF(pre, 2, 3), o1[D0], 0, 0, 0); } while (0)
#define PVM2(pre, D0, PO0, PO1) do { if (VAR == 3) break; \
    o0[D0] = __builtin_amdgcn_mfma_f32_32x32x16_bf16(PO0[0], VF(pre, 0, 1), o0[D0], 0, 0, 0); o1[D0] = __builtin_amdgcn_mfma_f32_32x32x16_bf16(PO1[0], VF(pre, 0, 1), o1[D0], 0, 0, 0); \
    o0[D0] = __builtin_amdgcn_mfma_f32_32x32x16_bf16(PO0[1], VF(pre, 2, 3), o0[D0], 0, 0, 0); o1[D0] = __builtin_amdgcn_mfma_f32_32x32x16_bf16(PO1[1], VF(pre, 2, 3), o1[D0], 0, 0, 0); } while (0)
#define VRD4(d0_, d1_, d2_, d3_, D0, vbx) do { d0_ = TRR(((0 * 4 + D0) * 512), vbx); d1_ = TRR(((1 * 4 + D0) * 512), vbx); d2_ = TRR(((2 * 4 + D0) * 512), vbx); d3_ = TRR(((3 * 4 + D0) * 512), vbx); } while (0)
    bf16x8 pa0[2], pa1[2];
    bf16x8 pk0, pk1, pk2, pk3, pq0, pq1, pq2, pq3;
    s16x4 va0, va1, va2, va3;
#define STEP5(j, HASPV, HASNEXT) do { \
    const int kcur_ = kbase + ((j) & 3) * SLOT, knxt_ = kbase + (((j) + 1) & 3) * SLOT, vbx_ = vbase + (((j) - 1) & 3) * SLOT, vnx_ = vbase + ((j) & 3) * SLOT; \
    f32x16 S0_, S1_; bf16x8 mk0, mk1, mk2, mk3, mq0, mq1, mq2, mq3; \
    SBAR(); \
    QKMF(S0_, pk0, pk1, pk2, pk3, pq0, pq1, pq2, pq3); SBAR(); \
    QRD(1, mq0, mq1, mq2, mq3); KRD(1, kcur_, mk0, mk1, mk2, mk3); \
    if (HASPV) { \
        s16x4 vb0, vb1, vb2, vb3; VRD4(vb0, vb1, vb2, vb3, 1, vbx_); SBAR(); \
        PVM2(va, 0, pa0, pa1); SBAR(); \
        WAITL(4); SBAR(); QKMF(S1_, mk0, mk1, mk2, mk3, mq0, mq1, mq2, mq3); SBAR(); \
        { s16x4 vc0, vc1, vc2, vc3; VRD4(vc0, vc1, vc2, vc3, 2, vbx_); WAITL(4); SBAR(); PVM2(vb, 1, pa0, pa1); SMX_E(S0_); SBAR(); \
          { s16x4 vd0, vd1, vd2, vd3; VRD4(vd0, vd1, vd2, vd3, 3, vbx_); WAITL(4); SBAR(); PVM2(vc, 2, pa0, pa1); SMX_E(S1_); SBAR(); \
            if (HASNEXT) { QRD(0, pq0, pq1, pq2, pq3); KRD(0, knxt_, pk0, pk1, pk2, pk3); } \
            if (HASNEXT) WAITL(8); else WAITL(0); \
            SBAR(); \
            LSUM2(l0a, l0b, S0_, 0); LSUM2(l0a, l0b, S0_, 8); LSUM2(l1a, l1b, S1_, 0); LSUM2(l1a, l1b, S1_, 8); \
            if (VAR != 3) { o0[3] = __builtin_amdgcn_mfma_f32_32x32x16_bf16(pa0[0], VF(vd, 0, 1), o0[3], 0, 0, 0); o1[3] = __builtin_amdgcn_mfma_f32_32x32x16_bf16(pa1[0], VF(vd, 0, 1), o1[3], 0, 0, 0); SBAR(); \
              o0[3] = __builtin_amdgcn_mfma_f32_32x32x16_bf16(pa0[1], VF(vd, 2, 3), o0[3], 0, 0, 0); PK4(S0_, 0, pa0[0]); SBAR(); \
              o1[3] = __builtin_amdgcn_mfma_f32_32x32x16_bf16(pa1[1], VF(vd, 2, 3), o1[3], 0, 0, 0); PK4(S1_, 0, pa1[0]); SBAR(); } \
            PK4(S0_, 8, pa0[1]); PK4(S1_, 8, pa1[1]); SBAR(); } } \
    } else { \
        WAITL(0); SBAR(); QKMF(S1_, mk0, mk1, mk2, mk3, mq0, mq1, mq2, mq3); SBAR(); \
        if (HASNEXT) { QRD(0, pq0, pq1, pq2, pq3); KRD(0, knxt_, pk0, pk1, pk2, pk3); } \
        SMX_E(S0_); SMX_E(S1_); SMX_P(S0_, pa0, l0a, l0b); SMX_P(S1_, pa1, l1a, l1b); SBAR(); } \
    VRD4(va0, va1, va2, va3, 0, vnx_); } while (0)
#define MF(acc_, a_, b_) acc_ = __builtin_amdgcn_mfma_f32_32x32x16_bf16(a_, b_, acc_, 0, 0, 0)
#define E2(S_, i_) do { S_[i_] = EX(S_[i_]); S_[(i_) + 1] = EX(S_[(i_) + 1]); } while (0)
#define SUM4(S_, i_) fadd_(fadd_(S_[i_], S_[(i_) + 1]), fadd_(S_[(i_) + 2], S_[(i_) + 3]))
#define STEP6(j) do { \
    const int kcur_ = kbase + ((j) & 3) * SLOT, knxt_ = kbase + (((j) + 1) & 3) * SLOT, vbx_ = vbase + (((j) - 1) & 3) * SLOT, vnx_ = vbase + ((j) & 3) * SLOT; \
    f32x16 S0_, S1_; bf16x8 mk0, mk1, mk2, mk3, mq0, mq1, mq2, mq3; s16x4 vb0, vb1, vb2, vb3, vc0, vc1, vc2, vc3, vd0, vd1, vd2, vd3; float a0_, a1_, a2_, a3_, b0_, b1_; \
    SBAR(); \
    S0_ = __builtin_amdgcn_mfma_f32_32x32x16_bf16(pk0, pq0, (f32x16){}, 0, 0, 0); LDK(mq0, q1a, 4096); LDK(mq1, q1a, 5120); SBAR(); \
    MF(S0_, pk1, pq1); LDK(mq2, q1a, 6144); LDK(mq3, q1a, 7168); SBAR(); \
    MF(S0_, pk2, pq2); LDK(mk0, kcur_ ^ (4 << 5), 0); LDK(mk1, kcur_ ^ (5 << 5), 0); SBAR(); \
    MF(S0_, pk3, pq3); LDK(mk2, kcur_ ^ (6 << 5), 0); LDK(mk3, kcur_ ^ (7 << 5), 0); SBAR(); \
    MF(o0[0], pa0[0], VF(va, 0, 1)); vb0 = TRR(((0 * 4 + 1) * 512), vbx_); vb1 = TRR(((1 * 4 + 1) * 512), vbx_); SBAR(); \
    MF(o1[0], pa1[0], VF(va, 0, 1)); vb2 = TRR(((2 * 4 + 1) * 512), vbx_); vb3 = TRR(((3 * 4 + 1) * 512), vbx_); SBAR(); \
    MF(o0[0], pa0[1], VF(va, 2, 3)); E2(S0_, 0); SBAR(); \
    MF(o1[0], pa1[1], VF(va, 2, 3)); E2(S0_, 2); SBAR(); \
    WAITL(4); SBAR(); \
    S1_ = __builtin_amdgcn_mfma_f32_32x32x16_bf16(mk0, mq0, (f32x16){}, 0, 0, 0); E2(S0_, 4); LDK(pk0, knxt_ ^ (0 << 5), 0); SBAR(); \
    MF(S1_, mk1, mq1); E2(S0_, 6); LDK(pk1, knxt_ ^ (1 << 5), 0); SBAR(); \
    MF(S1_, mk2, mq2); E2(S0_, 8); LDK(pk2, knxt_ ^ (2 << 5), 0); SBAR(); \
    MF(S1_, mk3, mq3); E2(S0_, 10); LDK(pk3, knxt_ ^ (3 << 5), 0); SBAR(); \
    WAITL(4); SBAR(); \
    MF(o0[1], pa0[0], VF(vb, 0, 1)); E2(S0_, 12); vc0 = TRR(((0 * 4 + 2) * 512), vbx_); vc1 = TRR(((1 * 4 + 2) * 512), vbx_); SBAR(); \
    MF(o1[1], pa1[0], VF(vb, 0, 1)); E2(S0_, 14); vc2 = TRR(((2 * 4 + 2) * 512), vbx_); vc3 = TRR(((3 * 4 + 2) * 512), vbx_); SBAR(); \
    MF(o0[1], pa0[1], VF(vb, 2, 3)); a0_ = SUM4(S0_, 0); LDK(pq0, q1a, 0); LDK(pq1, q1a, 1024); SBAR(); \
    MF(o1[1], pa1[1], VF(vb, 2, 3)); a1_ = SUM4(S0_, 4); LDK(pq2, q1a, 2048); LDK(pq3, q1a, 3072); SBAR(); \
    WAITL(4); SBAR(); \
    MF(o0[2], pa0[0], VF(vc, 0, 1)); E2(S1_, 0); vd0 = TRR(((0 * 4 + 3) * 512), vbx_); vd1 = TRR(((1 * 4 + 3) * 512), vbx_); SBAR(); \
    MF(o1[2], pa1[0], VF(vc, 0, 1)); E2(S1_, 2); vd2 = TRR(((2 * 4 + 3) * 512), vbx_); vd3 = TRR(((3 * 4 + 3) * 512), vbx_); SBAR(); \
    MF(o0[2], pa0[1], VF(vc, 2, 3)); E2(S1_, 4); a2_ = SUM4(S0_, 8); va0 = TRR(((0 * 4 + 0) * 512), vnx_); va1 = TRR(((1 * 4 + 0) * 512), vnx_); SBAR(); \
    MF(o1[2], pa1[1], VF(vc, 2, 3)); E2(S1_, 6); a3_ = SUM4(S0_, 12); va2 = TRR(((2 * 4 + 0) * 512), vnx_); va3 = TRR(((3 * 4 + 0) * 512), vnx_); SBAR(); \
    WAITL(4); SBAR(); \
    MF(o0[3], pa0[0], VF(vd, 0, 1)); E2(S1_, 8); l0a[0] += fadd_(fadd_(a0_, a1_), fadd_(a2_, a3_)); SBAR(); \
    MF(o1[3], pa1[0], VF(vd, 0, 1)); E2(S1_, 10); PK4(S0_, 0, pa0[0]); SBAR(); \
    MF(o0[3], pa0[1], VF(vd, 2, 3)); E2(S1_, 12); b0_ = SUM4(S1_, 0); SBAR(); \
    MF(o1[3], pa1[1], VF(vd, 2, 3)); E2(S1_, 14); PK4(S0_, 8, pa0[1]); b1_ = SUM4(S1_, 4); SBAR(); \
    PK4(S1_, 0, pa1[0]); PK4(S1_, 8, pa1[1]); l1a[0] += fadd_(fadd_(b0_, b1_), fadd_(SUM4(S1_, 8), SUM4(S1_, 12))); SBAR(); } while (0)
    DMA_K(0); DMA_V(0); DMA_K(1); DMA_V(1); DMA_K(2);
    BARV(1);
    QRD(0, pq0, pq1, pq2, pq3); KRD(0, kbase, pk0, pk1, pk2, pk3); WAITL(0);
    DMA_K(3); DMA_V(2);
    STEP5(0, 0, 1);
    BARV(2);
#pragma unroll 1
    for (int j = 1; j + 1 < NT; ++j) {
        if (j + 3 < NT) DMA_K(j + 3);
        if (j + 2 < NT) DMA_V(j + 2);
        if (VAR == 3) STEP5(j, 1, 1); else STEP6(j);
        if (j + 3 < NT) BARV(2); else BARV(0);
    }
    STEP5(NT - 1, 1, 0);
    BARV(0);
    { const int vbx_ = vbase + ((NT - 1) & 3) * SLOT;
      s16x4 vb0, vb1, vb2, vb3, vc0, vc1, vc2, vc3, vd0, vd1, vd2, vd3;
      VRD4(vb0, vb1, vb2, vb3, 1, vbx_); WAITL(4); SBAR(); PVM2(va, 0, pa0, pa1); SBAR();
      VRD4(vc0, vc1, vc2, vc3, 2, vbx_); WAITL(4); SBAR(); PVM2(vb, 1, pa0, pa1); SBAR();
      VRD4(vd0, vd1, vd2, vd3, 3, vbx_); WAITL(4); SBAR(); PVM2(vc, 2, pa0, pa1); SBAR(); WAITL(0); SBAR(); PVM2(vd, 3, pa0, pa1); SBAR(); }
    float l0 = (l0a[0] + l0a[1]) + (l0b[0] + l0b[1]), l1 = (l1a[0] + l1a[1]) + (l1b[0] + l1b[1]);
    { auto rr = __builtin_amdgcn_permlane32_swap(__float_as_uint(l0), __float_as_uint(l0), false, false); l0 = __uint_as_float(rr[0]) + __uint_as_float(rr[1]); }
    { auto rr = __builtin_amdgcn_permlane32_swap(__float_as_uint(l1), __float_as_uint(l1), false, false); l1 = __uint_as_float(rr[0]) + __uint_as_float(rr[1]); }
    if (hi == 0) { li_l[r32] = __builtin_amdgcn_rcpf(l0); li_l[32 + r32] = lam * __builtin_amdgcn_rcpf(l1); }
    asm volatile("s_waitcnt lgkmcnt(0)" ::: "memory");
    if (do_store) {
        float sg[4];
#pragma unroll
        for (int d0 = 0; d0 < 4; ++d0) sg[d0] = subg[d0 * 32 + r32] * 0.8f;
        bf16_t* Ow = Ob + qrow * 2048 + 1024 + h * 128;
#pragma unroll
        for (int r = 0; r < 16; ++r) {
            float dv[4]; float ss = 0.f; const float ra_ = li_l[crow(r, hi)], rb_ = li_l[32 + crow(r, hi)];
#pragma unroll
            for (int d0 = 0; d0 < 4; ++d0) { dv[d0] = o0[d0][r] * ra_ - o1[d0][r] * rb_; ss += dv[d0] * dv[d0]; }
#pragma unroll
            for (int s_ = 1; s_ < 32; s_ <<= 1) ss += __shfl_xor(ss, s_);
            const float rs = rsqrtf(ss * (1.0f / 128.0f) + EPSN);
#pragma unroll
            for (int d0 = 0; d0 < 4; ++d0) { const unsigned w = cvt_pk_bf16(dv[d0] * rs * sg[d0], 0.f); Ow[(size_t)crow(r, hi) * 2048 + d0 * 32 + r32] = (bf16_t)(w & 0xffffu); }
        }
    }
    BARV(0);
#undef TBASE
#undef DMA_K
#undef DMA_V
#undef BARV
#undef WAITL
#undef LDK
#undef EX
#undef PK4
#undef LSUM2
#undef KRD
#undef QRD
#undef QKMF
#undef VRD4
#undef STEP5
#undef STEP6
#undef MF
#undef E2
#undef SUM4
#undef SMX_E
#undef SMX_P
#undef PVM2
#undef STEP4
#undef QF0
#undef QF1
#undef VRD
#undef VF
#undef PVM
}
template <int VAR> __device__ __forceinline__ void attnB7_unit(const bf16_t* Qb, const bf16_t* __restrict__ KBp, const bf16_t* __restrict__ VBp, bf16_t* Ob, int b, int h, int qb, char* lds, float lam, const float* subg, const int wid, const bool do_store, const int nb, const int nh, const int nqb, const bool first, const bool has_next) {
    const int lane = lane_id(), r32 = lane & 31, hi = lane >> 5;
    constexpr int SLOT = 8192, VRING = 4 * SLOT, QOFF = 8 * SLOT;
    float* li_l = (float*)(lds + B2_WS) + wid * 64;
    f32x16 o0[4] = {}, o1[4] = {};
    const size_t qrow = (size_t)b * SEQ + qb * 256 + wid * 32;
    const int q1a = (int)(uintptr_t)lds + QOFF + wid * 8192 + lane * 16;
    unsigned koff, voff;
    { const int p = wid * 64 + lane;
      { const int row = p >> 4, cpos = p & 15, chunk = cpos ^ (row & 15); koff = (unsigned)(row * 2048 + chunk * 16); }
      { const int st = p >> 5, kk7 = (p >> 2) & 7, ch = p & 3, kk = (st >> 2) * 8 + kk7, k = (kk & ~0xC) | ((kk & 4) << 1) | ((kk & 8) >> 1), c = (st & 3) * 32 + ch * 8; voff = (unsigned)(k * 2048 + c * 2); } }
    const char* Kg = (const char*)KBp; const char* Vg = (const char*)VBp;
    const unsigned lds0 = (unsigned)(uintptr_t)lds;
    const unsigned kdst = lds0 + wid * 1024, vdst = lds0 + VRING + wid * 1024;
#define TB(bb_, hh_, tile) (((tile) < 256 ? (size_t)(bb_) * SEQ + (size_t)(tile) * 32 : (size_t)T + (size_t)(bb_) * CTXL + (size_t)((tile) - 256) * 32) * 2048 + (size_t)(hh_) * 256)
#define DMA_K(tile) do { if (VAR == 1) break; glds16s(Kg + TB(b, h, tile), koff, kdst + (unsigned)(((tile) & 3) * SLOT)); } while (0)
#define DMA_V(tile) do { if (VAR == 1) break; glds16s(Vg + TB(b, h, tile), voff, vdst + (unsigned)(((tile) & 3) * SLOT)); } while (0)
#define DMA_KN(tile) do { if (VAR == 1) break; glds16s(Kg + TB(nb, nh, tile), koff, kdst + (unsigned)(((tile) & 3) * SLOT)); } while (0)
#define DMA_VN(tile) do { if (VAR == 1) break; glds16s(Vg + TB(nb, nh, tile), voff, vdst + (unsigned)(((tile) & 3) * SLOT)); } while (0)
#define QDMA(bb_, hh_, qq_) do { const int lq_ = lane_id(); const bf16_t* qs_ = Qb + ((size_t)(bb_) * SEQ + (size_t)(qq_) * 256 + wid * 32) * 2048 + 1024 + (hh_) * 128; const unsigned qo_ = (unsigned)((lq_ & 31) * 4096 + (lq_ >> 5) * 16); \
    _Pragma("unroll") for (int d0 = 0; d0 < 8; ++d0) glds16s(qs_ + d0 * 16, qo_, lds0 + QOFF + wid * 8192 + d0 * 1024); } while (0)
#define BARV(N) do { if (VAR == 4) asm volatile("s_waitcnt vmcnt(" #N ") lgkmcnt(0)" ::: "memory"); else asm volatile("s_waitcnt vmcnt(" #N ") lgkmcnt(0)\n\ts_barrier" ::: "memory"); } while (0)
#define WAITL(N) asm volatile("s_waitcnt lgkmcnt(" #N ")" ::: "memory")
#define LDK(dst, addr, OFF) do { if (VAR == 6 || VAR == 7) { asm volatile("" : "=v"(dst)); } else asm volatile("ds_read_b128 %0, %1 offset:%2" : "=&v"(dst) : "v"(addr), "i"(OFF) : "memory"); } while (0)
    const int kbase = (int)lds0 + r32 * 256 + ((hi ^ (r32 & 15)) << 4);
    const int vbase = (int)(lds0 + VRING) + (((lane & 3) << 3) | (((lane >> 2) & 3) << 6) | (((lane >> 4) & 1) << 5) | ((lane >> 5) << 11));
    constexpr int NT = 264;
    f32x2 l0a = {0.f, 0.f}, l0b = {0.f, 0.f}, l1a = {0.f, 0.f}, l1b = {0.f, 0.f};
#define EX(v) ((VAR == 2) ? (v) * 0.5f : (VAR == 6) ? (v) : __builtin_amdgcn_exp2f(v))
#define PK4(P, BASE, OUT) do { if (VAR == 6 || VAR == 8) break; u32x4 w_ = {cvt_pk_bf16(P[BASE + 0], P[BASE + 1]), cvt_pk_bf16(P[BASE + 2], P[BASE + 3]), cvt_pk_bf16(P[BASE + 4], P[BASE + 5]), cvt_pk_bf16(P[BASE + 6], P[BASE + 7])}; OUT = *reinterpret_cast<bf16x8*>(&w_); } while (0)
#define LSUM2(la, lb, P, B) do { if (VAR == 6 || VAR == 8) break; const float t0_ = (P[B] + P[B + 1]) + (P[B + 2] + P[B + 3]), t1_ = (P[B + 4] + P[B + 5]) + (P[B + 6] + P[B + 7]); la[0] += t0_ + t1_; } while (0)
#define KRD(MP, kb_, k0_, k1_, k2_, k3_) do { LDK(k0_, (kb_) ^ (((MP) * 4 + 0) << 5), 0); LDK(k1_, (kb_) ^ (((MP) * 4 + 1) << 5), 0); LDK(k2_, (kb_) ^ (((MP) * 4 + 2) << 5), 0); LDK(k3_, (kb_) ^ (((MP) * 4 + 3) << 5), 0); } while (0)
#define QRD(MP, q0_, q1_, q2_, q3_) do { LDK(q0_, q1a, (MP) * 4096 + 0); LDK(q1_, q1a, (MP) * 4096 + 1024); LDK(q2_, q1a, (MP) * 4096 + 2048); LDK(q3_, q1a, (MP) * 4096 + 3072); } while (0)
#define QKMF(S_, k0_, k1_, k2_, k3_, q0_, q1_, q2_, q3_) do { \
    S_ = __builtin_amdgcn_mfma_f32_32x32x16_bf16(k0_, q0_, (f32x16){}, 0, 0, 0); S_ = __builtin_amdgcn_mfma_f32_32x32x16_bf16(k1_, q1_, S_, 0, 0, 0); \
    S_ = __builtin_amdgcn_mfma_f32_32x32x16_bf16(k2_, q2_, S_, 0, 0, 0); S_ = __builtin_amdgcn_mfma_f32_32x32x16_bf16(k3_, q3_, S_, 0, 0, 0); } while (0)
#define SMX_E(S_) do { _Pragma("unroll") for (int r = 0; r < 16; ++r) S_[r] = EX(S_[r]); } while (0)
#define SMX_P(S_, PA, LA, LB) do { PK4(S_, 0, PA[0]); PK4(S_, 8, PA[1]); LSUM2(LA, LB, S_, 0); LSUM2(LA, LB, S_, 8); } while (0)
#define QF0(d) qf0[d]
#define QF1(d) qf1[d]
#define TRR(OFF_, vbx__) ((VAR == 6 || VAR == 7) ? tr_fake<OFF_>(vbx__) : tr_read<OFF_>(vbx__))
#define VRD(pre, D0, vbx) const s16x4 pre##0 = TRR(((0 * 4 + D0) * 512 + 0), vbx), pre##1 = TRR(((0 * 4 + D0) * 512 + 256), vbx), pre##2 = TRR(((2 * 4 + D0) * 512 + 0), vbx), pre##3 = TRR(((2 * 4 + D0) * 512 + 256), vbx)
#define VF(pre, a, b_) ((bf16x8){pre##a[0], pre##a[1], pre##a[2], pre##a[3], pre##b_[0], pre##b_[1], pre##b_[2], pre##b_[3]})
#define PVM(pre, D0) do { \
    o0[D0] = __builtin_amdgcn_mfma_f32_32x32x16_bf16(VF(pre, 0, 1), pa0[0], o0[D0], 0, 0, 0); o1[D0] = __builtin_amdgcn_mfma_f32_32x32x16_bf16(VF(pre, 0, 1), pa1[0], o1[D0], 0, 0, 0); \
    o0[D0] = __builtin_amdgcn_mfma_f32_32x32x16_bf16(VF(pre, 2, 3), pa0[1], o0[D0], 0, 0, 0); o1[D0] = __builtin_amdgcn_mfma_f32_32x32x16_bf16(VF(pre, 2, 3), pa1[1], o1[D0], 0, 0, 0); } while (0)
#define PVM2(pre, D0, PO0, PO1) do { if (VAR == 3) break; \
    o0[D0] = __builtin_amdgcn_mfma_f32_32x32x16_bf16(VF(pre, 0, 1), PO0[0], o0[D0], 0, 0, 0); o1[D0] = __builtin_amdgcn_mfma_f32_32x32x16_bf16(VF(pre, 0, 1), PO1[0], o1[D0], 0, 0, 0); \
    o0[D0] = __builtin_amdgcn_mfma_f32_32x32x16_bf16(VF(pre, 2, 3), PO0[1], o0[D0], 0, 0, 0); o1[D0] = __builtin_amdgcn_mfma_f32_32x32x16_bf16(VF(pre, 2, 3), PO1[1], o1[D0], 0, 0, 0); } while (0)
#define VRD4(d0_, d1_, d2_, d3_, D0, vbx) do { d0_ = TRR(((0 * 4 + D0) * 512 + 0), vbx); d1_ = TRR(((0 * 4 + D0) * 512 + 256), vbx); d2_ = TRR(((2 * 4 + D0) * 512 + 0), vbx); d3_ = TRR(((2 * 4 + D0) * 512 + 256), vbx); } while (0)
    bf16x8 pa0[2], pa1[2];
    bf16x8 pk0, pk1, pk2, pk3, pq0, pq1, pq2, pq3;
    s16x4 va0, va1, va2, va3;
#define STEP5(j, HASPV, HASNEXT) do { \
    const int kcur_ = kbase + ((j) & 3) * SLOT, knxt_ = kbase + (((j) + 1) & 3) * SLOT, vbx_ = vbase + (((j) - 1) & 3) * SLOT, vnx_ = vbase + ((j) & 3) * SLOT; \
    f32x16 S0_, S1_; bf16x8 mk0, mk1, mk2, mk3, mq0, mq1, mq2, mq3; \
    SBAR(); \
    QKMF(S0_, pk0, pk1, pk2, pk3, pq0, pq1, pq2, pq3); SBAR(); \
    QRD(1, mq0, mq1, mq2, mq3); KRD(1, kcur_, mk0, mk1, mk2, mk3); \
    if (HASPV) { \
        s16x4 vb0, vb1, vb2, vb3; VRD4(vb0, vb1, vb2, vb3, 1, vbx_); SBAR(); \
        PVM2(va, 0, pa0, pa1); SBAR(); \
        WAITL(4); SBAR(); QKMF(S1_, mk0, mk1, mk2, mk3, mq0, mq1, mq2, mq3); SBAR(); \
        { s16x4 vc0, vc1, vc2, vc3; VRD4(vc0, vc1, vc2, vc3, 2, vbx_); WAITL(4); SBAR(); PVM2(vb, 1, pa0, pa1); SMX_E(S0_); SBAR(); \
          { s16x4 vd0, vd1, vd2, vd3; VRD4(vd0, vd1, vd2, vd3, 3, vbx_); WAITL(4); SBAR(); PVM2(vc, 2, pa0, pa1); SMX_E(S1_); SBAR(); \
            if (HASNEXT) { KRD(0, knxt_, pk0, pk1, pk2, pk3); } \
            if (HASNEXT) WAITL(4); else WAITL(0); \
            SBAR(); \
            LSUM2(l0a, l0b, S0_, 0); LSUM2(l0a, l0b, S0_, 8); LSUM2(l1a, l1b, S1_, 0); LSUM2(l1a, l1b, S1_, 8); \
            if (VAR != 3) { o0[3] = __builtin_amdgcn_mfma_f32_32x32x16_bf16(VF(vd, 0, 1), pa0[0], o0[3], 0, 0, 0); o1[3] = __builtin_amdgcn_mfma_f32_32x32x16_bf16(VF(vd, 0, 1), pa1[0], o1[3], 0, 0, 0); SBAR(); \
              o0[3] = __builtin_amdgcn_mfma_f32_32x32x16_bf16(VF(vd, 2, 3), pa0[1], o0[3], 0, 0, 0); PK4(S0_, 0, pa0[0]); SBAR(); \
              o1[3] = __builtin_amdgcn_mfma_f32_32x32x16_bf16(VF(vd, 2, 3), pa1[1], o1[3], 0, 0, 0); PK4(S1_, 0, pa1[0]); SBAR(); } \
            PK4(S0_, 8, pa0[1]); PK4(S1_, 8, pa1[1]); SBAR(); } } \
    } else { \
        WAITL(0); SBAR(); QKMF(S1_, mk0, mk1, mk2, mk3, mq0, mq1, mq2, mq3); SBAR(); \
        if (HASNEXT) { KRD(0, knxt_, pk0, pk1, pk2, pk3); } \
        SMX_E(S0_); SMX_E(S1_); SMX_P(S0_, pa0, l0a, l0b); SMX_P(S1_, pa1, l1a, l1b); SBAR(); } \
    VRD4(va0, va1, va2, va3, 0, vnx_); } while (0)
#define MF(acc_, a_, b_) acc_ = __builtin_amdgcn_mfma_f32_32x32x16_bf16(a_, b_, acc_, 0, 0, 0)
#define E2(S_, i_) do { S_[i_] = EX(S_[i_]); S_[(i_) + 1] = EX(S_[(i_) + 1]); } while (0)
#define SUM4(S_, i_) fadd_(fadd_(S_[i_], S_[(i_) + 1]), fadd_(S_[(i_) + 2], S_[(i_) + 3]))
#define STEP6(j) do { \
    const int kcur_ = kbase + ((j) & 3) * SLOT, knxt_ = kbase + (((j) + 1) & 3) * SLOT, vbx_ = vbase + (((j) - 1) & 3) * SLOT, vnx_ = vbase + ((j) & 3) * SLOT; \
    f32x16 S0_, S1_; bf16x8 mk0, mk1, mk2, mk3, mq0, mq1, mq2, mq3; s16x4 vb0, vb1, vb2, vb3, vc0, vc1, vc2, vc3, vd0, vd1, vd2, vd3; float a0_, a1_, a2_, a3_, b0_, b1_; \
    SBAR(); \
    S0_ = __builtin_amdgcn_mfma_f32_32x32x16_bf16(pk0, pq0, (f32x16){}, 0, 0, 0); LDK(mq0, q1a, 4096); LDK(mq1, q1a, 5120); SBAR(); \
    MF(S0_, pk1, pq1); LDK(mq2, q1a, 6144); LDK(mq3, q1a, 7168); SBAR(); \
    MF(S0_, pk2, pq2); LDK(mk0, kcur_ ^ (4 << 5), 0); LDK(mk1, kcur_ ^ (5 << 5), 0); SBAR(); \
    MF(S0_, pk3, pq3); LDK(mk2, kcur_ ^ (6 << 5), 0); LDK(mk3, kcur_ ^ (7 << 5), 0); SBAR(); \
    MF(o0[0], VF(va, 0, 1), pa0[0]); vb0 = TRR(((0 * 4 + 1) * 512 + 0), vbx_); vb1 = TRR(((0 * 4 + 1) * 512 + 256), vbx_); SBAR(); \
    MF(o1[0], VF(va, 0, 1), pa1[0]); vb2 = TRR(((2 * 4 + 1) * 512 + 0), vbx_); vb3 = TRR(((2 * 4 + 1) * 512 + 256), vbx_); SBAR(); \
    MF(o0[0], VF(va, 2, 3), pa0[1]); E2(S0_, 0); SBAR(); \
    MF(o1[0], VF(va, 2, 3), pa1[1]); E2(S0_, 2); SBAR(); \
    WAITL(4); SBAR(); \
    S1_ = __builtin_amdgcn_mfma_f32_32x32x16_bf16(mk0, mq0, (f32x16){}, 0, 0, 0); E2(S0_, 4); SBAR(); \
    MF(S1_, mk1, mq1); E2(S0_, 6); SBAR(); \
    MF(S1_, mk2, mq2); E2(S0_, 8); SBAR(); \
    MF(S1_, mk3, mq3); E2(S0_, 10); SBAR(); \
    WAITL(0); SBAR(); \
    MF(o0[1], VF(vb, 0, 1), pa0[0]); E2(S0_, 12); vc0 = TRR(((0 * 4 + 2) * 512 + 0), vbx_); vc1 = TRR(((0 * 4 + 2) * 512 + 256), vbx_); SBAR(); \
    MF(o1[1], VF(vb, 0, 1), pa1[0]); E2(S0_, 14); vc2 = TRR(((2 * 4 + 2) * 512 + 0), vbx_); vc3 = TRR(((2 * 4 + 2) * 512 + 256), vbx_); SBAR(); \
    MF(o0[1], VF(vb, 2, 3), pa0[1]); a0_ = SUM4(S0_, 0); LDK(pk0, knxt_ ^ (0 << 5), 0); LDK(pk1, knxt_ ^ (1 << 5), 0); SBAR(); \
    MF(o1[1], VF(vb, 2, 3), pa1[1]); a1_ = SUM4(S0_, 4); LDK(pk2, knxt_ ^ (2 << 5), 0); LDK(pk3, knxt_ ^ (3 << 5), 0); SBAR(); \
    WAITL(4); SBAR(); \
    MF(o0[2], VF(vc, 0, 1), pa0[0]); E2(S1_, 0); vd0 = TRR(((0 * 4 + 3) * 512 + 0), vbx_); vd1 = TRR(((0 * 4 + 3) * 512 + 256), vbx_); SBAR(); \
    MF(o1[2], VF(vc, 0, 1), pa1[0]); E2(S1_, 2); vd2 = TRR(((2 * 4 + 3) * 512 + 0), vbx_); vd3 = TRR(((2 * 4 + 3) * 512 + 256), vbx_); SBAR(); \
    MF(o0[2], VF(vc, 2, 3), pa0[1]); E2(S1_, 4); a2_ = SUM4(S0_, 8); va0 = TRR(((0 * 4 + 0) * 512 + 0), vnx_); va1 = TRR(((0 * 4 + 0) * 512 + 256), vnx_); SBAR(); \
    MF(o1[2], VF(vc, 2, 3), pa1[1]); E2(S1_, 6); a3_ = SUM4(S0_, 12); va2 = TRR(((2 * 4 + 0) * 512 + 0), vnx_); va3 = TRR(((2 * 4 + 0) * 512 + 256), vnx_); SBAR(); \
    WAITL(4); SBAR(); \
    MF(o0[3], VF(vd, 0, 1), pa0[0]); E2(S1_, 8); l0a[0] += fadd_(fadd_(a0_, a1_), fadd_(a2_, a3_)); SBAR(); \
    MF(o1[3], VF(vd, 0, 1), pa1[0]); E2(S1_, 10); PK4(S0_, 0, pa0[0]); SBAR(); \
    MF(o0[3], VF(vd, 2, 3), pa0[1]); E2(S1_, 12); b0_ = SUM4(S1_, 0); SBAR(); \
    MF(o1[3], VF(vd, 2, 3), pa1[1]); E2(S1_, 14); PK4(S0_, 8, pa0[1]); b1_ = SUM4(S1_, 4); SBAR(); \
    PK4(S1_, 0, pa1[0]); PK4(S1_, 8, pa1[1]); l1a[0] += fadd_(fadd_(b0_, b1_), fadd_(SUM4(S1_, 8), SUM4(S1_, 12))); SBAR(); } while (0)
    if (first) { QDMA(b, h, qb); DMA_K(0); DMA_V(0); DMA_K(1); DMA_V(1); DMA_K(2); BARV(1); }
    else BARV(0);
    QRD(0, pq0, pq1, pq2, pq3); KRD(0, kbase, pk0, pk1, pk2, pk3); WAITL(0);
    DMA_K(3); DMA_V(2);
    STEP5(0, 0, 1);
    BARV(2);
#pragma unroll 1
    for (int j = 1; j + 1 < NT; ++j) {
        if (j + 3 < NT) DMA_K(j + 3);
        if (j + 2 < NT) DMA_V(j + 2);
        if (VAR == 3) STEP5(j, 1, 1); else STEP6(j);
        if (j + 3 < NT) BARV(2); else BARV(0);
    }
    STEP5(NT - 1, 1, 0);
    BARV(0);
    if (has_next) { QDMA(nb, nh, nqb); DMA_KN(0); DMA_VN(0); DMA_KN(1); DMA_VN(1); DMA_KN(2); }
    { const int vbx_ = vbase + ((NT - 1) & 3) * SLOT;
      s16x4 vb0, vb1, vb2, vb3, vc0, vc1, vc2, vc3, vd0, vd1, vd2, vd3;
      VRD4(vb0, vb1, vb2, vb3, 1, vbx_); WAITL(4); SBAR(); PVM2(va, 0, pa0, pa1); SBAR();
      VRD4(vc0, vc1, vc2, vc3, 2, vbx_); WAITL(4); SBAR(); PVM2(vb, 1, pa0, pa1); SBAR();
      VRD4(vd0, vd1, vd2, vd3, 3, vbx_); WAITL(4); SBAR(); PVM2(vc, 2, pa0, pa1); SBAR(); WAITL(0); SBAR(); PVM2(vd, 3, pa0, pa1); SBAR(); }
    float l0 = (l0a[0] + l0a[1]) + (l0b[0] + l0b[1]), l1 = (l1a[0] + l1a[1]) + (l1b[0] + l1b[1]);
    { auto rr = __builtin_amdgcn_permlane32_swap(__float_as_uint(l0), __float_as_uint(l0), false, false); l0 = __uint_as_float(rr[0]) + __uint_as_float(rr[1]); }
    { auto rr = __builtin_amdgcn_permlane32_swap(__float_as_uint(l1), __float_as_uint(l1), false, false); l1 = __uint_as_float(rr[0]) + __uint_as_float(rr[1]); }
    (void)li_l;
    if (do_store) {
        const float ra_ = __builtin_amdgcn_rcpf(l0), rb_ = lam * __builtin_amdgcn_rcpf(l1);
        float ss = 0.f;
#pragma unroll
        for (int d0 = 0; d0 < 4; ++d0)
#pragma unroll
            for (int r = 0; r < 16; ++r) { const float dv = o0[d0][r] * ra_ - o1[d0][r] * rb_; o0[d0][r] = dv; ss += dv * dv; }
        { auto rr = __builtin_amdgcn_permlane32_swap(__float_as_uint(ss), __float_as_uint(ss), false, false); ss = __uint_as_float(rr[0]) + __uint_as_float(rr[1]); }
        const float rs = rsqrtf(ss * (1.0f / 128.0f) + EPSN) * 0.8f;
        const int le_ = lane_id(), r32e = le_ & 31, hie = le_ >> 5;
        bf16_t* Ow = Ob + (qrow + r32e) * 2048 + 1024 + h * 128 + 4 * hie;
#pragma unroll
        for (int d0 = 0; d0 < 4; ++d0)
#pragma unroll
            for (int r4 = 0; r4 < 4; ++r4) {
                const f32x4 sg = *(const f32x4*)(subg + d0 * 32 + r4 * 8 + 4 * hie);
                u32x2 w; w.x = cvt_pk_bf16(o0[d0][4 * r4] * rs * sg[0], o0[d0][4 * r4 + 1] * rs * sg[1]); w.y = cvt_pk_bf16(o0[d0][4 * r4 + 2] * rs * sg[2], o0[d0][4 * r4 + 3] * rs * sg[3]);
                *(u32x2*)(Ow + d0 * 32 + r4 * 8) = w;
            }
    }
    if (!has_next) BARV(0);
#undef TB
#undef DMA_KN
#undef DMA_VN
#undef QDMA
#undef DMA_K
#undef DMA_V
#undef BARV
#undef WAITL
#undef LDK
#undef EX
#undef PK4
#undef LSUM2
#undef KRD
#undef QRD
#undef QKMF
#undef VRD4
#undef STEP5
#undef STEP6
#undef MF
#undef E2
#undef SUM4
#undef SMX_E
#undef SMX_P
#undef PVM2
#undef STEP4
#undef QF0
#undef QF1
#undef VRD
#undef VF
#undef PVM
}

__device__ __forceinline__ void attnB8_unit(const bf16_t* Qb, const bf16_t* __restrict__ KBp, const bf16_t* __restrict__ VBp, bf16_t* Ob, int b, int h, int qb, char* lds, const float* lamp, const float* subg, const int wid, const bool do_store, const int nb, const int nh, const int nqb, const bool first, const bool has_next) {
    const int lane = lane_id(), r32 = lane & 31, hi = lane >> 5;
    const int mp = wid & 1, g = wid >> 1;
    constexpr int SLOT = 8192, VRING = 4 * SLOT, QOFF = 8 * SLOT;
    f32x16 o0[4] = {}, o1[4] = {};
    const size_t qrow = (size_t)b * SEQ + qb * 256 + g * 64;
    const int q1a = (int)(uintptr_t)lds + QOFF + wid * 8192 + lane * 16;
    unsigned koff, voff;
    { const int p = wid * 64 + lane;
      { const int row = p >> 4, cpos = p & 15, chunk = cpos ^ (row & 15); koff = (unsigned)(row * 2048 + chunk * 16); }
      { const int st = p >> 5, kk7 = (p >> 2) & 7, ch = p & 3, kk = (st >> 2) * 8 + kk7, k = (kk & ~0xC) | ((kk & 4) << 1) | ((kk & 8) >> 1), c = (st & 3) * 32 + ch * 8; voff = (unsigned)(k * 2048 + c * 2); } }
    const char* Kg = (const char*)KBp; const char* Vg = (const char*)VBp;
    const unsigned lds0 = (unsigned)(uintptr_t)lds;
    const unsigned kdst = lds0 + wid * 1024, vdst = lds0 + VRING + wid * 1024;
#define TB(bb_, hh_, tile) (((tile) < 256 ? (size_t)(bb_) * SEQ + (size_t)(tile) * 32 : (size_t)T + (size_t)(bb_) * CTXL + (size_t)((tile) - 256) * 32) * 2048 + (size_t)(hh_) * 256)
#define DMA_K(tile) glds16s(Kg + TB(b, h, tile), koff, kdst + (unsigned)(((tile) & 3) * SLOT))
#define DMA_V(tile) glds16s(Vg + TB(b, h, tile), voff, vdst + (unsigned)(((tile) & 3) * SLOT))
#define DMA_KN(tile) glds16s(Kg + TB(nb, nh, tile), koff, kdst + (unsigned)(((tile) & 3) * SLOT))
#define DMA_VN(tile) glds16s(Vg + TB(nb, nh, tile), voff, vdst + (unsigned)(((tile) & 3) * SLOT))
#define QDMA(bb_, hh_, qq_) do { const int lq_ = lane_id(); const bf16_t* qs_ = Qb + ((size_t)(bb_) * SEQ + (size_t)(qq_) * 256 + g * 64) * 2048 + 1024 + (hh_) * 128 + mp * 64; const unsigned qo_ = (unsigned)((lq_ & 31) * 4096 + (lq_ >> 5) * 16); \
    _Pragma("unroll") for (int f = 0; f < 8; ++f) glds16s(qs_ + (f >> 2) * (32 * 2048) + (f & 3) * 16, qo_, lds0 + QOFF + wid * 8192 + f * 1024); } while (0)
#define BARV(N) asm volatile("s_waitcnt vmcnt(" #N ") lgkmcnt(0)\n\ts_barrier" ::: "memory")
#define WAITL(N) asm volatile("s_waitcnt lgkmcnt(" #N ")" ::: "memory")
#define LDK(dst, addr, OFF) asm volatile("ds_read_b128 %0, %1 offset:%2" : "=&v"(dst) : "v"(addr), "i"(OFF) : "memory")
    const int kbase = ((int)lds0 + r32 * 256 + ((hi ^ (r32 & 15)) << 4)) ^ (mp << 7);
    const int vbase = (int)(lds0 + VRING) + (((lane & 3) << 3) | (((lane >> 2) & 3) << 6) | (((lane >> 4) & 1) << 5) | ((lane >> 5) << 11));
    constexpr int NT = 264;
    float l0a = 0.f, l1a = 0.f;
#define EX(v) __builtin_amdgcn_exp2f(v)
#define PK4(P, BASE, OUT) do { u32x4 w_ = {cvt_pk_bf16(P[BASE + 0], P[BASE + 1]), cvt_pk_bf16(P[BASE + 2], P[BASE + 3]), cvt_pk_bf16(P[BASE + 4], P[BASE + 5]), cvt_pk_bf16(P[BASE + 6], P[BASE + 7])}; OUT = *reinterpret_cast<bf16x8*>(&w_); } while (0)
#define LSUM2(la, P, B) do { const float t0_ = (P[B] + P[B + 1]) + (P[B + 2] + P[B + 3]), t1_ = (P[B + 4] + P[B + 5]) + (P[B + 6] + P[B + 7]); la += t0_ + t1_; } while (0)
#define KRD(kb_) do { LDK(k0, (kb_) ^ (0 << 5), 0); LDK(k1, (kb_) ^ (1 << 5), 0); LDK(k2, (kb_) ^ (2 << 5), 0); LDK(k3, (kb_) ^ (3 << 5), 0); } while (0)
#define QKMF(S_, q0_, q1_, q2_, q3_) do { \
    S_ = __builtin_amdgcn_mfma_f32_32x32x16_bf16(k0, q0_, (f32x16){}, 0, 0, 0); S_ = __builtin_amdgcn_mfma_f32_32x32x16_bf16(k1, q1_, S_, 0, 0, 0); \
    S_ = __builtin_amdgcn_mfma_f32_32x32x16_bf16(k2, q2_, S_, 0, 0, 0); S_ = __builtin_amdgcn_mfma_f32_32x32x16_bf16(k3, q3_, S_, 0, 0, 0); } while (0)
#define SMX_E(S_) do { _Pragma("unroll") for (int r = 0; r < 16; ++r) S_[r] = EX(S_[r]); } while (0)
#define SMX_P(S_, PA, LA) do { PK4(S_, 0, PA[0]); PK4(S_, 8, PA[1]); LSUM2(LA, S_, 0); LSUM2(LA, S_, 8); } while (0)
#undef TRR
#define TRR(OFF_, vbx__) tr_read<OFF_>(vbx__)
#define VF(pre, a, b_) ((bf16x8){pre##a[0], pre##a[1], pre##a[2], pre##a[3], pre##b_[0], pre##b_[1], pre##b_[2], pre##b_[3]})
#define PVM2(pre, D0, PO0, PO1) do { \
    o0[D0] = __builtin_amdgcn_mfma_f32_32x32x16_bf16(VF(pre, 0, 1), PO0[0], o0[D0], 0, 0, 0); o1[D0] = __builtin_amdgcn_mfma_f32_32x32x16_bf16(VF(pre, 0, 1), PO1[0], o1[D0], 0, 0, 0); \
    o0[D0] = __builtin_amdgcn_mfma_f32_32x32x16_bf16(VF(pre, 2, 3), PO0[1], o0[D0], 0, 0, 0); o1[D0] = __builtin_amdgcn_mfma_f32_32x32x16_bf16(VF(pre, 2, 3), PO1[1], o1[D0], 0, 0, 0); } while (0)
#define VRD4(d0_, d1_, d2_, d3_, D0, vbx) do { d0_ = TRR(((0 * 4 + D0) * 512 + 0), vbx); d1_ = TRR(((0 * 4 + D0) * 512 + 256), vbx); d2_ = TRR(((2 * 4 + D0) * 512 + 0), vbx); d3_ = TRR(((2 * 4 + D0) * 512 + 256), vbx); } while (0)
    bf16x8 pa0[2], pa1[2];
    bf16x8 k0, k1, k2, k3;
    bf16x8 qa0, qa1, qa2, qa3, qb0, qb1, qb2, qb3;
#define STEP5(j, HASPV, HASNEXT) do { \
    const int knxt_ = kbase + (((j) + 1) & 3) * SLOT, vbx_ = vbase + (((j) - 1) & 3) * SLOT; \
    f32x16 S0_, S1_; s16x4 va0, va1, va2, va3; \
    SBAR(); \
    if (HASPV) { VRD4(va0, va1, va2, va3, 0, vbx_); } \
    QKMF(S0_, qa0, qa1, qa2, qa3); SBAR(); \
    if (HASPV) { \
        s16x4 vb0, vb1, vb2, vb3; VRD4(vb0, vb1, vb2, vb3, 1, vbx_); WAITL(4); SBAR(); \
        PVM2(va, 0, pa0, pa1); SBAR(); \
        QKMF(S1_, qb0, qb1, qb2, qb3); SBAR(); \
        { s16x4 vc0, vc1, vc2, vc3; VRD4(vc0, vc1, vc2, vc3, 2, vbx_); WAITL(4); SBAR(); PVM2(vb, 1, pa0, pa1); SMX_E(S0_); SBAR(); \
          { s16x4 vd0, vd1, vd2, vd3; VRD4(vd0, vd1, vd2, vd3, 3, vbx_); WAITL(4); SBAR(); PVM2(vc, 2, pa0, pa1); SMX_E(S1_); SBAR(); \
            if (HASNEXT) { KRD(knxt_); } \
            if (HASNEXT) WAITL(4); else WAITL(0); \
            SBAR(); \
            LSUM2(l0a, S0_, 0); LSUM2(l0a, S0_, 8); LSUM2(l1a, S1_, 0); LSUM2(l1a, S1_, 8); \
            o0[3] = __builtin_amdgcn_mfma_f32_32x32x16_bf16(VF(vd, 0, 1), pa0[0], o0[3], 0, 0, 0); o1[3] = __builtin_amdgcn_mfma_f32_32x32x16_bf16(VF(vd, 0, 1), pa1[0], o1[3], 0, 0, 0); SBAR(); \
            o0[3] = __builtin_amdgcn_mfma_f32_32x32x16_bf16(VF(vd, 2, 3), pa0[1], o0[3], 0, 0, 0); PK4(S0_, 0, pa0[0]); SBAR(); \
            o1[3] = __builtin_amdgcn_mfma_f32_32x32x16_bf16(VF(vd, 2, 3), pa1[1], o1[3], 0, 0, 0); PK4(S1_, 0, pa1[0]); SBAR(); \
            PK4(S0_, 8, pa0[1]); PK4(S1_, 8, pa1[1]); SBAR(); } } \
    } else { \
        QKMF(S1_, qb0, qb1, qb2, qb3); SBAR(); \
        if (HASNEXT) { KRD(knxt_); } \
        SMX_E(S0_); SMX_E(S1_); SMX_P(S0_, pa0, l0a); SMX_P(S1_, pa1, l1a); SBAR(); } \
    } while (0)
#define MF(acc_, a_, b_) acc_ = __builtin_amdgcn_mfma_f32_32x32x16_bf16(a_, b_, acc_, 0, 0, 0)
#define E2(S_, i_) do { S_[i_] = EX(S_[i_]); S_[(i_) + 1] = EX(S_[(i_) + 1]); } while (0)
#define SUM4(S_, i_) fadd_(fadd_(S_[i_], S_[(i_) + 1]), fadd_(S_[(i_) + 2], S_[(i_) + 3]))
#define STEP6(j) do { \
    const int knxt_ = kbase + (((j) + 1) & 3) * SLOT, vbx_ = vbase + (((j) - 1) & 3) * SLOT; \
    f32x16 S0_, S1_; s16x4 va0, va1, va2, va3, vb0, vb1, vb2, vb3, vc0, vc1, vc2, vc3, vd0, vd1, vd2, vd3; float b0_; \
    SBAR(); \
    S0_ = __builtin_amdgcn_mfma_f32_32x32x16_bf16(k0, qa0, (f32x16){}, 0, 0, 0); va0 = TRR(((0 * 4 + 0) * 512 + 0), vbx_); va1 = TRR(((0 * 4 + 0) * 512 + 256), vbx_); SBAR(); \
    MF(S0_, k1, qa1); va2 = TRR(((2 * 4 + 0) * 512 + 0), vbx_); va3 = TRR(((2 * 4 + 0) * 512 + 256), vbx_); SBAR(); \
    MF(S0_, k2, qa2); if ((j) + 3 < NT) DMA_K((j) + 3); SBAR(); \
    MF(S0_, k3, qa3); if ((j) + 2 < NT) DMA_V((j) + 2); SBAR(); \
    WAITL(0); SBAR(); \
    MF(o0[0], VF(va, 0, 1), pa0[0]); vb0 = TRR(((0 * 4 + 1) * 512 + 0), vbx_); vb1 = TRR(((0 * 4 + 1) * 512 + 256), vbx_); SBAR(); \
    MF(o1[0], VF(va, 0, 1), pa1[0]); vb2 = TRR(((2 * 4 + 1) * 512 + 0), vbx_); vb3 = TRR(((2 * 4 + 1) * 512 + 256), vbx_); SBAR(); \
    MF(o0[0], VF(va, 2, 3), pa0[1]); E2(S0_, 0); SBAR(); \
    MF(o1[0], VF(va, 2, 3), pa1[1]); E2(S0_, 2); SBAR(); \
    S1_ = __builtin_amdgcn_mfma_f32_32x32x16_bf16(k0, qb0, (f32x16){}, 0, 0, 0); E2(S0_, 4); SBAR(); \
    MF(S1_, k1, qb1); E2(S0_, 6); SBAR(); \
    MF(S1_, k2, qb2); E2(S0_, 8); SBAR(); \
    MF(S1_, k3, qb3); E2(S0_, 10); SBAR(); \
    WAITL(0); SBAR(); \
    MF(o0[1], VF(vb, 0, 1), pa0[0]); E2(S0_, 12); vc0 = TRR(((0 * 4 + 2) * 512 + 0), vbx_); vc1 = TRR(((0 * 4 + 2) * 512 + 256), vbx_); SBAR(); \
    MF(o1[1], VF(vb, 0, 1), pa1[0]); E2(S0_, 14); vc2 = TRR(((2 * 4 + 2) * 512 + 0), vbx_); vc3 = TRR(((2 * 4 + 2) * 512 + 256), vbx_); SBAR(); \
    MF(o0[1], VF(vb, 2, 3), pa0[1]); l0a += SUM4(S0_, 0); LDK(k0, knxt_ ^ (0 << 5), 0); LDK(k1, knxt_ ^ (1 << 5), 0); SBAR(); \
    MF(o1[1], VF(vb, 2, 3), pa1[1]); l0a += SUM4(S0_, 4); LDK(k2, knxt_ ^ (2 << 5), 0); LDK(k3, knxt_ ^ (3 << 5), 0); SBAR(); \
    WAITL(4); SBAR(); \
    MF(o0[2], VF(vc, 0, 1), pa0[0]); E2(S1_, 0); vd0 = TRR(((0 * 4 + 3) * 512 + 0), vbx_); vd1 = TRR(((0 * 4 + 3) * 512 + 256), vbx_); SBAR(); \
    MF(o1[2], VF(vc, 0, 1), pa1[0]); E2(S1_, 2); vd2 = TRR(((2 * 4 + 3) * 512 + 0), vbx_); vd3 = TRR(((2 * 4 + 3) * 512 + 256), vbx_); SBAR(); \
    MF(o0[2], VF(vc, 2, 3), pa0[1]); E2(S1_, 4); l0a += SUM4(S0_, 8); SBAR(); \
    MF(o1[2], VF(vc, 2, 3), pa1[1]); E2(S1_, 6); l0a += SUM4(S0_, 12); SBAR(); \
    WAITL(0); SBAR(); \
    MF(o0[3], VF(vd, 0, 1), pa0[0]); E2(S1_, 8); SBAR(); \
    MF(o1[3], VF(vd, 0, 1), pa1[0]); E2(S1_, 10); PK4(S0_, 0, pa0[0]); SBAR(); \
    MF(o0[3], VF(vd, 2, 3), pa0[1]); E2(S1_, 12); b0_ = SUM4(S1_, 0); SBAR(); \
    MF(o1[3], VF(vd, 2, 3), pa1[1]); E2(S1_, 14); PK4(S0_, 8, pa0[1]); b0_ = fadd_(b0_, SUM4(S1_, 4)); SBAR(); \
    PK4(S1_, 0, pa1[0]); PK4(S1_, 8, pa1[1]); l1a += fadd_(b0_, fadd_(SUM4(S1_, 8), SUM4(S1_, 12))); SBAR(); } while (0)
    if (first) { QDMA(b, h, qb); DMA_K(0); DMA_V(0); DMA_K(1); DMA_V(1); DMA_K(2); BARV(1); }
    else BARV(0);
    LDK(qa0, q1a, 0); LDK(qa1, q1a, 1024); LDK(qa2, q1a, 2048); LDK(qa3, q1a, 3072); LDK(qb0, q1a, 4096); LDK(qb1, q1a, 5120); LDK(qb2, q1a, 6144); LDK(qb3, q1a, 7168);
    KRD(kbase); WAITL(0);
    DMA_K(3); DMA_V(2);
    STEP5(0, 0, 1);
    BARV(2);
#pragma unroll 1
    for (int j = 1; j + 1 < NT; ++j) {
        STEP6(j);
        if (j + 3 < NT) BARV(2); else BARV(0);
    }
    STEP5(NT - 1, 1, 0);
    BARV(0);
    if (has_next) { QDMA(nb, nh, nqb); DMA_KN(0); DMA_VN(0); DMA_KN(1); DMA_VN(1); DMA_KN(2); }
    { const int vbx_ = vbase + ((NT - 1) & 3) * SLOT;
      s16x4 va0, va1, va2, va3, vb0, vb1, vb2, vb3, vc0, vc1, vc2, vc3, vd0, vd1, vd2, vd3;
      VRD4(va0, va1, va2, va3, 0, vbx_); VRD4(vb0, vb1, vb2, vb3, 1, vbx_); WAITL(4); SBAR(); PVM2(va, 0, pa0, pa1); SBAR();
      VRD4(vc0, vc1, vc2, vc3, 2, vbx_); WAITL(4); SBAR(); PVM2(vb, 1, pa0, pa1); SBAR();
      VRD4(vd0, vd1, vd2, vd3, 3, vbx_); WAITL(4); SBAR(); PVM2(vc, 2, pa0, pa1); SBAR(); WAITL(0); SBAR(); PVM2(vd, 3, pa0, pa1); SBAR(); }
    float l0 = l0a, l1 = l1a;
    { auto rr = __builtin_amdgcn_permlane32_swap(__float_as_uint(l0), __float_as_uint(l0), false, false); l0 = __uint_as_float(rr[0]) + __uint_as_float(rr[1]); }
    { auto rr = __builtin_amdgcn_permlane32_swap(__float_as_uint(l1), __float_as_uint(l1), false, false); l1 = __uint_as_float(rr[0]) + __uint_as_float(rr[1]); }
    {
        const float lamv = *(const volatile float*)lamp;
        const float fsel = mp ? lamv : 1.0f;
        const float sc0 = fsel * __builtin_amdgcn_rcpf(l0), sc1 = fsel * __builtin_amdgcn_rcpf(l1);
        LAS float* xb = (LAS float*)((LAS char*)lds + 139264) + g * 1024 + lane_id();
#define XCH(OA, SC) do { \
        if (mp) { _Pragma("unroll") for (int r = 0; r < 16; ++r) xb[r * 64] = OA[r] * SC; } \
        asm volatile("s_waitcnt lgkmcnt(0)\n\ts_barrier" ::: "memory"); \
        if (!mp) { _Pragma("unroll") for (int r = 0; r < 16; ++r) OA[r] = OA[r] * SC - xb[r * 64]; } \
        asm volatile("s_waitcnt lgkmcnt(0)\n\ts_barrier" ::: "memory"); } while (0)
#pragma unroll
        for (int d0 = 0; d0 < 4; ++d0) { XCH(o0[d0], sc0); XCH(o1[d0], sc1); }
#undef XCH
    }
    if (do_store && mp == 0) {
        float s0 = 0.f, s1 = 0.f;
#pragma unroll
        for (int d0 = 0; d0 < 4; ++d0)
#pragma unroll
            for (int r = 0; r < 16; ++r) { s0 += o0[d0][r] * o0[d0][r]; s1 += o1[d0][r] * o1[d0][r]; }
        { auto rr = __builtin_amdgcn_permlane32_swap(__float_as_uint(s0), __float_as_uint(s0), false, false); s0 = __uint_as_float(rr[0]) + __uint_as_float(rr[1]); }
        { auto rr = __builtin_amdgcn_permlane32_swap(__float_as_uint(s1), __float_as_uint(s1), false, false); s1 = __uint_as_float(rr[0]) + __uint_as_float(rr[1]); }
        const float rs0 = rsqrtf(s0 * (1.0f / 128.0f) + EPSN) * 0.8f, rs1 = rsqrtf(s1 * (1.0f / 128.0f) + EPSN) * 0.8f;
        const int le_ = lane_id(), r32e = le_ & 31, hie = le_ >> 5;
        bf16_t* Ow = Ob + (qrow + r32e) * 2048 + 1024 + h * 128 + 4 * hie;
#pragma unroll
        for (int d0 = 0; d0 < 4; ++d0)
#pragma unroll
            for (int r4 = 0; r4 < 4; ++r4) {
                const f32x4 sg = *(const f32x4*)(subg + d0 * 32 + r4 * 8 + 4 * hie);
                u32x2 w; w.x = cvt_pk_bf16(o0[d0][4 * r4] * rs0 * sg[0], o0[d0][4 * r4 + 1] * rs0 * sg[1]); w.y = cvt_pk_bf16(o0[d0][4 * r4 + 2] * rs0 * sg[2], o0[d0][4 * r4 + 3] * rs0 * sg[3]);
                *(u32x2*)(Ow + d0 * 32 + r4 * 8) = w;
                u32x2 w2; w2.x = cvt_pk_bf16(o1[d0][4 * r4] * rs1 * sg[0], o1[d0][4 * r4 + 1] * rs1 * sg[1]); w2.y = cvt_pk_bf16(o1[d0][4 * r4 + 2] * rs1 * sg[2], o1[d0][4 * r4 + 3] * rs1 * sg[3]);
                *(u32x2*)(Ow + 32 * 2048 + d0 * 32 + r4 * 8) = w2;
            }
    }
    if (!has_next) BARV(0);
#undef TB
#undef DMA_KN
#undef DMA_VN
#undef QDMA
#undef DMA_K
#undef DMA_V
#undef BARV
#undef WAITL
#undef LDK
#undef EX
#undef PK4
#undef LSUM2
#undef KRD
#undef QKMF
#undef VRD4
#undef STEP5
#undef STEP6
#undef MF
#undef E2
#undef SUM4
#undef SMX_E
#undef SMX_P
#undef PVM2
#undef TRR
#undef VF
}

__device__ __forceinline__ void attnB9_unit(const bf16_t* Qb, const bf16_t* __restrict__ KBp, const bf16_t* __restrict__ VBp, bf16_t* Ob, int b, int h, int qb, char* lds, const float* lamp, const float* subg, const int wid, const bool do_store, const int nb, const int nh, const int nqb, const bool first, const bool has_next) {
    const int lane = lane_id(), r32 = lane & 31, hi = lane >> 5;
    const int mp = wid & 1, g = wid >> 1;
    constexpr int SLOT = 8192, VRING = 8 * SLOT;
    f32x16 o0[4] = {}, o1[4] = {};
    const size_t qrow = (size_t)b * SEQ + qb * 256 + g * 64;
    unsigned koff, voff;
    { const int p = wid * 64 + lane;
      { const int row = p >> 4, cpos = p & 15, chunk = cpos ^ (row & 15); koff = (unsigned)(row * 2048 + chunk * 16); }
      { const int st = p >> 5, kk7 = (p >> 2) & 7, ch = p & 3, kk = (st >> 2) * 8 + kk7, k = (kk & ~0xC) | ((kk & 4) << 1) | ((kk & 8) >> 1), c = (st & 3) * 32 + ch * 8; voff = (unsigned)(k * 2048 + c * 2); } }
    const char* Kg = (const char*)KBp; const char* Vg = (const char*)VBp;
    const unsigned lds0 = (unsigned)(uintptr_t)lds;
    const unsigned kdst = lds0 + wid * 1024, vdst = lds0 + VRING + wid * 1024;
#define TB(bb_, hh_, tile) (((tile) < 256 ? (size_t)(bb_) * SEQ + (size_t)(tile) * 32 : (size_t)T + (size_t)(bb_) * CTXL + (size_t)((tile) - 256) * 32) * 2048 + (size_t)(hh_) * 256)
#define DMA_K(tile) glds16s(Kg + TB(b, h, tile), koff, kdst + (unsigned)(((tile) & 7) * SLOT))
#define DMA_V(tile) glds16s(Vg + TB(b, h, tile), voff, vdst + (unsigned)(((tile) & 7) * SLOT))
#define DMA_KN(tile) glds16s(Kg + TB(nb, nh, tile), koff, kdst + (unsigned)(((tile) & 7) * SLOT))
#define DMA_VN(tile) glds16s(Vg + TB(nb, nh, tile), voff, vdst + (unsigned)(((tile) & 7) * SLOT))
#define QLD() do { const bf16_t* qs_ = Qb + (qrow + r32) * 2048 + 1024 + h * 128 + mp * 64 + hi * 8; \
    qa0 = *(const bf16x8*)(qs_); qa1 = *(const bf16x8*)(qs_ + 16); qa2 = *(const bf16x8*)(qs_ + 32); qa3 = *(const bf16x8*)(qs_ + 48); \
    qb0 = *(const bf16x8*)(qs_ + 32 * 2048); qb1 = *(const bf16x8*)(qs_ + 32 * 2048 + 16); qb2 = *(const bf16x8*)(qs_ + 32 * 2048 + 32); qb3 = *(const bf16x8*)(qs_ + 32 * 2048 + 48); } while (0)
#define BARV(N) asm volatile("s_waitcnt vmcnt(" #N ") lgkmcnt(0)\n\ts_barrier" ::: "memory")
#define WAITL(N) asm volatile("s_waitcnt lgkmcnt(" #N ")" ::: "memory")
#define LDK(dst, addr, OFF) asm volatile("ds_read_b128 %0, %1 offset:%2" : "=&v"(dst) : "v"(addr), "i"(OFF) : "memory")
    const int kbase = ((int)lds0 + r32 * 256 + ((hi ^ (r32 & 15)) << 4)) ^ (mp << 7);
    const int vbase = (int)(lds0 + VRING) + (((lane & 3) << 3) | (((lane >> 2) & 3) << 6) | (((lane >> 4) & 1) << 5) | ((lane >> 5) << 11));
    constexpr int NT = 264;
    float l0a = 0.f, l1a = 0.f;
#define EX(v) __builtin_amdgcn_exp2f(v)
#define PK4(P, BASE, OUT) do { u32x4 w_ = {cvt_pk_bf16(P[BASE + 0], P[BASE + 1]), cvt_pk_bf16(P[BASE + 2], P[BASE + 3]), cvt_pk_bf16(P[BASE + 4], P[BASE + 5]), cvt_pk_bf16(P[BASE + 6], P[BASE + 7])}; OUT = *reinterpret_cast<bf16x8*>(&w_); } while (0)
#define LSUM2(la, P, B) do { const float t0_ = (P[B] + P[B + 1]) + (P[B + 2] + P[B + 3]), t1_ = (P[B + 4] + P[B + 5]) + (P[B + 6] + P[B + 7]); la += t0_ + t1_; } while (0)
#define KRD(kb_) do { LDK(k0, (kb_) ^ (0 << 5), 0); LDK(k1, (kb_) ^ (1 << 5), 0); LDK(k2, (kb_) ^ (2 << 5), 0); LDK(k3, (kb_) ^ (3 << 5), 0); } while (0)
#define QKMF(S_, q0_, q1_, q2_, q3_) do { \
    S_ = __builtin_amdgcn_mfma_f32_32x32x16_bf16(k0, q0_, (f32x16){}, 0, 0, 0); S_ = __builtin_amdgcn_mfma_f32_32x32x16_bf16(k1, q1_, S_, 0, 0, 0); \
    S_ = __builtin_amdgcn_mfma_f32_32x32x16_bf16(k2, q2_, S_, 0, 0, 0); S_ = __builtin_amdgcn_mfma_f32_32x32x16_bf16(k3, q3_, S_, 0, 0, 0); } while (0)
#define SMX_E(S_) do { _Pragma("unroll") for (int r = 0; r < 16; ++r) S_[r] = EX(S_[r]); } while (0)
#define SMX_P(S_, PA, LA) do { PK4(S_, 0, PA[0]); PK4(S_, 8, PA[1]); LSUM2(LA, S_, 0); LSUM2(LA, S_, 8); } while (0)
#undef TRR
#define TRR(OFF_, vbx__) tr_read<OFF_>(vbx__)
#define VF(pre, a, b_) ((bf16x8){pre##a[0], pre##a[1], pre##a[2], pre##a[3], pre##b_[0], pre##b_[1], pre##b_[2], pre##b_[3]})
#define PVM2(pre, D0, PO0, PO1) do { \
    o0[D0] = __builtin_amdgcn_mfma_f32_32x32x16_bf16(VF(pre, 0, 1), PO0[0], o0[D0], 0, 0, 0); o1[D0] = __builtin_amdgcn_mfma_f32_32x32x16_bf16(VF(pre, 0, 1), PO1[0], o1[D0], 0, 0, 0); \
    o0[D0] = __builtin_amdgcn_mfma_f32_32x32x16_bf16(VF(pre, 2, 3), PO0[1], o0[D0], 0, 0, 0); o1[D0] = __builtin_amdgcn_mfma_f32_32x32x16_bf16(VF(pre, 2, 3), PO1[1], o1[D0], 0, 0, 0); } while (0)
#define VRD4(d0_, d1_, d2_, d3_, D0, vbx) do { d0_ = TRR(((0 * 4 + D0) * 512 + 0), vbx); d1_ = TRR(((0 * 4 + D0) * 512 + 256), vbx); d2_ = TRR(((2 * 4 + D0) * 512 + 0), vbx); d3_ = TRR(((2 * 4 + D0) * 512 + 256), vbx); } while (0)
    bf16x8 pa0[2], pa1[2];
    bf16x8 k0, k1, k2, k3;
    bf16x8 qa0, qa1, qa2, qa3, qb0, qb1, qb2, qb3;
#define STEP5(j, HASPV, HASNEXT) do { \
    const int knxt_ = kbase + (((j) + 1) & 7) * SLOT, vbx_ = vbase + (((j) - 1) & 7) * SLOT; \
    f32x16 S0_, S1_; s16x4 va0, va1, va2, va3; \
    SBAR(); \
    if (HASPV) { VRD4(va0, va1, va2, va3, 0, vbx_); } \
    QKMF(S0_, qa0, qa1, qa2, qa3); SBAR(); \
    if (HASPV) { \
        s16x4 vb0, vb1, vb2, vb3; VRD4(vb0, vb1, vb2, vb3, 1, vbx_); WAITL(4); SBAR(); \
        PVM2(va, 0, pa0, pa1); SBAR(); \
        QKMF(S1_, qb0, qb1, qb2, qb3); SBAR(); \
        { s16x4 vc0, vc1, vc2, vc3; VRD4(vc0, vc1, vc2, vc3, 2, vbx_); WAITL(4); SBAR(); PVM2(vb, 1, pa0, pa1); SMX_E(S0_); SBAR(); \
          { s16x4 vd0, vd1, vd2, vd3; VRD4(vd0, vd1, vd2, vd3, 3, vbx_); WAITL(4); SBAR(); PVM2(vc, 2, pa0, pa1); SMX_E(S1_); SBAR(); \
            if (HASNEXT) { KRD(knxt_); } \
            if (HASNEXT) WAITL(4); else WAITL(0); \
            SBAR(); \
            LSUM2(l0a, S0_, 0); LSUM2(l0a, S0_, 8); LSUM2(l1a, S1_, 0); LSUM2(l1a, S1_, 8); \
            o0[3] = __builtin_amdgcn_mfma_f32_32x32x16_bf16(VF(vd, 0, 1), pa0[0], o0[3], 0, 0, 0); o1[3] = __builtin_amdgcn_mfma_f32_32x32x16_bf16(VF(vd, 0, 1), pa1[0], o1[3], 0, 0, 0); SBAR(); \
            o0[3] = __builtin_amdgcn_mfma_f32_32x32x16_bf16(VF(vd, 2, 3), pa0[1], o0[3], 0, 0, 0); PK4(S0_, 0, pa0[0]); SBAR(); \
            o1[3] = __builtin_amdgcn_mfma_f32_32x32x16_bf16(VF(vd, 2, 3), pa1[1], o1[3], 0, 0, 0); PK4(S1_, 0, pa1[0]); SBAR(); \
            PK4(S0_, 8, pa0[1]); PK4(S1_, 8, pa1[1]); SBAR(); } } \
    } else { \
        QKMF(S1_, qb0, qb1, qb2, qb3); SBAR(); \
        if (HASNEXT) { KRD(knxt_); } \
        SMX_E(S0_); SMX_E(S1_); SMX_P(S0_, pa0, l0a); SMX_P(S1_, pa1, l1a); SBAR(); } \
    } while (0)
#define MF(acc_, a_, b_) acc_ = __builtin_amdgcn_mfma_f32_32x32x16_bf16(a_, b_, acc_, 0, 0, 0)
#define E2(S_, i_) do { S_[i_] = EX(S_[i_]); S_[(i_) + 1] = EX(S_[(i_) + 1]); } while (0)
#define SUM4(S_, i_) fadd_(fadd_(S_[i_], S_[(i_) + 1]), fadd_(S_[(i_) + 2], S_[(i_) + 3]))
#define STEP6(j) do { \
    const int knxt_ = kbase + (((j) + 1) & 7) * SLOT, vbx_ = vbase + (((j) - 1) & 7) * SLOT; \
    f32x16 S0_, S1_; s16x4 va0, va1, va2, va3, vb0, vb1, vb2, vb3, vc0, vc1, vc2, vc3, vd0, vd1, vd2, vd3; float b0_; \
    SBAR(); \
    S0_ = __builtin_amdgcn_mfma_f32_32x32x16_bf16(k0, qa0, (f32x16){}, 0, 0, 0); va0 = TRR(((0 * 4 + 0) * 512 + 0), vbx_); va1 = TRR(((0 * 4 + 0) * 512 + 256), vbx_); SBAR(); \
    MF(S0_, k1, qa1); va2 = TRR(((2 * 4 + 0) * 512 + 0), vbx_); va3 = TRR(((2 * 4 + 0) * 512 + 256), vbx_); SBAR(); \
    MF(S0_, k2, qa2); if ((j) + 7 < NT) DMA_K((j) + 7); SBAR(); \
    MF(S0_, k3, qa3); if ((j) + 5 < NT) DMA_V((j) + 5); SBAR(); \
    WAITL(0); SBAR(); \
    MF(o0[0], VF(va, 0, 1), pa0[0]); vb0 = TRR(((0 * 4 + 1) * 512 + 0), vbx_); vb1 = TRR(((0 * 4 + 1) * 512 + 256), vbx_); SBAR(); \
    MF(o1[0], VF(va, 0, 1), pa1[0]); vb2 = TRR(((2 * 4 + 1) * 512 + 0), vbx_); vb3 = TRR(((2 * 4 + 1) * 512 + 256), vbx_); SBAR(); \
    MF(o0[0], VF(va, 2, 3), pa0[1]); E2(S0_, 0); SBAR(); \
    MF(o1[0], VF(va, 2, 3), pa1[1]); E2(S0_, 2); SBAR(); \
    S1_ = __builtin_amdgcn_mfma_f32_32x32x16_bf16(k0, qb0, (f32x16){}, 0, 0, 0); E2(S0_, 4); SBAR(); \
    MF(S1_, k1, qb1); E2(S0_, 6); SBAR(); \
    MF(S1_, k2, qb2); E2(S0_, 8); vc0 = TRR(((0 * 4 + 2) * 512 + 0), vbx_); SBAR(); \
    MF(S1_, k3, qb3); E2(S0_, 10); vc1 = TRR(((0 * 4 + 2) * 512 + 256), vbx_); SBAR(); \
    WAITL(2); SBAR(); \
    MF(o0[1], VF(vb, 0, 1), pa0[0]); E2(S0_, 12); vc2 = TRR(((2 * 4 + 2) * 512 + 0), vbx_); SBAR(); \
    MF(o1[1], VF(vb, 0, 1), pa1[0]); E2(S0_, 14); vc3 = TRR(((2 * 4 + 2) * 512 + 256), vbx_); SBAR(); \
    MF(o0[1], VF(vb, 2, 3), pa0[1]); l0a += SUM4(S0_, 0); vd0 = TRR(((0 * 4 + 3) * 512 + 0), vbx_); LDK(k0, knxt_ ^ (0 << 5), 0); LDK(k1, knxt_ ^ (1 << 5), 0); SBAR(); \
    MF(o1[1], VF(vb, 2, 3), pa1[1]); l0a += SUM4(S0_, 4); vd1 = TRR(((0 * 4 + 3) * 512 + 256), vbx_); LDK(k2, knxt_ ^ (2 << 5), 0); LDK(k3, knxt_ ^ (3 << 5), 0); SBAR(); \
    WAITL(6); SBAR(); \
    MF(o0[2], VF(vc, 0, 1), pa0[0]); E2(S1_, 0); vd2 = TRR(((2 * 4 + 3) * 512 + 0), vbx_); SBAR(); \
    MF(o1[2], VF(vc, 0, 1), pa1[0]); E2(S1_, 2); vd3 = TRR(((2 * 4 + 3) * 512 + 256), vbx_); SBAR(); \
    MF(o0[2], VF(vc, 2, 3), pa0[1]); E2(S1_, 4); l0a += SUM4(S0_, 8); SBAR(); \
    MF(o1[2], VF(vc, 2, 3), pa1[1]); E2(S1_, 6); l0a += SUM4(S0_, 12); SBAR(); \
    WAITL(2); SBAR(); \
    MF(o0[3], VF(vd, 0, 1), pa0[0]); E2(S1_, 8); SBAR(); \
    MF(o1[3], VF(vd, 0, 1), pa1[0]); E2(S1_, 10); PK4(S0_, 0, pa0[0]); SBAR(); \
    WAITL(0); SBAR(); \
    MF(o0[3], VF(vd, 2, 3), pa0[1]); E2(S1_, 12); b0_ = SUM4(S1_, 0); SBAR(); \
    MF(o1[3], VF(vd, 2, 3), pa1[1]); E2(S1_, 14); PK4(S0_, 8, pa0[1]); b0_ = fadd_(b0_, SUM4(S1_, 4)); SBAR(); \
    PK4(S1_, 0, pa1[0]); PK4(S1_, 8, pa1[1]); l1a += fadd_(b0_, fadd_(SUM4(S1_, 8), SUM4(S1_, 12))); SBAR(); } while (0)
    QLD();
    if (first) { DMA_K(0); DMA_V(0); DMA_K(1); DMA_K(2); DMA_K(3); DMA_V(1); DMA_K(4); DMA_V(2); DMA_K(5); DMA_V(3); DMA_K(6); DMA_V(4); }
    BARV(0);
    KRD(kbase); WAITL(0);
    DMA_K(7); DMA_V(5);
    STEP5(0, 0, 1);
    WAITL(0);
#pragma unroll 1
    for (int j = 1; j + 1 < NT; ++j) {
        STEP6(j);
        if (j & 1) { if (j + 7 < NT) BARV(8); else BARV(0); }
        else WAITL(0);
    }
    STEP5(NT - 1, 1, 0);
    BARV(0);
    if (has_next) { DMA_KN(0); DMA_VN(0); DMA_KN(1); DMA_KN(2); DMA_KN(3); DMA_VN(1); DMA_KN(4); DMA_VN(2); DMA_KN(5); DMA_VN(3); DMA_KN(6); DMA_VN(4); }
    { const int vbx_ = vbase + ((NT - 1) & 7) * SLOT;
      s16x4 va0, va1, va2, va3, vb0, vb1, vb2, vb3, vc0, vc1, vc2, vc3, vd0, vd1, vd2, vd3;
      VRD4(va0, va1, va2, va3, 0, vbx_); VRD4(vb0, vb1, vb2, vb3, 1, vbx_); WAITL(4); SBAR(); PVM2(va, 0, pa0, pa1); SBAR();
      VRD4(vc0, vc1, vc2, vc3, 2, vbx_); WAITL(4); SBAR(); PVM2(vb, 1, pa0, pa1); SBAR();
      VRD4(vd0, vd1, vd2, vd3, 3, vbx_); WAITL(4); SBAR(); PVM2(vc, 2, pa0, pa1); SBAR(); WAITL(0); SBAR(); PVM2(vd, 3, pa0, pa1); SBAR(); }
    float l0 = l0a, l1 = l1a;
    { auto rr = __builtin_amdgcn_permlane32_swap(__float_as_uint(l0), __float_as_uint(l0), false, false); l0 = __uint_as_float(rr[0]) + __uint_as_float(rr[1]); }
    { auto rr = __builtin_amdgcn_permlane32_swap(__float_as_uint(l1), __float_as_uint(l1), false, false); l1 = __uint_as_float(rr[0]) + __uint_as_float(rr[1]); }
    {
        const float lamv = *(const volatile float*)lamp;
        const float fsel = mp ? lamv : 1.0f;
        const float sc0 = fsel * __builtin_amdgcn_rcpf(l0), sc1 = fsel * __builtin_amdgcn_rcpf(l1);
        LAS float* xb = (LAS float*)((LAS char*)lds + 139264) + g * 1024 + lane_id();
#define XCH(OA, SC) do { \
        if (mp) { _Pragma("unroll") for (int r = 0; r < 16; ++r) xb[r * 64] = OA[r] * SC; } \
        asm volatile("s_waitcnt lgkmcnt(0)\n\ts_barrier" ::: "memory"); \
        if (!mp) { _Pragma("unroll") for (int r = 0; r < 16; ++r) OA[r] = OA[r] * SC - xb[r * 64]; } \
        asm volatile("s_waitcnt lgkmcnt(0)\n\ts_barrier" ::: "memory"); } while (0)
#pragma unroll
        for (int d0 = 0; d0 < 4; ++d0) { XCH(o0[d0], sc0); XCH(o1[d0], sc1); }
#undef XCH
    }
    if (do_store && mp == 0) {
        float s0 = 0.f, s1 = 0.f;
#pragma unroll
        for (int d0 = 0; d0 < 4; ++d0)
#pragma unroll
            for (int r = 0; r < 16; ++r) { s0 += o0[d0][r] * o0[d0][r]; s1 += o1[d0][r] * o1[d0][r]; }
        { auto rr = __builtin_amdgcn_permlane32_swap(__float_as_uint(s0), __float_as_uint(s0), false, false); s0 = __uint_as_float(rr[0]) + __uint_as_float(rr[1]); }
        { auto rr = __builtin_amdgcn_permlane32_swap(__float_as_uint(s1), __float_as_uint(s1), false, false); s1 = __uint_as_float(rr[0]) + __uint_as_float(rr[1]); }
        const float rs0 = rsqrtf(s0 * (1.0f / 128.0f) + EPSN) * 0.8f, rs1 = rsqrtf(s1 * (1.0f / 128.0f) + EPSN) * 0.8f;
        const int le_ = lane_id(), r32e = le_ & 31, hie = le_ >> 5;
        bf16_t* Ow = Ob + (qrow + r32e) * 2048 + 1024 + h * 128 + 4 * hie;
#pragma unroll
        for (int d0 = 0; d0 < 4; ++d0)
#pragma unroll
            for (int r4 = 0; r4 < 4; ++r4) {
                const f32x4 sg = *(const f32x4*)(subg + d0 * 32 + r4 * 8 + 4 * hie);
                u32x2 w; w.x = cvt_pk_bf16(o0[d0][4 * r4] * rs0 * sg[0], o0[d0][4 * r4 + 1] * rs0 * sg[1]); w.y = cvt_pk_bf16(o0[d0][4 * r4 + 2] * rs0 * sg[2], o0[d0][4 * r4 + 3] * rs0 * sg[3]);
                *(u32x2*)(Ow + d0 * 32 + r4 * 8) = w;
                u32x2 w2; w2.x = cvt_pk_bf16(o1[d0][4 * r4] * rs1 * sg[0], o1[d0][4 * r4 + 1] * rs1 * sg[1]); w2.y = cvt_pk_bf16(o1[d0][4 * r4 + 2] * rs1 * sg[2], o1[d0][4 * r4 + 3] * rs1 * sg[3]);
                *(u32x2*)(Ow + 32 * 2048 + d0 * 32 + r4 * 8) = w2;
            }
    }
    if (!has_next) BARV(0);
#undef TB
#undef DMA_KN
#undef DMA_VN
#undef QLD
#undef DMA_K
#undef DMA_V
#undef BARV
#undef WAITL
#undef LDK
#undef EX
#undef PK4
#undef LSUM2
#undef KRD
#undef QKMF
#undef VRD4
#undef STEP5
#undef STEP6
#undef MF
#undef E2
#undef SUM4
#undef SMX_E
#undef SMX_P
#undef PVM2
#undef TRR
#undef VF
}

__device__ __forceinline__ void attnA4_unit(const bf16_t* Qb, const bf16_t* __restrict__ KVAp, bf16_t* Ob, int b, int kvh, int qb, char* lds, const float* sink, const int wid, const bool do_store) {
    const int lane = lane_id(), r32 = lane & 31, hi = lane >> 5;
    constexpr int SLOT = 8192, VRING = 3 * SLOT;
    float* li_l = (float*)(lds + B2_WS) + wid * 64;
    const int head = kvh * 8 + wid, t0 = qb * 64;
    const size_t qrow = (size_t)b * SEQ + t0;
    f32x16 o[2][2] = {}; bf16x8 q[2][4];
#pragma unroll
    for (int rb = 0; rb < 2; ++rb)
#pragma unroll
        for (int d0 = 0; d0 < 4; ++d0) q[rb][d0] = *reinterpret_cast<const bf16x8*>(Qb + (qrow + rb * 32 + r32) * 2048 + head * 64 + hi * 8 + d0 * 16);
    const int p = wid * 64 + lane;
    const int krow = p >> 3, kchunk = (p & 7) ^ ((krow >> 1) & 7);
    const int vst_ = p >> 5, vkk = (vst_ >> 1) * 8 + ((p >> 2) & 7), vk = (vkk & ~0xC) | ((vkk & 4) << 1) | ((vkk & 8) >> 1), vc = (vst_ & 1) * 32 + (p & 3) * 8;
    const char* KVg = (const char*)KVAp + kvh * 128;
    const unsigned lds0 = (unsigned)(uintptr_t)lds;
    const unsigned kdst = lds0 + wid * 1024, vdst = lds0 + VRING + wid * 1024;
#define ROWA(v) ((v) < 256 ? (size_t)T + (size_t)b * CTXL + (v) : (size_t)b * SEQ + (size_t)min(max(t0 - 384 + (v), 0), SEQ - 1))
#define DMA_A(tile, slotoff) do { const unsigned so_ = (unsigned)__builtin_amdgcn_readfirstlane(slotoff); \
    glds16(KVg + ROWA((tile) * 64 + krow) * 512 + kchunk * 16, kdst + so_); glds16(KVg + ROWA((tile) * 64 + vk) * 512 + 256 + vc * 2, vdst + so_); } while (0)
#define BARV(N) asm volatile("s_waitcnt vmcnt(" #N ") lgkmcnt(0)\n\ts_barrier" ::: "memory")
#define WAITL(N) asm volatile("s_waitcnt lgkmcnt(" #N ")" ::: "memory")
#define LDK(dst, addr, OFF) asm volatile("ds_read_b128 %0, %1 offset:%2" : "=&v"(dst) : "v"(addr), "i"(OFF) : "memory")
    const int kbase = (int)lds0 + r32 * 128 + ((hi ^ ((r32 >> 1) & 7)) << 4);
    const int vbase = (int)(lds0 + VRING) + v_rd_base(lane);
    constexpr int NT = 9;
    float lsum[2] = {0.f, 0.f};
#define PK4(P, BASE, OUT) do { unsigned a0 = cvt_pk_bf16(P[BASE + 0], P[BASE + 1]), a1 = cvt_pk_bf16(P[BASE + 2], P[BASE + 3]);   \
    unsigned b0_ = cvt_pk_bf16(P[BASE + 4], P[BASE + 5]), b1_ = cvt_pk_bf16(P[BASE + 6], P[BASE + 7]);                              \
    auto r0 = __builtin_amdgcn_permlane32_swap(a0, b0_, false, false); auto r1 = __builtin_amdgcn_permlane32_swap(a1, b1_, false, false); \
    u32x4 w = {r0[0], r1[0], r0[1], r1[1]}; OUT = *reinterpret_cast<bf16x8*>(&w); } while (0)
#define VRDA(pre, D0, vbx) const s16x4 pre##0 = tr_read<((0 * 2 + D0) * 512)>(vbx), pre##1 = tr_read<((1 * 2 + D0) * 512)>(vbx), pre##2 = tr_read<((2 * 2 + D0) * 512)>(vbx), pre##3 = tr_read<((3 * 2 + D0) * 512)>(vbx), \
    pre##4 = tr_read<((4 * 2 + D0) * 512)>(vbx), pre##5 = tr_read<((5 * 2 + D0) * 512)>(vbx), pre##6 = tr_read<((6 * 2 + D0) * 512)>(vbx), pre##7 = tr_read<((7 * 2 + D0) * 512)>(vbx)
#define VF(pre, a, b_) ((bf16x8){pre##a[0], pre##a[1], pre##a[2], pre##a[3], pre##b_[0], pre##b_[1], pre##b_[2], pre##b_[3]})
    int sl_c = 0, sl_1 = SLOT, sl_2 = 2 * SLOT;
    DMA_A(0, sl_c); DMA_A(1, sl_1);
    BARV(2);
#pragma unroll 1
    for (int j = 0; j < NT; ++j) {
        if (j + 2 < NT) DMA_A(j + 2, sl_2);
        const int ka_ = kbase + sl_c, vbx_ = vbase + sl_c;
        bf16x8 pa[2][4];
#pragma unroll
        for (int rb = 0; rb < 2; ++rb) {
            f32x16 Sa, Sb; bf16x8 ka0, kb0, ka1, kb1;
            LDK(ka0, ka_ ^ (0 << 5), 0); LDK(kb0, ka_ ^ (0 << 5), 4096); LDK(ka1, ka_ ^ (1 << 5), 0); LDK(kb1, ka_ ^ (1 << 5), 4096);
            WAITL(2); SBAR();
            Sa = __builtin_amdgcn_mfma_f32_32x32x16_bf16(ka0, q[rb][0], (f32x16){}, 0, 0, 0); Sb = __builtin_amdgcn_mfma_f32_32x32x16_bf16(kb0, q[rb][0], (f32x16){}, 0, 0, 0); SBAR();
            LDK(ka0, ka_ ^ (2 << 5), 0); LDK(kb0, ka_ ^ (2 << 5), 4096);
            WAITL(2); SBAR();
            Sa = __builtin_amdgcn_mfma_f32_32x32x16_bf16(ka1, q[rb][1], Sa, 0, 0, 0); Sb = __builtin_amdgcn_mfma_f32_32x32x16_bf16(kb1, q[rb][1], Sb, 0, 0, 0); SBAR();
            LDK(ka1, ka_ ^ (3 << 5), 0); LDK(kb1, ka_ ^ (3 << 5), 4096);
            WAITL(2); SBAR();
            Sa = __builtin_amdgcn_mfma_f32_32x32x16_bf16(ka0, q[rb][2], Sa, 0, 0, 0); Sb = __builtin_amdgcn_mfma_f32_32x32x16_bf16(kb0, q[rb][2], Sb, 0, 0, 0); SBAR();
            WAITL(0); SBAR();
            Sa = __builtin_amdgcn_mfma_f32_32x32x16_bf16(ka1, q[rb][3], Sa, 0, 0, 0); Sb = __builtin_amdgcn_mfma_f32_32x32x16_bf16(kb1, q[rb][3], Sb, 0, 0, 0); SBAR();
            if (j >= 4) {
#pragma unroll
                for (int r = 0; r < 16; ++r) {
                    const int v0 = 64 * j + crow(r, hi), v1 = v0 + 32;
                    { const int k = t0 - 384 + v0, d = t0 + rb * 32 + r32 - k; if (!((k >= 0) && (k < SEQ) && (d <= 128) && (d >= -128))) Sa[r] = -INFINITY; }
                    { const int k = t0 - 384 + v1, d = t0 + rb * 32 + r32 - k; if (!((k >= 0) && (k < SEQ) && (d <= 128) && (d >= -128))) Sb[r] = -INFINITY; }
                }
            }
            float ls_ = 0.f;
#pragma unroll
            for (int r = 0; r < 16; ++r) { Sa[r] = __builtin_amdgcn_exp2f(Sa[r]); Sb[r] = __builtin_amdgcn_exp2f(Sb[r]); }
#pragma unroll
            for (int r = 0; r < 16; r += 4) ls_ += ((Sa[r] + Sa[r + 1]) + (Sa[r + 2] + Sa[r + 3])) + ((Sb[r] + Sb[r + 1]) + (Sb[r + 2] + Sb[r + 3]));
            lsum[rb] += ls_;
            PK4(Sa, 0, pa[rb][0]); PK4(Sa, 8, pa[rb][1]); PK4(Sb, 0, pa[rb][2]); PK4(Sb, 8, pa[rb][3]); SBAR();
        }
        { VRDA(va, 0, vbx_); WAITL(0); SBAR();
          o[0][0] = __builtin_amdgcn_mfma_f32_32x32x16_bf16(pa[0][0], VF(va, 0, 1), o[0][0], 0, 0, 0); o[1][0] = __builtin_amdgcn_mfma_f32_32x32x16_bf16(pa[1][0], VF(va, 0, 1), o[1][0], 0, 0, 0);
          o[0][0] = __builtin_amdgcn_mfma_f32_32x32x16_bf16(pa[0][1], VF(va, 2, 3), o[0][0], 0, 0, 0); o[1][0] = __builtin_amdgcn_mfma_f32_32x32x16_bf16(pa[1][1], VF(va, 2, 3), o[1][0], 0, 0, 0);
          o[0][0] = __builtin_amdgcn_mfma_f32_32x32x16_bf16(pa[0][2], VF(va, 4, 5), o[0][0], 0, 0, 0); o[1][0] = __builtin_amdgcn_mfma_f32_32x32x16_bf16(pa[1][2], VF(va, 4, 5), o[1][0], 0, 0, 0);
          o[0][0] = __builtin_amdgcn_mfma_f32_32x32x16_bf16(pa[0][3], VF(va, 6, 7), o[0][0], 0, 0, 0); o[1][0] = __builtin_amdgcn_mfma_f32_32x32x16_bf16(pa[1][3], VF(va, 6, 7), o[1][0], 0, 0, 0); SBAR(); }
        { VRDA(vb, 1, vbx_); WAITL(0); SBAR();
          o[0][1] = __builtin_amdgcn_mfma_f32_32x32x16_bf16(pa[0][0], VF(vb, 0, 1), o[0][1], 0, 0, 0); o[1][1] = __builtin_amdgcn_mfma_f32_32x32x16_bf16(pa[1][0], VF(vb, 0, 1), o[1][1], 0, 0, 0);
          o[0][1] = __builtin_amdgcn_mfma_f32_32x32x16_bf16(pa[0][1], VF(vb, 2, 3), o[0][1], 0, 0, 0); o[1][1] = __builtin_amdgcn_mfma_f32_32x32x16_bf16(pa[1][1], VF(vb, 2, 3), o[1][1], 0, 0, 0);
          o[0][1] = __builtin_amdgcn_mfma_f32_32x32x16_bf16(pa[0][2], VF(vb, 4, 5), o[0][1], 0, 0, 0); o[1][1] = __builtin_amdgcn_mfma_f32_32x32x16_bf16(pa[1][2], VF(vb, 4, 5), o[1][1], 0, 0, 0);
          o[0][1] = __builtin_amdgcn_mfma_f32_32x32x16_bf16(pa[0][3], VF(vb, 6, 7), o[0][1], 0, 0, 0); o[1][1] = __builtin_amdgcn_mfma_f32_32x32x16_bf16(pa[1][3], VF(vb, 6, 7), o[1][1], 0, 0, 0); SBAR(); }
        if (j + 2 < NT) BARV(2); else BARV(0);
        { const int t_ = sl_c; sl_c = sl_1; sl_1 = sl_2; sl_2 = t_; }
    }
    const float sk = __builtin_amdgcn_exp2f(sink[head] * 1.4426950408889634f);
#pragma unroll
    for (int rb = 0; rb < 2; ++rb) { float l_ = lsum[rb];
        { auto rr = __builtin_amdgcn_permlane32_swap(__float_as_uint(l_), __float_as_uint(l_), false, false); l_ = __uint_as_float(rr[0]) + __uint_as_float(rr[1]); }
        if (hi == 0) li_l[rb * 32 + r32] = __builtin_amdgcn_rcpf(l_ + sk); }
    asm volatile("s_waitcnt lgkmcnt(0)" ::: "memory");
    if (do_store) {
#pragma unroll
        for (int rb = 0; rb < 2; ++rb) { bf16_t* Ow = Ob + (qrow + rb * 32) * 2048 + head * 64;
#pragma unroll
            for (int r = 0; r < 16; ++r) { const float rl = li_l[rb * 32 + crow(r, hi)];
#pragma unroll
                for (int d0 = 0; d0 < 2; ++d0) { const unsigned w = cvt_pk_bf16(o[rb][d0][r] * rl, 0.f); Ow[(size_t)crow(r, hi) * 2048 + d0 * 32 + r32] = (bf16_t)(w & 0xffffu); } } }
    }
    BARV(0);
#undef ROWA
#undef DMA_A
#undef BARV
#undef WAITL
#undef LDK
#undef PK4
#undef VRDA
#undef VF
}
__device__ __forceinline__ void attnA5_unit(const bf16_t* Qb, const bf16_t* __restrict__ KVAp, bf16_t* Ob, int b, int kvh, int qb, char* lds, const float* sink, const int wid, const bool do_store, bf16x8 (&q)[2][4], const bool first, const bool has_next, const int nb, const int nkvh, const int nqb) {
    const int lane = lane_id(), r32 = lane & 31, hi = lane >> 5;
    constexpr int SLOT = 8192, VRING = 3 * SLOT;
    float* li_l = (float*)(lds + B2_WS) + wid * 64;
    const int head = kvh * 8 + wid, t0 = qb * 64;
    const size_t qrow = (size_t)b * SEQ + t0;
    f32x16 o[2][2] = {};
    if (first) {
#pragma unroll
        for (int rb = 0; rb < 2; ++rb)
#pragma unroll
            for (int d0 = 0; d0 < 4; ++d0) q[rb][d0] = *reinterpret_cast<const bf16x8*>(Qb + (qrow + rb * 32 + r32) * 2048 + head * 64 + hi * 8 + d0 * 16);
    }
    const int p = wid * 64 + lane;
    const int krow = p >> 3, kchunk = (p & 7) ^ ((krow >> 1) & 7);
    const int vst_ = p >> 5, vkk = (vst_ >> 1) * 8 + ((p >> 2) & 7), vk = (vkk & ~0xC) | ((vkk & 4) << 1) | ((vkk & 8) >> 1), vc = (vst_ & 1) * 32 + (p & 3) * 8;
    const char* KVg = (const char*)KVAp + kvh * 128;
    const unsigned lds0 = (unsigned)(uintptr_t)lds;
    const unsigned kdst = lds0 + wid * 1024, vdst = lds0 + VRING + wid * 1024;
#define ROWA(v) ((v) < 256 ? (size_t)T + (size_t)b * CTXL + (v) : (size_t)b * SEQ + (size_t)min(max(t0 - 384 + (v), 0), SEQ - 1))
#define DMA_A(tile, slotoff) do { const unsigned so_ = (unsigned)__builtin_amdgcn_readfirstlane(slotoff); \
    glds16(KVg + ROWA((tile) * 64 + krow) * 512 + kchunk * 16, kdst + so_); glds16(KVg + ROWA((tile) * 64 + vk) * 512 + 256 + vc * 2, vdst + so_); } while (0)
#define BARV(N) asm volatile("s_waitcnt vmcnt(" #N ") lgkmcnt(0)\n\ts_barrier" ::: "memory")
#define WAITL(N) asm volatile("s_waitcnt lgkmcnt(" #N ")" ::: "memory")
#define LDK(dst, addr, OFF) asm volatile("ds_read_b128 %0, %1 offset:%2" : "=&v"(dst) : "v"(addr), "i"(OFF) : "memory")
    const int kbase = (int)lds0 + r32 * 128 + ((hi ^ ((r32 >> 1) & 7)) << 4);
    const int vbase = (int)(lds0 + VRING) + (((lane & 3) << 3) | (((lane >> 2) & 3) << 6) | (((lane >> 4) & 1) << 5) | ((lane >> 5) << 10));
    constexpr int NT = 9;
    float lsum[2] = {0.f, 0.f};
#define PK4(P, BASE, OUT) do { u32x4 w_ = {cvt_pk_bf16(P[BASE + 0], P[BASE + 1]), cvt_pk_bf16(P[BASE + 2], P[BASE + 3]), cvt_pk_bf16(P[BASE + 4], P[BASE + 5]), cvt_pk_bf16(P[BASE + 6], P[BASE + 7])}; OUT = *reinterpret_cast<bf16x8*>(&w_); } while (0)
#define VRDA(pre, D0, vbx) const s16x4 pre##0 = tr_read<(((0) * 2 + D0) * 512 + 0)>(vbx), pre##1 = tr_read<(((0) * 2 + D0) * 512 + 256)>(vbx), pre##2 = tr_read<(((2) * 2 + D0) * 512 + 0)>(vbx), pre##3 = tr_read<(((2) * 2 + D0) * 512 + 256)>(vbx), \
    pre##4 = tr_read<(((4) * 2 + D0) * 512 + 0)>(vbx), pre##5 = tr_read<(((4) * 2 + D0) * 512 + 256)>(vbx), pre##6 = tr_read<(((6) * 2 + D0) * 512 + 0)>(vbx), pre##7 = tr_read<(((6) * 2 + D0) * 512 + 256)>(vbx)
#define VF(pre, a, b_) ((bf16x8){pre##a[0], pre##a[1], pre##a[2], pre##a[3], pre##b_[0], pre##b_[1], pre##b_[2], pre##b_[3]})
    int sl_c = 0, sl_1 = SLOT, sl_2 = 2 * SLOT;
    if (first) { DMA_A(0, sl_c); DMA_A(1, sl_1); BARV(2); }
    else if (do_store) BARV(18);
    else BARV(2);
#pragma unroll 1
    for (int j = 0; j < NT; ++j) {
        if (j + 2 < NT) DMA_A(j + 2, sl_2);
        const int ka_ = kbase + sl_c, vbx_ = vbase + sl_c;
        bf16x8 pa[2][4];
        const bool domask = j >= 4 && (j == 4 || j == 8 || qb == 0 || qb >= 126);
#define MASKA(Sa_, Sb_, RB) do { if (domask) { _Pragma("unroll") for (int r = 0; r < 16; ++r) { const int v0 = 64 * j + crow(r, hi), v1 = v0 + 32; \
            { const int k = t0 - 384 + v0, d = t0 + (RB) * 32 + r32 - k; if (!((k >= 0) && (k < SEQ) && (d <= 128) && (d >= -128))) Sa_[r] = -INFINITY; } \
            { const int k = t0 - 384 + v1, d = t0 + (RB) * 32 + r32 - k; if (!((k >= 0) && (k < SEQ) && (d <= 128) && (d >= -128))) Sb_[r] = -INFINITY; } } } } while (0)
#define EX4(S_, i_) do { S_[i_] = __builtin_amdgcn_exp2f(S_[i_]); S_[(i_) + 1] = __builtin_amdgcn_exp2f(S_[(i_) + 1]); S_[(i_) + 2] = __builtin_amdgcn_exp2f(S_[(i_) + 2]); S_[(i_) + 3] = __builtin_amdgcn_exp2f(S_[(i_) + 3]); } while (0)
#define SUMQ(S_, i_) ((S_[i_] + S_[(i_) + 1]) + (S_[(i_) + 2] + S_[(i_) + 3]))
#define MFA(acc_, a_, b_) acc_ = __builtin_amdgcn_mfma_f32_32x32x16_bf16(a_, b_, acc_, 0, 0, 0)
        f32x16 S0a, S0b, S1a, S1b;
        bf16x8 ka[4], kb[4];
#pragma unroll
        for (int d0 = 0; d0 < 4; ++d0) { LDK(ka[d0], ka_ ^ (d0 << 5), 0); LDK(kb[d0], ka_ ^ (d0 << 5), 4096); }
        WAITL(6); SBAR();
        S0a = __builtin_amdgcn_mfma_f32_32x32x16_bf16(ka[0], q[0][0], (f32x16){}, 0, 0, 0); S0b = __builtin_amdgcn_mfma_f32_32x32x16_bf16(kb[0], q[0][0], (f32x16){}, 0, 0, 0); SBAR();
        WAITL(4); SBAR();
        MFA(S0a, ka[1], q[0][1]); MFA(S0b, kb[1], q[0][1]); SBAR();
        WAITL(2); SBAR();
        MFA(S0a, ka[2], q[0][2]); MFA(S0b, kb[2], q[0][2]); SBAR();
        WAITL(0); SBAR();
        MFA(S0a, ka[3], q[0][3]); MFA(S0b, kb[3], q[0][3]); SBAR();
        VRDA(va, 0, vbx_);
        S1a = __builtin_amdgcn_mfma_f32_32x32x16_bf16(ka[0], q[1][0], (f32x16){}, 0, 0, 0); MASKA(S0a, S0b, 0); SBAR();
        S1b = __builtin_amdgcn_mfma_f32_32x32x16_bf16(kb[0], q[1][0], (f32x16){}, 0, 0, 0); EX4(S0a, 0); SBAR();
        MFA(S1a, ka[1], q[1][1]); EX4(S0a, 4); SBAR();
        MFA(S1b, kb[1], q[1][1]); EX4(S0a, 8); SBAR();
        MFA(S1a, ka[2], q[1][2]); EX4(S0a, 12); SBAR();
        MFA(S1b, kb[2], q[1][2]); EX4(S0b, 0); SBAR();
        MFA(S1a, ka[3], q[1][3]); EX4(S0b, 4); SBAR();
        MFA(S1b, kb[3], q[1][3]); EX4(S0b, 8); SBAR();
        EX4(S0b, 12);
        lsum[0] += ((SUMQ(S0a, 0) + SUMQ(S0a, 4)) + (SUMQ(S0a, 8) + SUMQ(S0a, 12))) + ((SUMQ(S0b, 0) + SUMQ(S0b, 4)) + (SUMQ(S0b, 8) + SUMQ(S0b, 12)));
        PK4(S0a, 0, pa[0][0]); PK4(S0a, 8, pa[0][1]); PK4(S0b, 0, pa[0][2]); PK4(S0b, 8, pa[0][3]); SBAR();
        { VRDA(vb, 1, vbx_); WAITL(8); SBAR();
          MFA(o[0][0], VF(va, 0, 1), pa[0][0]); MASKA(S1a, S1b, 1); SBAR();
          MFA(o[0][0], VF(va, 2, 3), pa[0][1]); EX4(S1a, 0); SBAR();
          MFA(o[0][0], VF(va, 4, 5), pa[0][2]); EX4(S1a, 4); SBAR();
          MFA(o[0][0], VF(va, 6, 7), pa[0][3]); EX4(S1a, 8); SBAR();
          WAITL(0); SBAR();
          MFA(o[0][1], VF(vb, 0, 1), pa[0][0]); EX4(S1a, 12); SBAR();
          MFA(o[0][1], VF(vb, 2, 3), pa[0][1]); EX4(S1b, 0); SBAR();
          MFA(o[0][1], VF(vb, 4, 5), pa[0][2]); EX4(S1b, 4); SBAR();
          MFA(o[0][1], VF(vb, 6, 7), pa[0][3]); EX4(S1b, 8); SBAR();
          EX4(S1b, 12);
          PK4(S1a, 0, pa[1][0]); PK4(S1a, 8, pa[1][1]); PK4(S1b, 0, pa[1][2]); PK4(S1b, 8, pa[1][3]); SBAR();
          MFA(o[1][0], VF(va, 0, 1), pa[1][0]); const float t0s_ = SUMQ(S1a, 0) + SUMQ(S1a, 4); SBAR();
          MFA(o[1][1], VF(vb, 0, 1), pa[1][0]); const float t1s_ = SUMQ(S1a, 8) + SUMQ(S1a, 12); SBAR();
          MFA(o[1][0], VF(va, 2, 3), pa[1][1]); const float t2s_ = SUMQ(S1b, 0) + SUMQ(S1b, 4); SBAR();
          MFA(o[1][1], VF(vb, 2, 3), pa[1][1]); const float t3s_ = SUMQ(S1b, 8) + SUMQ(S1b, 12); SBAR();
          MFA(o[1][0], VF(va, 4, 5), pa[1][2]); lsum[1] += (t0s_ + t1s_) + (t2s_ + t3s_); SBAR();
          MFA(o[1][1], VF(vb, 4, 5), pa[1][2]); SBAR();
          MFA(o[1][0], VF(va, 6, 7), pa[1][3]); MFA(o[1][1], VF(vb, 6, 7), pa[1][3]); SBAR(); }
#undef MASKA
#undef EX4
#undef SUMQ
#undef MFA
        if (j + 2 < NT) BARV(2); else BARV(0);
        { const int t_ = sl_c; sl_c = sl_1; sl_1 = sl_2; sl_2 = t_; }
    }
    const float sk = __builtin_amdgcn_exp2f(sink[head] * 1.4426950408889634f);
    (void)li_l;
    if (has_next) {
        const int ln_ = lane_id(), r32n = ln_ & 31, hin = ln_ >> 5, nt0 = nqb * 64;
        const size_t nqrow = (size_t)nb * SEQ + nt0;
#pragma unroll
        for (int rb = 0; rb < 2; ++rb)
#pragma unroll
            for (int d0 = 0; d0 < 4; ++d0) q[rb][d0] = *reinterpret_cast<const bf16x8*>(Qb + (nqrow + rb * 32 + r32n) * 2048 + (nkvh * 8 + wid) * 64 + hin * 8 + d0 * 16);
        const char* KVn = (const char*)KVAp + nkvh * 128;
#define ROWAN(v) ((v) < 256 ? (size_t)T + (size_t)nb * CTXL + (v) : (size_t)nb * SEQ + (size_t)min(max(nt0 - 384 + (v), 0), SEQ - 1))
#pragma unroll
        for (int tl = 0; tl < 2; ++tl) { glds16(KVn + ROWAN(tl * 64 + krow) * 512 + kchunk * 16, kdst + (unsigned)(tl * SLOT)); glds16(KVn + ROWAN(tl * 64 + vk) * 512 + 256 + vc * 2, vdst + (unsigned)(tl * SLOT)); }
#undef ROWAN
    }
    if (do_store) {
        const int le_ = lane_id(), r32e = le_ & 31, hie = le_ >> 5;
#pragma unroll
        for (int rb = 0; rb < 2; ++rb) { float l_ = lsum[rb];
            { auto rr = __builtin_amdgcn_permlane32_swap(__float_as_uint(l_), __float_as_uint(l_), false, false); l_ = __uint_as_float(rr[0]) + __uint_as_float(rr[1]); }
            const float rl = __builtin_amdgcn_rcpf(l_ + sk);
            bf16_t* Ow = Ob + (qrow + rb * 32 + r32e) * 2048 + head * 64 + 4 * hie;
#pragma unroll
            for (int d0 = 0; d0 < 2; ++d0)
#pragma unroll
                for (int r4 = 0; r4 < 4; ++r4) { u32x2 w; w.x = cvt_pk_bf16(o[rb][d0][4 * r4] * rl, o[rb][d0][4 * r4 + 1] * rl); w.y = cvt_pk_bf16(o[rb][d0][4 * r4 + 2] * rl, o[rb][d0][4 * r4 + 3] * rl);
                    *(u32x2*)(Ow + d0 * 32 + r4 * 8) = w; } }
    }
    if (!has_next) BARV(0);
#undef ROWA
#undef DMA_A
#undef BARV
#undef WAITL
#undef LDK
#undef PK4
#undef VRDA
#undef VF
}
#undef SBAR
}

template <class RowMap>
__device__ __forceinline__ void transpose_item(const float* W, int ldn, int k0, int n0, bf16_t* WT, int ldt, int koff, const RowMap& rm, LAS float* scr, int lane) {
#pragma unroll 8
    for (int i = 0; i < 32; ++i) { const int kk = 2 * i + (lane >> 5); scr[kk * 33 + (lane & 31)] = W[(size_t)(k0 + kk) * ldn + n0 + (lane & 31)]; }
    LDS_WAIT(); asm volatile("" ::: "memory");
    const int c = lane & 7;
#pragma unroll
    for (int j = 0; j < 4; ++j) { const int n = (lane >> 3) + 8 * j; const LAS float* s = scr + (8 * c) * 33 + n;
        u32x4 o; o.x = cvt_pk_bf16(s[0 * 33], s[1 * 33]); o.y = cvt_pk_bf16(s[2 * 33], s[3 * 33]); o.z = cvt_pk_bf16(s[4 * 33], s[5 * 33]); o.w = cvt_pk_bf16(s[6 * 33], s[7 * 33]);
        *(u32x4*)(WT + (size_t)rm(n0 + n) * ldt + koff + k0 + 8 * c) = o; }
    LDS_WAIT(); asm volatile("" ::: "memory");
}
struct RowNat { __device__ __forceinline__ int operator()(int c) const { return c; } };
struct RowPerm { __device__ __forceinline__ int operator()(int c) const { return (c & ~31) | inv32(c & 31); } };
struct RowHead { __device__ __forceinline__ int operator()(int c) const { const int ci = c & 255; return (c & ~255) + 128 * ((ci >> 5) & 1) + 32 * (ci >> 6) + inv32(ci & 31); } };
struct RowP16 { __device__ __forceinline__ int operator()(int c) const { const int ci = c & 255; return (c & ~255) + 128 * ((ci >> 3) & 1) + 32 * (ci >> 6) + 16 * ((ci >> 2) & 1) + 4 * ((ci >> 4) & 3) + (ci & 3); } };
struct RowWin {
    __device__ __forceinline__ int operator()(int c) const {
        const int pn = c >> 8, ci = c & 255;
        const bool ropet = (pn >= 1 && pn <= 4) || (pn >= 9 && pn <= 16);
        if (pn == 0) { const int wc = ci >> 6, bj = (ci >> 5) & 1, p = ci & 31; return 128 * bj + 32 * wc + (wc < 2 ? p : inv32(p)); }
        if (ropet) { const int wc = ci >> 6, bj = (ci >> 5) & 1, p = ci & 31; return pn * 256 + 128 * bj + 32 * wc + p; }
        { const int wc = ci >> 6, bj = (ci >> 5) & 1, p = ci & 31; return pn * 256 + 128 * bj + 32 * wc + inv32(p); }
    }
};
struct RowGU { int up; __device__ __forceinline__ int operator()(int ch) const { const int pn = ch >> 7, c7 = ch & 127; return 256 * pn + 128 * up + (c7 & ~31) + inv32(c7 & 31); } };

__device__ __forceinline__ void modrow(const float* src, bf16_t* dst, const float* gain, const float* modr, const float* bada, int sh_off, int sc_off, int lane) {
    const f32x4* xr = (const f32x4*)src + lane;
    f32x4 v[4]; float s2 = 0.f;
#pragma unroll
    for (int j = 0; j < 4; ++j) { v[j] = xr[64 * j]; s2 += (v[j][0] * v[j][0] + v[j][1] * v[j][1]) + (v[j][2] * v[j][2] + v[j][3] * v[j][3]); }
    const float rstd = rsqrtf(wave_sum(s2) * (1.f / DM) + EPSN);
    u32x2* o8 = (u32x2*)dst + lane;
#pragma unroll
    for (int j = 0; j < 4; ++j) { const int k4 = (lane + 64 * j) * 4;
        const f32x4 g = *(const f32x4*)(gain + k4);
        const f32x4 sc = *(const f32x4*)(modr + sc_off + k4);
        const f32x4 sh = *(const f32x4*)(modr + sh_off + k4);
        const f32x4 hh = v[j] * rstd * g * (1.0f + sc) + sh;
        u32x2 w; w.x = cvt_pk_bf16(hh[0], hh[1]); w.y = cvt_pk_bf16(hh[2], hh[3]); o8[64 * j] = w; }
}

__device__ __forceinline__ void modrow2(const float* srcA, const float* srcB, bf16_t* dstA, bf16_t* dstB, const float* gain, const float* modA, const float* modB, int sh_off, int sc_off, int lane) {
    const f32x4* xa = (const f32x4*)srcA + lane; const f32x4* xb = (const f32x4*)srcB + lane;
    f32x4 va[4], vb[4]; float sa = 0.f, sb = 0.f;
#pragma unroll
    for (int j = 0; j < 4; ++j) { va[j] = __builtin_nontemporal_load(xa + 64 * j); vb[j] = __builtin_nontemporal_load(xb + 64 * j); }
#pragma unroll
    for (int j = 0; j < 4; ++j) { sa += (va[j][0] * va[j][0] + va[j][1] * va[j][1]) + (va[j][2] * va[j][2] + va[j][3] * va[j][3]); sb += (vb[j][0] * vb[j][0] + vb[j][1] * vb[j][1]) + (vb[j][2] * vb[j][2] + vb[j][3] * vb[j][3]); }
#pragma unroll
    for (int o = 1; o < 64; o <<= 1) { sa += __shfl_xor(sa, o); sb += __shfl_xor(sb, o); }
    const float ra = rsqrtf(sa * (1.f / DM) + EPSN), rb = rsqrtf(sb * (1.f / DM) + EPSN);
    u32x2* oa = (u32x2*)dstA + lane; u32x2* ob = (u32x2*)dstB + lane;
#pragma unroll
    for (int j = 0; j < 4; ++j) { const int k4 = (lane + 64 * j) * 4;
        const f32x4 g = *(const f32x4*)(gain + k4);
        const f32x4 ha = va[j] * ra * g * (1.0f + *(const f32x4*)(modA + sc_off + k4)) + *(const f32x4*)(modA + sh_off + k4);
        const f32x4 hb = vb[j] * rb * g * (1.0f + *(const f32x4*)(modB + sc_off + k4)) + *(const f32x4*)(modB + sh_off + k4);
        u32x2 wa; wa.x = cvt_pk_bf16(ha[0], ha[1]); wa.y = cvt_pk_bf16(ha[2], ha[3]); oa[64 * j] = wa;
        u32x2 wb; wb.x = cvt_pk_bf16(hb[0], hb[1]); wb.y = cvt_pk_bf16(hb[2], hb[3]); ob[64 * j] = wb; }
}

__device__ __forceinline__ void modrow2b(const bf16_t* srcA, const bf16_t* srcB, bf16_t* dstA, bf16_t* dstB, const float* gain, const float* modA, const float* modB, int sh_off, int sc_off, int lane) {
    const u32x2* xa = (const u32x2*)srcA + lane; const u32x2* xb = (const u32x2*)srcB + lane;
    u32x2 pa[4], pb[4]; f32x4 va[4], vb[4]; float sa = 0.f, sb = 0.f;
#pragma unroll
    for (int j = 0; j < 4; ++j) { pa[j] = __builtin_nontemporal_load(xa + 64 * j); pb[j] = __builtin_nontemporal_load(xb + 64 * j); }
#pragma unroll
    for (int j = 0; j < 4; ++j) { va[j] = (f32x4){bf_lo(pa[j].x), bf_hi(pa[j].x), bf_lo(pa[j].y), bf_hi(pa[j].y)}; vb[j] = (f32x4){bf_lo(pb[j].x), bf_hi(pb[j].x), bf_lo(pb[j].y), bf_hi(pb[j].y)};
        sa += (va[j][0] * va[j][0] + va[j][1] * va[j][1]) + (va[j][2] * va[j][2] + va[j][3] * va[j][3]); sb += (vb[j][0] * vb[j][0] + vb[j][1] * vb[j][1]) + (vb[j][2] * vb[j][2] + vb[j][3] * vb[j][3]); }
#pragma unroll
    for (int o = 1; o < 64; o <<= 1) { sa += __shfl_xor(sa, o); sb += __shfl_xor(sb, o); }
    const float ra = rsqrtf(sa * (1.f / DM) + EPSN), rb = rsqrtf(sb * (1.f / DM) + EPSN);
    u32x2* oa = (u32x2*)dstA + lane; u32x2* ob = (u32x2*)dstB + lane;
#pragma unroll
    for (int j = 0; j < 4; ++j) { const int k4 = (lane + 64 * j) * 4;
        const f32x4 g = *(const f32x4*)(gain + k4);
        const f32x4 ha = va[j] * ra * g * (1.0f + *(const f32x4*)(modA + sc_off + k4)) + *(const f32x4*)(modA + sh_off + k4);
        const f32x4 hb = vb[j] * rb * g * (1.0f + *(const f32x4*)(modB + sc_off + k4)) + *(const f32x4*)(modB + sh_off + k4);
        u32x2 wa; wa.x = cvt_pk_bf16(ha[0], ha[1]); wa.y = cvt_pk_bf16(ha[2], ha[3]); oa[64 * j] = wa;
        u32x2 wb; wb.x = cvt_pk_bf16(hb[0], hb[1]); wb.y = cvt_pk_bf16(hb[2], hb[3]); ob[64 * j] = wb; }
}

struct SchedP1 {
    int G, c; const char* A; const char* B;
    __device__ __forceinline__ bool next(int i, Unit& u) const {
        long L = (long)i * G + c; if (L >= 6472) return false;
        if (L < 6400) { int wgid = (int)L; { const int xcd = wgid % 8, off = wgid / 8; wgid = xcd * 800 + off; }
            const int gid = wgid / 200; u.pm = gid * 8 + ((wgid % 200) % 8); u.pn = (wgid % 200) / 8; }
        else { const int l2 = (int)(L - 6400); u.pm = 256 + l2 / 9; u.pn = l2 % 9; }
        u.A = A + (size_t)u.pm * 256 * 2048; u.B = B + (size_t)u.pn * 256 * 2048; u.tok = nullptr; u.x0 = 0; return true;
    }
};
struct SchedG1 {
    int t0, nu, r, W_; const char* A; const char* W; const int* texp; const int* rtok; const LAS int* tl;
    __device__ __forceinline__ void init(int ntiles, int G, int v) { const int nx = G >= 8 ? 8 : 1, wpx = G / nx, x = v / wpx; r = v % wpx; W_ = wpx; const int base = ntiles / nx, rem = ntiles % nx; t0 = x * base + (x < rem ? x : rem); nu = 2 * (base + (x < rem ? 1 : 0)); }
    __device__ __forceinline__ bool next(int i, Unit& u) const {
        const int uu = i * W_ + r; if (uu >= nu) return false;
        const int tile = t0 + (uu >> 1); u.pm = tile; u.pn = uu & 1;
        const int e = tl[i]; u.x0 = e;
        u.A = A; u.tok = rtok + (size_t)tile * 256; u.B = W + (size_t)e * (512 * 2048) + (size_t)u.pn * (256 * 2048); return true;
    }
};
struct SchedG2 {
    int t0, nu, r, W_; const char* A; const char* W; const int* texp; const char* Ws; const LAS int* tl;
    __device__ __forceinline__ void init(int ntiles, int G, int v) { const int nx = G >= 8 ? 8 : 1, wpx = G / nx, x = v / wpx; r = v % wpx; W_ = wpx; const int base = ntiles / nx, rem = ntiles % nx; t0 = x * base + (x < rem ? x : rem); nu = 4 * (base + (x < rem ? 1 : 0)); }
    __device__ __forceinline__ bool next(int i, Unit& u) const {
        const int uu = i * W_ + r; if (uu >= nu) return false;
        const int tile = t0 + (nu >> 2) - 1 - (uu >> 2); u.pm = tile; u.pn = uu & 3;
        const int e = tl[i]; u.x0 = e; u.tok = nullptr;
        u.A = A + (size_t)tile * 256 * 512; u.B = (e < NEXP ? W + (size_t)e * (1024 * 512) : Ws) + (size_t)u.pn * (256 * 512); return true;
    }
};

constexpr int NPHASE = 12;
struct Args { const float* in[30]; float* out; unsigned char* ws; int ph_lo, ph_hi, flags, pad; };
__global__ void __launch_bounds__(512, 2) fwd(Args args) {
    extern __shared__ __attribute__((aligned(16))) unsigned char lds[];
    LAS unsigned char* ldsl = (LAS unsigned char*)lds;
    volatile LAS unsigned* MISC = (volatile LAS unsigned*)(ldsl + MISC_OFF);
    const int wave = __builtin_amdgcn_readfirstlane(threadIdx.x >> 6);
#define TIDX (wave * 64 + lane_id())
    const int G = gridDim.x, bx = blockIdx.x;
    const int vcu = (G % 8 == 0) ? (bx % 8) * (G / 8) + bx / 8 : bx;
    unsigned char* ws = args.ws;
    unsigned* ctl = (unsigned*)(ws + WS_CTL);
    for (int u = TIDX; u < (LDS_BYTES - LDSCTL_OFF) / 4; u += 512) ((LAS unsigned*)(ldsl + LDSCTL_OFF))[u] = 0u;
    __syncthreads();
    XcdBarrier bar; bar.bar = ctl + CW_BAR; bar.x = 0; bar.st = nullptr;
#if MK_ONE_LAUNCH
    bar = xcd_barrier_post(ctl + CW_BAR, MISC + 8, TIDX == 0);
#define GRID_BAR() xcd_barrier(bar, TIDX == 0)
#else
#define GRID_BAR() do {} while (0)
#endif
    const int lo = args.ph_lo, hi = args.ph_hi;
#ifndef PH_MASK
#define PH_MASK 0xFFFFFFFFu
#endif
#define IN(k) (((PH_MASK >> (k)) & 1u) && lo <= (k) && (k) < hi)
#ifndef REP_MASK
#define REP_MASK 0u
#endif
#define NREP(k) ((((REP_MASK) >> (k)) & 1u) ? 2 : 1)
#define SEAM(k) do { if (IN(k) && IN((k) + 1)) GRID_BAR(); } while (0)
#define x_ (args.in[0])
#define cvec (args.in[1])
#define ctx (args.in[2])
#define c_ctx (args.in[3])
#define w_ada (args.in[4])
#define b_ada (args.in[5])
#define norm1_g (args.in[6])
#define norm2_g (args.in[7])
#define w_in (args.in[8])
#define modacc ((float*)(ws + WS_MOD))
#define Win_t ((bf16_t*)(ws + WS_WIN))
#define Wpab_t ((bf16_t*)(ws + WS_WPAB))
#define Wo_t ((bf16_t*)(ws + WS_WO))
#define Wr_t ((bf16_t*)(ws + WS_WR))
#define rope ((float*)(ws + WS_ROPE))
#define scal ((float*)(ws + WS_SCAL))
#define texp ((int*)(ws + WS_TEXP))
#define ridx ((int*)(ws + WS_IDX))
#define rwts ((float*)(ws + WS_WTS))
#define rrnk ((int*)(ws + WS_RNK))
#define wgb ((int*)(ws + WS_WGB))
#define rtok ((int*)(ws + WS_RTOK))
#define rw ((float*)(ws + WS_RW))
#define rdst ((int*)(ws + WS_RDST))
#define Hb ((bf16_t*)(ws + WS_H))
#define Qb ((bf16_t*)(ws + WS_Q))
#define KVAb ((bf16_t*)(ws + WS_KVA))
#define KBb ((bf16_t*)(ws + WS_KB))
#define VBb ((bf16_t*)(ws + WS_VB))
#define Gb ((bf16_t*)(ws + WS_G))
#define Zb ((bf16_t*)(ws + WS_H))
#define ACT ((bf16_t*)(ws + WS_ACT))
#define Wd_t ((bf16_t*)args.out)
#define Wds_t ((bf16_t*)(ws + WS_WDS))
#define X1 ((bf16_t*)(ws + WS_X1))
#define Wgu_t ((bf16_t*)(ws + WS_WGU))
#define H2 ((bf16_t*)(ws + WS_H2))
#define LT ((float*)(ws + WS_LT))
#define Y2 ((bf16_t*)(ws + WS_Y2))
#define cnt (ctl + CW_CNT)
    const int gw = vcu * 8 + wave, NGW = G * 8;

    if (IN(0)) {
        const int lane = lane_id(), tid = wave * 64 + lane;
        LAS float* sil = (LAS float*)ldsl;
        for (int i = tid; i < 9 * 1024; i += 512) { const int r = i >> 10, k = i & 1023; const float v = r < 8 ? cvec[r * 1024 + k] : c_ctx[k]; sil[i] = v / (1.0f + __expf(-v)); }
        __syncthreads();
        if (bx < 96) {
            LAS float* part = sil + 9 * 1024;
            const int j = bx * 64 + lane;
            float a[9];
#pragma unroll
            for (int r = 0; r < 9; ++r) a[r] = 0.f;
#pragma unroll 8
            for (int kk = 0; kk < 128; ++kk) { const int k = wave * 128 + kk; const float w = w_ada[(size_t)k * 6144 + j];
#pragma unroll
                for (int r = 0; r < 9; ++r) a[r] += sil[r * 1024 + k] * w; }
#pragma unroll
            for (int r = 0; r < 9; ++r) part[(wave * 9 + r) * 64 + lane] = a[r];
            __syncthreads();
            for (int i = tid; i < 9 * 64; i += 512) { const int r = i >> 6, l = i & 63; float sacc = 0.f;
#pragma unroll
                for (int w = 0; w < 8; ++w) sacc += part[(w * 9 + r) * 64 + l];
                modacc[r * 6144 + bx * 64 + l] = sacc + b_ada[bx * 64 + l]; }
        }
        __syncthreads();
        LAS float* scr = (LAS float*)(ldsl + wave * 16384);
        constexpr int I_IN = 16 * 200, I_SQ = 16 * 32, I_R = 16 * 8;
        for (int it = gw; it < I_IN + 3 * I_SQ + I_R; it += NGW) {
            int r = it;
            if (r < I_IN) { transpose_item(w_in, INW, 64 * (r / 200), 32 * (r % 200), Win_t, 1024, 0, RowWin{}, scr, lane); continue; } r -= I_IN;
            if (r < I_SQ) { transpose_item(args.in[19], 1024, 64 * (r / 32), 32 * (r % 32), Wpab_t, 2048, 0, RowHead{}, scr, lane); continue; } r -= I_SQ;
            if (r < I_SQ) { transpose_item(args.in[20], 1024, 64 * (r / 32), 32 * (r % 32), Wpab_t, 2048, 1024, RowHead{}, scr, lane); continue; } r -= I_SQ;
            if (r < I_SQ) { transpose_item(args.in[21], 1024, 64 * (r / 32), 32 * (r % 32), Wo_t, 1024, 0, RowHead{}, scr, lane); continue; } r -= I_SQ;
            transpose_item(args.in[22], 256, 64 * (r / 8), 32 * (r % 8), Wr_t, 1024, 0, RowNat{}, scr, lane);
        }
        for (int i = bx * 512 + tid; i < 2048; i += G * 512) { const int pos = i >> 4, j = i & 15; const float fr_ = powf(10000.0f, -(float)j / 16.0f); const float ang = (float)pos * fr_; rope[i] = cosf(ang); rope[2048 + i] = sinf(ang); }
        if (bx == 0 && wave == 0) {
            const float a = wave_sum(args.in[14][lane] * args.in[15][lane]), b2 = wave_sum(args.in[16][lane] * args.in[17][lane]);
            if (lane == 0) scal[0] = expf(a) - expf(b2) + 0.2f;
            float mq = fabsf(args.in[12][lane]), mk = fabsf(args.in[13][lane]);
#pragma unroll
            for (int o_ = 1; o_ < 64; o_ <<= 1) { mq = fmaxf(mq, __shfl_xor(mq, o_)); mk = fmaxf(mk, __shfl_xor(mk, o_)); }
            if (lane == 0) scal[2] = -11.55f * mq * mk;
            float aq = fabsf(args.in[9][lane]), ak = fabsf(args.in[10][lane]);
#pragma unroll
            for (int o_ = 1; o_ < 64; o_ <<= 1) { aq = fmaxf(aq, __shfl_xor(aq, o_)); ak = fmaxf(ak, __shfl_xor(ak, o_)); }
            if (lane == 0) scal[3] = -11.55f * aq * ak;
        }
        __syncthreads();
    }
    SEAM(0);

    if (IN(1)) {
        const int lane = lane_id();
        for (int m = gw; m < T; m += 2 * NGW) modrow2(x_ + (size_t)m * DM, x_ + (size_t)(m + NGW) * DM, Hb + (size_t)m * DM, Hb + (size_t)(m + NGW) * DM, norm1_g, modacc + (m >> 13) * 6144, modacc + ((m + NGW) >> 13) * 6144, 0, 1024, lane);
        for (int m = T + gw; m < TT; m += NGW) modrow(ctx + (size_t)(m - T) * DM, Hb + (size_t)m * DM, norm1_g, modacc + 8 * 6144, b_ada, 0, 1024, lane);
    }
    SEAM(1);

    if (IN(2)) {
        SchedP1 S{G, bx, (const char*)Hb, (const char*)Win_t};
        EpiP1 E{KVAb, KBb, VBb, Qb, Gb, args.in[9], args.in[10], args.in[12], args.in[13], rope, (args.flags >> 5) & 3};
        pg8::gemm_phase<EpiP1, SchedP1, true, false>(ldsl, 1024, S, E, wave);
    }
    SEAM(2);

    if (IN(3)) {
        const float lam = scal[0], negMb = scal[2];
        const int xq = vcu >> 5, rk = vcu & 31;
        if (G == 256) {
#ifdef PROBE_VAR
            for (int i = 0; i < 8; ++i) att::attnB7_unit<PROBE_VAR>(Qb, KBb, VBb, Qb, (xq * 8 + i) >> 3, (xq * 8 + i) & 7, rk, (char*)lds, lam, args.in[18], wave, lo > 0, 0, 0, 0, true, false);
#endif
            if (!(args.flags & 8)) { if (negMb > -100.f) { for (int i = 0; i < 8; ++i) att::attnB9_unit(Qb, KBb, VBb, Qb, (xq * 8 + i) >> 3, (xq * 8 + i) & 7, rk, (char*)lds, scal, args.in[18], wave, !(args.flags & 2), (xq * 8 + i + 1) >> 3, (xq * 8 + i + 1) & 7, rk, i == 0, i < 7); }
                else for (int i = 0; i < 16; ++i) { const int pair = xq * 8 + (i >> 1), qb = rk * 2 + (i & 1); att::attnB_unit(Qb, KBb, VBb, Qb, pair >> 3, pair & 7, qb, (char*)lds, lam, args.in[18], wave); } }
            if (!(args.flags & 4)) { if (scal[3] > -100.f) { bf16x8 qA[2][4]; for (int i = 0; i < 8; ++i) { const int uu = vcu * 8 + i, un = uu + 1; att::attnA5_unit(Qb, KVAb, Qb, uu >> 8, (uu >> 7) & 1, uu & 127, (char*)lds, args.in[11], wave, !(args.flags & 1), qA, i == 0, i < 7, un >> 8, (un >> 7) & 1, un & 127); } }
                else for (int i = 0; i < 16; ++i) { const int uu = vcu * 16 + i; att::attnA_unit(Qb, KVAb, Qb, uu >> 9, (uu >> 8) & 1, uu & 255, (char*)lds, args.in[11], wave, !(args.flags & 1)); } }
        } else {
            for (int uu = bx; uu < 4096; uu += G) att::attnB_unit(Qb, KBb, VBb, Qb, uu >> 9, (uu >> 6) & 7, uu & 63, (char*)lds, lam, args.in[18], wave);
            for (int uu = bx; uu < 4096; uu += G) att::attnA_unit(Qb, KVAb, Qb, uu >> 9, (uu >> 8) & 1, uu & 255, (char*)lds, args.in[11], wave);
        }
    }
    SEAM(3);

    if (IN(4)) {
        pg8::SchedMN S{256, 4, 1024, G, bx, 2048, (const char*)Qb, (const char*)Wpab_t};
        EpiZ E{Gb, Zb};
        pg8::gemm_phase<EpiZ, pg8::SchedMN, true, false>(ldsl, 2048, S, E, wave);
    }
    SEAM(4);

    if (IN(5)) {
        pg8::SchedMN S{256, 4, 1024, G, bx, 1024, (const char*)Zb, (const char*)Wo_t};
        EpiX1 E{x_, X1, modacc, b_ada};
        pg8::gemm_phase<EpiX1, pg8::SchedMN, true, false>(ldsl, 1024, S, E, wave);
    }
    SEAM(5);

    if (IN(6)) {
        const int lane = lane_id();
        LAS float* scr = (LAS float*)(ldsl + wave * 16384);
        {
            float va_[32], vb_[32];
#define CV_DESC(it_, src_, ldn_, k0_, n0_) const int e_##it_ = (it_) / 384, r_##it_ = (it_) % 384, mtx_##it_ = r_##it_ >> 7, q_##it_ = r_##it_ & 127; \
            const float* src_ = mtx_##it_ < 2 ? (e_##it_ < NEXP ? args.in[24 + mtx_##it_] + (size_t)e_##it_ * 262144 : args.in[27 + mtx_##it_]) : (e_##it_ < NEXP ? args.in[26] + (size_t)e_##it_ * 262144 : args.in[29]); \
            const int ldn_ = mtx_##it_ < 2 ? 256 : 1024, k0_ = mtx_##it_ < 2 ? 64 * (q_##it_ >> 3) : 64 * (q_##it_ >> 5), n0_ = mtx_##it_ < 2 ? 32 * (q_##it_ & 7) : 32 * (q_##it_ & 31);
#define CV_LOAD(v_, it_) do { CV_DESC(it_, s_, l_, k_, n_) \
            _Pragma("unroll") for (int i = 0; i < 32; ++i) v_[i] = __builtin_nontemporal_load(s_ + (size_t)(k_ + 2 * i + (lane >> 5)) * l_ + n_ + (lane & 31)); } while (0)
#define CV_STORE(v_, it_) do { CV_DESC(it_, s_, l_, k_, n_) (void)s_; (void)l_; \
            _Pragma("unroll") for (int i = 0; i < 32; ++i) scr[(2 * i + (lane >> 5)) * 33 + (lane & 31)] = v_[i]; \
            LDS_WAIT(); asm volatile("" ::: "memory"); \
            const int c_ = lane & 7; \
            _Pragma("unroll") for (int jj = 0; jj < 4; ++jj) { const int n = (lane >> 3) + 8 * jj; const LAS float* sp = scr + (8 * c_) * 33 + n; \
                u32x4 o; o.x = cvt_pk_bf16(sp[0 * 33], sp[1 * 33]); o.y = cvt_pk_bf16(sp[2 * 33], sp[3 * 33]); o.z = cvt_pk_bf16(sp[4 * 33], sp[5 * 33]); o.w = cvt_pk_bf16(sp[6 * 33], sp[7 * 33]); \
                if (mtx_##it_ < 2) { const RowGU rm{mtx_##it_}; *(u32x4*)(Wgu_t + (size_t)e_##it_ * 524288 + (size_t)rm(n_ + n) * 1024 + k_ + 8 * c_) = o; } \
                else { const RowP16 rm; *(u32x4*)((e_##it_ < NEXP ? Wd_t + (size_t)e_##it_ * 262144 : Wds_t) + (size_t)rm(n_ + n) * 256 + k_ + 8 * c_) = o; } } \
            LDS_WAIT(); asm volatile("" ::: "memory"); } while (0)
            const int NIT = NE1 * 384;
            int it = gw;
            if (it < NIT) CV_LOAD(va_, it);
            for (; it < NIT; it += 2 * NGW) {
                const int it1 = it + NGW, it2 = it + 2 * NGW;
                if (it1 < NIT) CV_LOAD(vb_, it1);
                CV_STORE(va_, it);
                if (it1 < NIT) { if (it2 < NIT) CV_LOAD(va_, it2); CV_STORE(vb_, it1); }
            }
#undef CV_DESC
#undef CV_LOAD
#undef CV_STORE
        }
            for (int m = gw; m < T; m += 2 * NGW) modrow2b(X1 + (size_t)m * DM, X1 + (size_t)(m + NGW) * DM, H2 + (size_t)m * DM, H2 + (size_t)(m + NGW) * DM, norm2_g, modacc + (m >> 13) * 6144, modacc + ((m + NGW) >> 13) * 6144, 3072, 4096, lane);
    }
    SEAM(6);

    if (IN(7)) {
        pg8::SchedMN S{256, 1, 256, G, bx, 1024, (const char*)H2, (const char*)Wr_t};
        EpiRoute E{args.in[23], ridx, rwts, rrnk, (args.flags & 16) ? wgb + 65536 : wgb, (args.flags & 16) ? cnt + 1024 : cnt};
        pg8::gemm_phase<EpiRoute, pg8::SchedMN, false, false>(ldsl, 1024, S, E, wave);
    }
    SEAM(7);

    if (IN(8)) {
        const int tid = TIDX;
        LAS int* pst = (LAS int*)ldsl;
        LAS int* pcn = pst + 512;
        if (tid < NEXP) pcn[tid] = ((int)cnt[tid] + 255) & ~255;
        __syncthreads();
        if (tid < 64) {
            const int a0 = pcn[4 * tid], a1 = pcn[4 * tid + 1], a2 = pcn[4 * tid + 2], a3 = pcn[4 * tid + 3];
            const int tot = a0 + a1 + a2 + a3; int inc = tot;
#pragma unroll
            for (int o = 1; o < 64; o <<= 1) { const int v = __shfl_up(inc, o); if (tid >= o) inc += v; }
            const int ex = inc - tot;
            pst[4 * tid] = ex; pst[4 * tid + 1] = ex + a0; pst[4 * tid + 2] = ex + a0 + a1; pst[4 * tid + 3] = ex + a0 + a1 + a2;
            if (tid == 63) { pst[256] = inc; pst[257] = inc + T; }
        }
        __syncthreads();
        for (int pm = bx; pm < 256; pm += G) {
            if (tid < 256) { const int t = pm * 256 + tid;
#pragma unroll
                for (int k = 0; k < 8; ++k) { const int e = ridx[t * 8 + k]; const int pos = pst[e] + wgb[pm * 256 + e] + rrnk[t * 8 + k]; rtok[pos] = t; rw[pos] = rwts[t * 8 + k]; rdst[pos] = t * NSLOT + k; }
                const int ps = pst[256] + t; rtok[ps] = t; rw[ps] = 1.0f; rdst[ps] = t * NSLOT + 8; }
        }
        for (int e = bx; e < NEXP; e += G) {
            const int c = (int)cnt[e], p0 = pst[e], p1 = pst[e + 1];
            for (int r = p0 + c + tid; r < p1; r += 512) { rtok[r] = 0; rw[r] = 0.f; rdst[r] = T * NSLOT; }
            for (int tl = (p0 >> 8) + tid; tl < (p1 >> 8); tl += 512) texp[tl] = e;
        }
        if (bx == 0) { for (int tl = (pst[256] >> 8) + tid; tl < (pst[257] >> 8); tl += 512) texp[tl] = 256; if (tid == 0) ((int*)scal)[1] = pst[257] >> 8; }
        __syncthreads();
    }
    SEAM(8);

    if (IN(9)) {
        const int ntiles = ((const int*)scal)[1];
        SchedG1 S{0, 0, 0, 0, (const char*)H2, (const char*)Wgu_t, texp, rtok, nullptr}; S.init(ntiles, G, vcu);
        { LAS int* tl_ = (LAS int*)(ldsl + EXP_TAB_OFF); const int t_ = TIDX; if (t_ < 64) { const int uu = t_ * S.W_ + S.r; if (uu < S.nu) tl_[t_] = texp[S.t0 + (uu >> 1)]; } __syncthreads(); S.tl = tl_; }
        EpiAct E{ACT, rw};
        pg8::gemm_phase<EpiAct, SchedG1, true, true>(ldsl, 1024, S, E, wave);
    }
    SEAM(9);

    if (IN(10)) {
        const int ntiles = ((const int*)scal)[1];
        SchedG2 S{0, 0, 0, 0, (const char*)ACT, (const char*)Wd_t, texp, (const char*)Wds_t, nullptr}; S.init(ntiles, G, vcu);
        { LAS int* tl_ = (LAS int*)(ldsl + EXP_TAB_OFF); const int t_ = TIDX; if (t_ < 64) { const int uu = t_ * S.W_ + S.r; if (uu < S.nu) tl_[t_] = texp[S.t0 + (S.nu >> 2) - 1 - (uu >> 2)]; } __syncthreads(); S.tl = tl_; }
        EpiY2 E{(unsigned char*)Y2, rdst};
        pg8::gemm_phase<EpiY2, SchedG2, false, false>(ldsl, 256, S, E, wave);
    }
    SEAM(10);

    if (IN(11)) {
        const int lane = lane_id();
#define COMB_LOAD(P, t_) const unsigned char* P##yr = (const unsigned char*)Y2 + (size_t)(t_) * NSLOT * 1024 + lane * 16; u32x4 P##w[NSLOT]; \
            _Pragma("unroll") for (int k = 0; k < NSLOT; ++k) P##w[k] = __builtin_nontemporal_load((const u32x4*)(P##yr + k * 1024)); \
            float* P##op = args.out + (size_t)(t_) * DM + lane * 16; const u32x4* P##xp = (const u32x4*)(X1 + (size_t)(t_) * DM + lane * 16); const u32x4 P##xa = __builtin_nontemporal_load(P##xp), P##xb = __builtin_nontemporal_load(P##xp + 1); f32x4 P##x[4]; \
            P##x[0] = (f32x4){bf_lo(P##xa.x), bf_hi(P##xa.x), bf_lo(P##xa.y), bf_hi(P##xa.y)}; P##x[1] = (f32x4){bf_lo(P##xa.z), bf_hi(P##xa.z), bf_lo(P##xa.w), bf_hi(P##xa.w)}; P##x[2] = (f32x4){bf_lo(P##xb.x), bf_hi(P##xb.x), bf_lo(P##xb.y), bf_hi(P##xb.y)}; P##x[3] = (f32x4){bf_lo(P##xb.z), bf_hi(P##xb.z), bf_lo(P##xb.w), bf_hi(P##xb.w)};
#define COMB_DONE(P, t_) { const float* g2p = modacc + ((t_) >> 13) * 6144 + 5120 + lane * 16; \
            _Pragma("unroll") for (int q = 0; q < 4; ++q) { f32x4 s_ = {0.f, 0.f, 0.f, 0.f}; \
                _Pragma("unroll") for (int k = 0; k < NSLOT; ++k) { const f32x2 a = __builtin_amdgcn_cvt_pk_f32_fp8((int)P##w[k][q], false), b_ = __builtin_amdgcn_cvt_pk_f32_fp8((int)P##w[k][q], true); s_[0] += a[0]; s_[1] += a[1]; s_[2] += b_[0]; s_[3] += b_[1]; } \
                *(f32x4*)(P##op + 4 * q) = P##x[q] + *(const f32x4*)(g2p + 4 * q) * s_; } }
        for (int t = gw; t < T; t += 2 * NGW) {
            COMB_LOAD(a_, t) COMB_LOAD(b_, t + NGW)
            COMB_DONE(a_, t) COMB_DONE(b_, t + NGW)
        }
#undef COMB_LOAD
#undef COMB_DONE
    }
#undef IN
#undef SEAM
}

extern "C" void kernel_launch(void* const* d_in, const int* in_sizes, int n_in, void* d_out, int out_size, void* d_ws, size_t ws_size, hipStream_t stream) {
    static int grid = 0;
    if (grid == 0) {
        if (n_in != 30 || out_size != T * DM || ws_size < WS_END) { fprintf(stderr, "kernel_launch: unexpected shapes (n_in %d, out %d, ws %zu)\n", n_in, out_size, ws_size); grid = -1; return; }
        int dev = 0, cus = 0, per_cu = 0;
        if (hipGetDevice(&dev) != hipSuccess || hipDeviceGetAttribute(&cus, hipDeviceAttributeMultiprocessorCount, dev) != hipSuccess) { grid = -1; return; }
        if (hipFuncSetAttribute((const void*)fwd, hipFuncAttributeMaxDynamicSharedMemorySize, LDS_BYTES) != hipSuccess) { fprintf(stderr, "kernel_launch: hipFuncSetAttribute failed\n"); grid = -1; return; }
        if (hipOccupancyMaxActiveBlocksPerMultiprocessor(&per_cu, (const void*)fwd, 512, LDS_BYTES) != hipSuccess || per_cu < 1) fprintf(stderr, "kernel_launch: occupancy query reports %d\n", per_cu);
        (void)hipGetLastError();
        grid = cus;
    }
    if (grid < 0) return;
    if (hipMemsetAsync((char*)d_ws + WS_CTL, 0, CTL_BYTES, stream) != hipSuccess) return;
    Args a{};
    for (int i = 0; i < 30; ++i) a.in[i] = (const float*)d_in[i];
    a.out = (float*)d_out; a.ws = (unsigned char*)d_ws;
#if MK_ONE_LAUNCH
    a.ph_lo = 0; a.ph_hi = NPHASE;
    hipLaunchKernelGGL(fwd, dim3(grid), dim3(512), LDS_BYTES, stream, a);
#else
#ifdef PROBE_SEQ
    { const int seq[] = {PROBE_SEQ}; for (int k = 0; k < (int)(sizeof(seq) / sizeof(int)); ++k) { const int p = seq[k] & 0xff; a.ph_lo = p; a.ph_hi = p + 1; a.flags = seq[k] >> 8; hipLaunchKernelGGL(fwd, dim3(grid), dim3(512), LDS_BYTES, stream, a); } }
#else
    for (int p = 0; p < NPHASE; ++p) { a.ph_lo = p; a.ph_hi = p + 1; hipLaunchKernelGGL(fwd, dim3(grid), dim3(512), LDS_BYTES, stream, a); }
#endif
#endif
    const hipError_t le = hipPeekAtLastError();
    if (le != hipSuccess) fprintf(stderr, "kernel_launch: launch failed: %s\n", hipGetErrorName(le));
}
```
